# Optimizing an MI355X kernel written in HIP

```python
import math
import jax, jax.numpy as jnp
from jax import lax
import numpy as np

D_MODEL = 2048
BATCH = 1
SEQ = 8192
DEPTH = 2

CHUNK = 64
N_BRANCH = 3
EPS = 1e-6

HG_DK = 128
HG_DV = 128
HG_WIDTH = D_MODEL // 2
HG_HEADS = HG_WIDTH // HG_DK
HG_VWIDTH = HG_HEADS * HG_DV

S5_WIDTH = D_MODEL // 2
S5_GROUP = 16
S5_GROUPS = S5_WIDTH // S5_GROUP
S5_STATE = 64

FOX_DH = 128
FOX_WIDTH = D_MODEL // 2
FOX_HEADS = FOX_WIDTH // FOX_DH
Q_BLOCK = 128

IN_SIZES = (HG_WIDTH, HG_WIDTH, HG_VWIDTH, HG_VWIDTH,
            S5_WIDTH, S5_WIDTH,
            FOX_WIDTH, FOX_WIDTH, FOX_WIDTH, FOX_HEADS, FOX_WIDTH,
            N_BRANCH * D_MODEL)
IN_WIDTH = sum(IN_SIZES)

kernel_name = 'hybrid_hgrn2_s5_fox_gated_merge'


def rms_norm(x, g):
    xf = x.astype(jnp.float32)
    y = xf * lax.rsqrt(jnp.mean(xf * xf, axis=-1, keepdims=True) + EPS)
    return (y * g.astype(jnp.float32)).astype(x.dtype)


def split_columns(z):
    parts = []
    off = 0
    for n in IN_SIZES:
        parts.append(z[..., off:off + n])
        off += n
    return parts


def hgrn_lower_bounds(lb_param):
    p = jax.nn.softmax(lb_param.astype(jnp.float32), axis=0)
    c = jnp.cumsum(p, axis=0)
    return c - c[0:1]


def hgrn2_mixer(q, f_logit, i, lb):
    b_, s_, _ = q.shape
    nc = s_ // CHUNK
    f32 = jnp.float32
    lbf = lb.astype(f32)
    zf = f_logit.astype(f32)
    log_f = jnp.logaddexp(jnp.log(lbf), jnp.log1p(-lbf) + jax.nn.log_sigmoid(zf))
    k = (1.0 - lbf) * jax.nn.sigmoid(-zf)

    def to_chunks(t, d):
        return t.astype(f32).reshape(b_, nc, CHUNK, HG_HEADS, d).transpose(1, 0, 3, 2, 4)

    xs = (to_chunks(q, HG_DK), to_chunks(k, HG_DK), to_chunks(i, HG_DV), to_chunks(log_f, HG_DK))
    causal = jnp.tril(jnp.ones((CHUNK, CHUNK), dtype=bool))[:, :, None]

    def step(state, inp):
        qb, kb, ib, gb = inp
        cum = jnp.cumsum(gb, axis=2)
        last = cum[:, :, -1:, :]
        diff = cum[:, :, :, None, :] - cum[:, :, None, :, :]
        decay = jnp.exp(jnp.where(causal, diff, -jnp.inf))
        scores = jnp.einsum('bhtk,bhtsk,bhsk->bhts', qb, decay, kb)
        out = (jnp.einsum('bhts,bhsv->bhtv', scores, ib)
               + jnp.einsum('bhtk,bhkv->bhtv', qb * jnp.exp(cum), state))
        new_state = (jnp.exp(last[:, :, 0, :, None]) * state
                     + jnp.einsum('bhsk,bhsv->bhkv', kb * jnp.exp(last - cum), ib))
        return new_state, out

    s0 = jnp.zeros((b_, HG_HEADS, HG_DK, HG_DV), f32)
    _, o = lax.scan(step, s0, xs)
    return o.transpose(1, 0, 3, 2, 4).reshape(b_, s_, HG_HEADS, HG_DV)


def s5_mixer(u, a_re, a_im, log_dt, b_re, b_im, c_re, c_im, d_skip, w_glu):
    b_, s_, _ = u.shape
    f32 = jnp.float32
    uf = u.astype(f32).reshape(b_, s_, S5_GROUPS, S5_GROUP)
    ar = a_re.astype(f32)
    ai = a_im.astype(f32)
    dt = jnp.exp(log_dt.astype(f32))[:, None]
    mag = jnp.exp(ar * dt)
    ang = ai * dt
    abar_re = mag * jnp.cos(ang)
    abar_im = mag * jnp.sin(ang)
    nr = abar_re - 1.0
    den = ar * ar + ai * ai
    zr = (nr * ar + abar_im * ai) / den
    zi = (abar_im * ar - nr * ai) / den
    br = b_re.astype(f32)
    bi = b_im.astype(f32)
    bbar_re = zr[:, :, None] * br - zi[:, :, None] * bi
    bbar_im = zr[:, :, None] * bi + zi[:, :, None] * br
    bu_re = jnp.einsum('bsgc,gpc->bsgp', uf, bbar_re)
    bu_im = jnp.einsum('bsgc,gpc->bsgp', uf, bbar_im)
    a_full_re = jnp.broadcast_to(abar_re, bu_re.shape)
    a_full_im = jnp.broadcast_to(abar_im, bu_im.shape)

    def combine(e1, e2):
        a1r, a1i, b1r, b1i = e1
        a2r, a2i, b2r, b2i = e2
        return (a2r * a1r - a2i * a1i,
                a2r * a1i + a2i * a1r,
                a2r * b1r - a2i * b1i + b2r,
                a2r * b1i + a2i * b1r + b2i)

    _, _, xr, xi = lax.associative_scan(combine, (a_full_re, a_full_im, bu_re, bu_im), axis=1)
    y = (jnp.einsum('bsgp,gcp->bsgc', xr, c_re.astype(f32))
         - jnp.einsum('bsgp,gcp->bsgc', xi, c_im.astype(f32))
         + d_skip.astype(f32).reshape(S5_GROUPS, S5_GROUP) * uf)
    y = jax.nn.gelu(y.reshape(b_, s_, S5_WIDTH))
    zg = jnp.einsum('bsw,wv->bsv', y, w_glu.astype(f32))
    return zg[..., :S5_WIDTH] * jax.nn.sigmoid(zg[..., S5_WIDTH:])


def fox_mixer(q, k, v, f_logit):
    b_, s_, _ = q.shape
    f32 = jnp.float32
    nb = s_ // Q_BLOCK

    def heads(t):
        return t.astype(f32).reshape(b_, s_, FOX_HEADS, FOX_DH).transpose(0, 2, 1, 3)

    qh, kh, vh = heads(q), heads(k), heads(v)
    c = jnp.cumsum(jax.nn.log_sigmoid(f_logit.astype(f32)), axis=1).transpose(0, 2, 1)
    pos = jnp.arange(s_)
    scale = FOX_DH ** -0.5
    q_blocks = qh.reshape(b_, FOX_HEADS, nb, Q_BLOCK, FOX_DH).transpose(2, 0, 1, 3, 4)
    c_blocks = c.reshape(b_, FOX_HEADS, nb, Q_BLOCK).transpose(2, 0, 1, 3)
    pos_blocks = pos.reshape(nb, Q_BLOCK)

    def block(args):
        qb, cb, pb = args
        s = (jnp.einsum('bhtd,bhsd->bhts', qb, kh) * scale
             + cb[..., None] - c[:, :, None, :])
        s = jnp.where(pb[:, None] >= pos[None, :], s, -jnp.inf)
        p = jax.nn.softmax(s, axis=-1)
        return jnp.einsum('bhts,bhsd->bhtd', p, vh)

    o = lax.map(block, (q_blocks, c_blocks, pos_blocks))
    return o.transpose(1, 0, 3, 2, 4).reshape(b_, s_, FOX_WIDTH)


def hybrid_layer(x, norm_g, w_in, b_gate, fox_bf, lb, hg_norm_g,
                 s5_a_re, s5_a_im, s5_log_dt, s5_b_re, s5_b_im, s5_c_re, s5_c_im,
                 s5_d, s5_w_glu, w_br_a, w_br_b, w_br_c, w_out):
    b_, s_, _ = x.shape
    dt = x.dtype
    h = rms_norm(x, norm_g)
    z = jnp.einsum('bsd,de->bse', h, w_in)
    (hq, hf, hi, hgate, su, sgate, fq, fk, fv, ff, fgate, mg) = split_columns(z)

    o_a = hgrn2_mixer(hq, hf, hi, lb)
    o_a = o_a * lax.rsqrt(jnp.mean(o_a * o_a, axis=-1, keepdims=True) + EPS)
    o_a = o_a.reshape(b_, s_, HG_VWIDTH) * hg_norm_g.astype(jnp.float32)
    o_a = (o_a * jax.nn.silu(hgate.astype(jnp.float32))).astype(dt)

    o_b = s5_mixer(su, s5_a_re, s5_a_im, s5_log_dt, s5_b_re, s5_b_im,
                   s5_c_re, s5_c_im, s5_d, s5_w_glu)
    o_b = (o_b * jax.nn.silu(sgate.astype(jnp.float32))).astype(dt)

    o_c = fox_mixer(fq, fk, fv, ff + fox_bf)
    o_c = (o_c * jax.nn.silu(fgate.astype(jnp.float32))).astype(dt)

    gates = jax.nn.sigmoid((mg + b_gate).astype(jnp.float32)).reshape(b_, s_, N_BRANCH, D_MODEL)
    merged = (gates[:, :, 0] * jnp.einsum('bsw,wd->bsd', o_a, w_br_a).astype(jnp.float32)
              + gates[:, :, 1] * jnp.einsum('bsw,wd->bsd', o_b, w_br_b).astype(jnp.float32)
              + gates[:, :, 2] * jnp.einsum('bsw,wd->bsd', o_c, w_br_c).astype(jnp.float32))
    return x + jnp.einsum('bsd,de->bse', merged.astype(dt), w_out).astype(dt)


def setup_inputs(seed: int = 0) -> dict:
    key = jax.random.key(seed)
    ks = jax.random.split(key, 24)
    f32 = jnp.float32
    nrm = lambda k, shape, s: jax.random.normal(k, shape, f32) * s
    n_idx = jnp.arange(S5_STATE, dtype=f32)
    return {
        'x': nrm(ks[0], (BATCH, SEQ, D_MODEL), 1.0),
        'norm_g': 1.0 + nrm(ks[1], (DEPTH, D_MODEL), 0.02),
        'w_in': nrm(ks[2], (DEPTH, D_MODEL, IN_WIDTH), D_MODEL ** -0.5),
        'b_gate': nrm(ks[3], (DEPTH, N_BRANCH * D_MODEL), 0.02),
        'fox_bf': jax.random.uniform(ks[4], (DEPTH, FOX_HEADS), f32, 1.0, 4.0),
        'hg_lb': nrm(ks[5], (DEPTH, HG_WIDTH), 0.1),
        'hg_norm_g': 1.0 + nrm(ks[6], (DEPTH, HG_VWIDTH), 0.02),
        's5_a_re': -0.5 + nrm(ks[7], (DEPTH, S5_GROUPS, S5_STATE), 0.01),
        's5_a_im': math.pi * n_idx + nrm(ks[8], (DEPTH, S5_GROUPS, S5_STATE), 0.01),
        's5_log_dt': jax.random.uniform(ks[9], (DEPTH, S5_GROUPS), f32, math.log(1e-3), math.log(1e-1)),
        's5_b_re': nrm(ks[10], (DEPTH, S5_GROUPS, S5_STATE, S5_GROUP), (2 * S5_GROUP) ** -0.5),
        's5_b_im': nrm(ks[11], (DEPTH, S5_GROUPS, S5_STATE, S5_GROUP), (2 * S5_GROUP) ** -0.5),
        's5_c_re': nrm(ks[12], (DEPTH, S5_GROUPS, S5_GROUP, S5_STATE), (2 * S5_STATE) ** -0.5),
        's5_c_im': nrm(ks[13], (DEPTH, S5_GROUPS, S5_GROUP, S5_STATE), (2 * S5_STATE) ** -0.5),
        's5_d': nrm(ks[14], (DEPTH, S5_WIDTH), 1.0),
        's5_w_glu': nrm(ks[15], (DEPTH, S5_WIDTH, 2 * S5_WIDTH), S5_WIDTH ** -0.5),
        'w_br_a': nrm(ks[16], (DEPTH, HG_VWIDTH, D_MODEL), HG_VWIDTH ** -0.5),
        'w_br_b': nrm(ks[17], (DEPTH, S5_WIDTH, D_MODEL), S5_WIDTH ** -0.5),
        'w_br_c': nrm(ks[18], (DEPTH, FOX_WIDTH, D_MODEL), FOX_WIDTH ** -0.5),
        'w_out': nrm(ks[19], (DEPTH, D_MODEL, D_MODEL), D_MODEL ** -0.5),
        'final_g': 1.0 + nrm(ks[20], (D_MODEL,), 0.02),
    }


def reference(x, norm_g, w_in, b_gate, fox_bf, hg_lb, hg_norm_g, s5_a_re, s5_a_im,
              s5_log_dt, s5_b_re, s5_b_im, s5_c_re, s5_c_im, s5_d, s5_w_glu,
              w_br_a, w_br_b, w_br_c, w_out, final_g):
    lbs = hgrn_lower_bounds(hg_lb)
    for l in range(DEPTH):
        x = hybrid_layer(x, norm_g[l], w_in[l], b_gate[l], fox_bf[l], lbs[l], hg_norm_g[l],
                         s5_a_re[l], s5_a_im[l], s5_log_dt[l], s5_b_re[l], s5_b_im[l],
                         s5_c_re[l], s5_c_im[l], s5_d[l], s5_w_glu[l],
                         w_br_a[l], w_br_b[l], w_br_c[l], w_out[l])
    return rms_norm(x, final_g)
```

```cpp
#include <hip/hip_runtime.h>
#include <hip/hip_cooperative_groups.h>
#include <cstdint>
#include <cstdio>
namespace cg = cooperative_groups;

typedef unsigned short bf16_t;
typedef short bf16x8 __attribute__((ext_vector_type(8)));
typedef short s16x4 __attribute__((ext_vector_type(4)));
typedef float f32x4 __attribute__((ext_vector_type(4)));
typedef float f32x2 __attribute__((ext_vector_type(2)));
typedef float f32x16 __attribute__((ext_vector_type(16)));
typedef unsigned u32x4 __attribute__((ext_vector_type(4)));
typedef unsigned u32x2 __attribute__((ext_vector_type(2)));

#ifndef SINGLE_LAUNCH
#define SINGLE_LAUNCH 1
#endif

constexpr int S = 8192, DM = 2048, INW = 16392, NZ = 16384, HW = 1024;
constexpr int NTHREADS = 512;
constexpr int LDS_BYTES = 133120;
constexpr float EPS = 1e-6f;
constexpr int SL = 32, NCH = S / SL;

struct P {
  const float *x, *norm_g, *w_in, *b_gate, *fox_bf, *hg_lb, *hg_norm_g, *a_re, *a_im, *log_dt, *b_re, *b_im, *c_re, *c_im,
      *s5_d, *w_glu, *w_a, *w_b, *w_c, *w_out, *final_g;
  float* out;
  bf16_t *WinT, *WgluT, *WbrT, *WoutT, *Ktab, *M1, *M2;
  float* AL;
  float* xbuf; bf16_t* h; float* lsf; float* cc;
  bf16_t* zb; float* logf; bf16_t* gates;
  float* oin; bf16_t* qd; float* SlocT; float* elast; bf16_t* SprevT;
  float* Xloc; bf16_t* Xprev; bf16_t* yg;
  bf16_t *oa, *ob, *oc, *m;
};

__device__ __forceinline__ unsigned cvtpk(float lo, float hi) { unsigned r; asm("v_cvt_pk_bf16_f32 %0, %1, %2" : "=v"(r) : "v"(lo), "v"(hi)); return r; }
__device__ __forceinline__ bf16_t f2bf(float v) { return (bf16_t)(cvtpk(v, 0.f) & 0xffffu); }
__device__ __forceinline__ float bf2f(bf16_t h) { return __uint_as_float(((unsigned)h) << 16); }
__device__ __forceinline__ float bflo(unsigned u) { return __uint_as_float(u << 16); }
__device__ __forceinline__ float bfhi(unsigned u) { return __uint_as_float(u & 0xffff0000u); }
__device__ __forceinline__ float sigmoidf_(float x) { return 1.f / (1.f + __expf(-x)); }
__device__ __forceinline__ float siluf_(float x) { return x * sigmoidf_(x); }
__device__ __forceinline__ float logsigf_(float x) { return fminf(x, 0.f) - log1pf(__expf(-fabsf(x))); }
__device__ __forceinline__ float gelu_tanh(float y) { const float u = 0.7978845608028654f * (y + 0.044715f * y * y * y); return 0.5f * y * (1.f + tanhf(u)); }
__device__ __forceinline__ int otid() { int t = threadIdx.x; asm volatile("" : "+v"(t)); return t; }
__device__ __forceinline__ f32x4 mfma16(bf16x8 a, bf16x8 b, f32x4 c) { return __builtin_amdgcn_mfma_f32_16x16x32_bf16(a, b, c, 0, 0, 0); }
__device__ __forceinline__ float wave_sum(float v) {
#pragma unroll
  for (int o = 32; o >= 1; o >>= 1) v += __shfl_xor(v, o);
  return v;
}
__device__ __forceinline__ bf16x8 pack8f(const float* v) {
  u32x4 w = {cvtpk(v[0], v[1]), cvtpk(v[2], v[3]), cvtpk(v[4], v[5]), cvtpk(v[6], v[7])};
  return *reinterpret_cast<bf16x8*>(&w);
}

template <int NT> __device__ __forceinline__ int ncol(int nt) { return NT == 4 ? ((nt >> 1) * 128 + (nt & 1) * 16) : nt * 16; }

template <int NT>
__device__ __forceinline__ void gemm_main(f32x4 (&acc)[8][NT], const bf16_t* __restrict__ A, int lda, const bf16_t* __restrict__ Bt, int ldb, int K, char* lds) {
  constexpr int BN = NT * 64;
  constexpr int BUF = 32768 + BN * 128;
  const int tid = otid(), lane = tid & 63, wid = tid >> 6, wr = wid >> 2, wc = wid & 3, fr = lane & 15, fq = lane >> 4;
  const int lrow = tid >> 3, lch = tid & 7;
  const bf16_t* ga = A + (size_t)lrow * lda + lch * 8;
  const bf16_t* gb = Bt + (size_t)lrow * ldb + lch * 8;
  const int wofs = lrow * 128 + ((lch ^ (lrow & 7)) << 4);
  u32x4 ra[4], rb[NT];
#pragma unroll
  for (int i = 0; i < 4; ++i) ra[i] = *(const u32x4*)(ga + (size_t)i * 64 * lda);
#pragma unroll
  for (int i = 0; i < NT; ++i) rb[i] = *(const u32x4*)(gb + (size_t)i * 64 * ldb);
#pragma unroll
  for (int i = 0; i < 4; ++i) *(u32x4*)(lds + wofs + i * 8192) = ra[i];
#pragma unroll
  for (int i = 0; i < NT; ++i) *(u32x4*)(lds + 32768 + wofs + i * 8192) = rb[i];
  __syncthreads();
  const int nk = K >> 6;
  const int a0 = (wr * 128 + fr) * 128 + ((fq ^ (fr & 7)) << 4);
  const int a1 = (wr * 128 + fr) * 128 + (((4 + fq) ^ (fr & 7)) << 4);
  const int b0 = 32768 + (wc * 32 + fr) * 128 + ((fq ^ (fr & 7)) << 4);
  const int b1 = 32768 + (wc * 32 + fr) * 128 + (((4 + fq) ^ (fr & 7)) << 4);
  for (int kt = 0; kt < nk; ++kt) {
    const char* buf = lds + (kt & 1) * BUF;
    const bool more = kt + 1 < nk;
    if (more) {
      ga += 64; gb += 64;
#pragma unroll
      for (int i = 0; i < 4; ++i) ra[i] = *(const u32x4*)(ga + (size_t)i * 64 * lda);
#pragma unroll
      for (int i = 0; i < NT; ++i) rb[i] = *(const u32x4*)(gb + (size_t)i * 64 * ldb);
    }
    {
      bf16x8 af[8], bfr[NT];
#pragma unroll
      for (int m = 0; m < 8; ++m) af[m] = *(const bf16x8*)(buf + a0 + m * 2048);
#pragma unroll
      for (int nt = 0; nt < NT; ++nt) bfr[nt] = *(const bf16x8*)(buf + b0 + ncol<NT>(nt) * 128);
#pragma unroll
      for (int m = 0; m < 8; ++m)
#pragma unroll
        for (int nt = 0; nt < NT; ++nt) acc[m][nt] = mfma16(bfr[nt], af[m], acc[m][nt]);
    }
    {
      bf16x8 af[8], bfr[NT];
#pragma unroll
      for (int m = 0; m < 8; ++m) af[m] = *(const bf16x8*)(buf + a1 + m * 2048);
#pragma unroll
      for (int nt = 0; nt < NT; ++nt) bfr[nt] = *(const bf16x8*)(buf + b1 + ncol<NT>(nt) * 128);
#pragma unroll
      for (int m = 0; m < 8; ++m)
#pragma unroll
        for (int nt = 0; nt < NT; ++nt) acc[m][nt] = mfma16(bfr[nt], af[m], acc[m][nt]);
    }
    if (more) {
      char* nb = lds + ((kt + 1) & 1) * BUF;
#pragma unroll
      for (int i = 0; i < 4; ++i) *(u32x4*)(nb + wofs + i * 8192) = ra[i];
#pragma unroll
      for (int i = 0; i < NT; ++i) *(u32x4*)(nb + 32768 + wofs + i * 8192) = rb[i];
    }
    __syncthreads();
  }
}

template <int NT> __device__ __forceinline__ void zero_acc(f32x4 (&acc)[8][NT]) {
#pragma unroll
  for (int m = 0; m < 8; ++m)
#pragma unroll
    for (int nt = 0; nt < NT; ++nt) acc[m][nt] = (f32x4){0.f, 0.f, 0.f, 0.f};
}

__device__ void tr_tile(const float* __restrict__ src, int ld_src, int k0, int n_src0, bf16_t* __restrict__ dst, int ld_dst, int n_dst0, char* lds) {
  float* t = (float*)lds;
  const int tid = otid();
  {
    const int r = tid >> 4, c4 = (tid & 15) * 4;
#pragma unroll
    for (int i = 0; i < 2; ++i) {
      const int k = r + 32 * i;
      const f32x4 v = *(const f32x4*)(src + (size_t)(k0 + k) * ld_src + n_src0 + c4);
      t[k * 65 + c4 + 0] = v[0]; t[k * 65 + c4 + 1] = v[1]; t[k * 65 + c4 + 2] = v[2]; t[k * 65 + c4 + 3] = v[3];
    }
  }
  __syncthreads();
  {
    const int n = tid >> 3, k8 = (tid & 7) * 8;
    float v[8];
#pragma unroll
    for (int j = 0; j < 8; ++j) v[j] = t[(k8 + j) * 65 + n];
    *(bf16x8*)(dst + (size_t)(n_dst0 + n) * ld_dst + k0 + k8) = pack8f(v);
  }
  __syncthreads();
}

__device__ void s5_tables(const P& p, int unit, char* lds) {
  const int l = unit >> 6, g = unit & 63, lg = l * 64 + g, tid = threadIdx.x;
  f32x2* pw = (f32x2*)lds;
  f32x2* bb = (f32x2*)(lds + 17408);
  f32x2* cw = (f32x2*)(lds + 25600);
  const float dtf = expf(p.log_dt[lg]);
#pragma unroll 1
  for (int idx = tid; idx < 64 * 33; idx += NTHREADS) {
    const int pp = idx / 33, j = idx - pp * 33;
    const float ar = p.a_re[lg * 64 + pp], ai = p.a_im[lg * 64 + pp];
    double rev = (double)ai * (double)dtf * (double)j * 0.15915494309189535;
    rev -= rint(rev);
    const float mag = expf(ar * dtf * (float)j);
    const float rf = (float)rev;
    pw[pp * 34 + j] = (f32x2){mag * __builtin_amdgcn_cosf(rf), mag * __builtin_amdgcn_sinf(rf)};
  }
#pragma unroll 1
  for (int idx = tid; idx < 1024; idx += NTHREADS) {
    const int pp = idx >> 4, c = idx & 15;
    const float ar = p.a_re[lg * 64 + pp], ai = p.a_im[lg * 64 + pp];
    double rev = (double)ai * (double)dtf * 0.15915494309189535;
    rev -= rint(rev);
    const float mag = expf(ar * dtf), rf = (float)rev;
    const float abr = mag * __builtin_amdgcn_cosf(rf), abi = mag * __builtin_amdgcn_sinf(rf);
    const float nr = abr - 1.f, den = ar * ar + ai * ai;
    const float zr = (nr * ar + abi * ai) / den, zi = (abi * ar - nr * ai) / den;
    const float br = p.b_re[(size_t)(lg * 64 + pp) * 16 + c], bi = p.b_im[(size_t)(lg * 64 + pp) * 16 + c];
    bb[idx] = (f32x2){zr * br - zi * bi, zr * bi + zi * br};
    const int c2 = idx >> 6, p2 = idx & 63;
    cw[idx] = (f32x2){p.c_re[(size_t)(lg * 16 + c2) * 64 + p2], p.c_im[(size_t)(lg * 16 + c2) * 64 + p2]};
  }
  __syncthreads();
#pragma unroll 1
  for (int idx = tid; idx < 32 * 256; idx += NTHREADS) {
    const int d = idx >> 8, c = (idx >> 4) & 15, c1 = idx & 15;
    float sum = 0.f;
#pragma unroll 4
    for (int pp = 0; pp < 64; ++pp) {
      const f32x2 w = pw[pp * 34 + d], b = bb[pp * 16 + c1], cv = cw[c * 64 + pp];
      const float tr = w[0] * b[0] - w[1] * b[1], ti = w[0] * b[1] + w[1] * b[0];
      sum += cv[0] * tr - cv[1] * ti;
    }
    p.Ktab[(size_t)(lg * 32 + d) * 256 + c * 16 + c1] = f2bf(sum);
  }
#pragma unroll 2
  for (int idx = tid; idx < 128 * 512; idx += NTHREADS) {
    const int pr = idx >> 9, col = idx & 511, s = col >> 4, c1 = col & 15, pp = pr & 63, im = pr >> 6;
    const f32x2 w = pw[pp * 34 + (SL - 1 - s)], b = bb[pp * 16 + c1];
    const float tr = w[0] * b[0] - w[1] * b[1], ti = w[0] * b[1] + w[1] * b[0];
    p.M1[(size_t)(lg * 128 + pr) * 512 + col] = f2bf(im ? ti : tr);
  }
#pragma unroll 2
  for (int idx = tid; idx < 512 * 128; idx += NTHREADS) {
    const int row = idx >> 7, pr = idx & 127, t = row >> 4, c = row & 15, pp = pr & 63, im = pr >> 6;
    const f32x2 w = pw[pp * 34 + t + 1], cv = cw[c * 64 + pp];
    const float tr = cv[0] * w[0] - cv[1] * w[1], ti = cv[0] * w[1] + cv[1] * w[0];
    p.M2[(size_t)(lg * 512 + row) * 128 + pr] = f2bf(im ? -ti : tr);
  }
  if (tid < 64) { const f32x2 w = pw[tid * 34 + SL]; p.AL[(lg * 64 + tid) * 2] = w[0]; p.AL[(lg * 64 + tid) * 2 + 1] = w[1]; }
  __syncthreads();
}

__device__ void phase_prep(const P& p, char* lds) {
  constexpr int NU = 128 + 16384 + 1024 + 3072 + 2048;
  for (int u0 = blockIdx.x; u0 < NU; u0 += gridDim.x) {
    int u = u0;
    if (u < 128) { s5_tables(p, u, lds); continue; }
    u -= 128;
    if (u < 16384) {
      const int l = u >> 13, rem = u & 8191, kt = rem >> 8, ntile = rem & 255, n0 = ntile * 64;
      tr_tile(p.w_in + (size_t)l * DM * INW, INW, kt * 64, n0 + (n0 >= 9216 ? 8 : 0), p.WinT + (size_t)l * NZ * DM, DM, n0, lds);
      continue;
    }
    u -= 16384;
    if (u < 1024) {
      const int l = u >> 9, rem = u & 511, kt = rem >> 5, ntile = rem & 31, n0 = ntile * 64;
      const int j = n0 >> 8, within = n0 & 255, half = within >> 7, idx = within & 127;
      tr_tile(p.w_glu + (size_t)l * HW * 2048, 2048, kt * 64, half * 1024 + j * 128 + idx, p.WgluT + (size_t)l * 2048 * HW, HW, n0, lds);
      continue;
    }
    u -= 1024;
    if (u < 3072) {
      const int mat = u >> 9, rem = u & 511, kt = rem >> 5, ntile = rem & 31, l = mat / 3, br = mat - l * 3;
      const float* src = (br == 0 ? p.w_a : br == 1 ? p.w_b : p.w_c) + (size_t)l * HW * DM;
      tr_tile(src, DM, kt * 64, ntile * 64, p.WbrT + (size_t)mat * DM * HW, HW, ntile * 64, lds);
      continue;
    }
    u -= 3072;
    {
      const int l = u >> 10, rem = u & 1023, kt = rem >> 5, ntile = rem & 31;
      tr_tile(p.w_out + (size_t)l * DM * DM, DM, kt * 64, ntile * 64, p.WoutT + (size_t)l * DM * DM, DM, ntile * 64, lds);
    }
  }
}

__device__ void phase_norm(const P& p, int l, char* lds) {
  const float* xin = l == 0 ? p.x : p.xbuf;
  const int tid = otid(), lane = tid & 63, wid = tid >> 6;
  f32x4* wff = (f32x4*)lds;
  const float* wl = p.w_in + (size_t)l * DM * INW;
#pragma unroll
  for (int i = 0; i < 8; ++i) { const int idx = tid + NTHREADS * i, k = idx >> 1, hf = idx & 1; wff[idx] = *(const f32x4*)(wl + (size_t)k * INW + 9216 + hf * 4); }
  __syncthreads();
  const float* g = p.norm_g + l * DM;
  for (int row = blockIdx.x * 8 + wid; row < S; row += gridDim.x * 8) {
    const float* xr = xin + (size_t)row * DM;
    f32x4 xv[8];
    float ss = 0.f;
#pragma unroll
    for (int j = 0; j < 8; ++j) { xv[j] = *(const f32x4*)(xr + (lane + 64 * j) * 4); ss += xv[j][0] * xv[j][0] + xv[j][1] * xv[j][1] + xv[j][2] * xv[j][2] + xv[j][3] * xv[j][3]; }
    ss = wave_sum(ss);
    const float rstd = rsqrtf(ss * (1.f / DM) + EPS);
    float fa[8] = {0.f, 0.f, 0.f, 0.f, 0.f, 0.f, 0.f, 0.f};
#pragma unroll
    for (int j = 0; j < 8; ++j) {
      const int c = (lane + 64 * j) * 4;
      const f32x4 gv = *(const f32x4*)(g + c);
      float hv[4];
#pragma unroll
      for (int e = 0; e < 4; ++e) hv[e] = xv[j][e] * rstd * gv[e];
      u32x2 o = {cvtpk(hv[0], hv[1]), cvtpk(hv[2], hv[3])};
      *(u32x2*)(p.h + (size_t)row * DM + c) = o;
#pragma unroll
      for (int e = 0; e < 4; ++e) {
        const f32x4 w0 = wff[(c + e) * 2], w1 = wff[(c + e) * 2 + 1];
        fa[0] += hv[e] * w0[0]; fa[1] += hv[e] * w0[1]; fa[2] += hv[e] * w0[2]; fa[3] += hv[e] * w0[3];
        fa[4] += hv[e] * w1[0]; fa[5] += hv[e] * w1[1]; fa[6] += hv[e] * w1[2]; fa[7] += hv[e] * w1[3];
      }
    }
#pragma unroll
    for (int j = 0; j < 8; ++j) fa[j] = wave_sum(fa[j]);
    if (lane == 0) {
#pragma unroll
      for (int j = 0; j < 8; ++j) p.lsf[row * 8 + j] = logsigf_(fa[j] + p.fox_bf[l * 8 + j]);
    }
  }
  __syncthreads();
}

__device__ void phase_final_norm(const P& p) {
  const int tid = otid(), lane = tid & 63, wid = tid >> 6;
  for (int row = blockIdx.x * 8 + wid; row < S; row += gridDim.x * 8) {
    const float* xr = p.xbuf + (size_t)row * DM;
    f32x4 xv[8];
    float ss = 0.f;
#pragma unroll
    for (int j = 0; j < 8; ++j) { xv[j] = *(const f32x4*)(xr + (lane + 64 * j) * 4); ss += xv[j][0] * xv[j][0] + xv[j][1] * xv[j][1] + xv[j][2] * xv[j][2] + xv[j][3] * xv[j][3]; }
    ss = wave_sum(ss);
    const float rstd = rsqrtf(ss * (1.f / DM) + EPS);
#pragma unroll
    for (int j = 0; j < 8; ++j) {
      const int c = (lane + 64 * j) * 4;
      const f32x4 gv = *(const f32x4*)(p.final_g + c);
      f32x4 o;
#pragma unroll
      for (int e = 0; e < 4; ++e) o[e] = xv[j][e] * rstd * gv[e];
      *(f32x4*)(p.out + (size_t)row * DM + c) = o;
    }
  }
}

__device__ void phase_gemm_in(const P& p, int l, char* lds) {
  const int tid = otid(), lane = tid & 63, wid = tid >> 6, wr = wid >> 2, wc = wid & 3, fr = lane & 15, fq = lane >> 4;
  for (int t = blockIdx.x; t < 32 * 64; t += gridDim.x) {
    const int pm = t & 31, pn = t >> 5;
    f32x4 acc[8][4];
    zero_acc<4>(acc);
    gemm_main<4>(acc, p.h + (size_t)pm * 256 * DM, DM, p.WinT + ((size_t)l * NZ + (size_t)pn * 256) * DM, DM, DM, lds);
    const int region = pn >> 2;
    const int row0 = pm * 256 + wr * 128 + fr;
    const int cbase = (pn & 3) * 256 + wc * 32 + 4 * fq;
    if (region == 1) {
#pragma unroll
      for (int nt = 0; nt < 4; ++nt) {
        const int c = cbase + ncol<4>(nt);
        float lb[4], la[4], l1m[4];
#pragma unroll
        for (int e = 0; e < 4; ++e) {
          lb[e] = l == 0 ? 0.f : sigmoidf_(p.hg_lb[HW + c + e] - p.hg_lb[c + e]);
          la[e] = l == 0 ? -1e30f : __logf(lb[e]);
          l1m[e] = l == 0 ? 0.f : __logf(1.f - lb[e]);
        }
#pragma unroll
        for (int m = 0; m < 8; ++m) {
          const int row = row0 + m * 16;
          f32x4 lf; float kk[4];
#pragma unroll
          for (int e = 0; e < 4; ++e) {
            const float z = acc[m][nt][e];
            const float ez = __expf(-fabsf(z));
            const float ls = fminf(z, 0.f) - __logf(1.f + ez);
            const float b = l1m[e] + ls, a = la[e], mx = fmaxf(a, b);
            lf[e] = mx + __logf(1.f + __expf(-fabsf(a - b)));
            const float sneg = (z >= 0.f ? ez : 1.f) / (1.f + ez);
            kk[e] = (1.f - lb[e]) * sneg;
          }
          *(f32x4*)(p.logf + (size_t)row * HW + c) = lf;
          u32x2 o = {cvtpk(kk[0], kk[1]), cvtpk(kk[2], kk[3])};
          *(u32x2*)(p.zb + (size_t)1 * S * HW + (size_t)row * HW + c) = o;
        }
      }
    } else if (region < 10) {
      const bool act = (region == 3 || region == 5 || region == 9);
      bf16_t* dst = p.zb + (size_t)region * S * HW;
#pragma unroll
      for (int m = 0; m < 8; ++m)
#pragma unroll
        for (int nt = 0; nt < 4; ++nt) {
          const int row = row0 + m * 16, c = cbase + ncol<4>(nt);
          f32x4 v = acc[m][nt];
          if (act) {
#pragma unroll
            for (int e = 0; e < 4; ++e) v[e] = siluf_(v[e]);
          }
          u32x2 o = {cvtpk(v[0], v[1]), cvtpk(v[2], v[3])};
          *(u32x2*)(dst + (size_t)row * HW + c) = o;
        }
    } else {
      const int gc0 = (pn - 40) * 256 + wc * 32 + 4 * fq;
#pragma unroll
      for (int nt = 0; nt < 4; ++nt) {
        const int c = gc0 + ncol<4>(nt);
        const f32x4 bg = *(const f32x4*)(p.b_gate + (size_t)l * 6144 + c);
#pragma unroll
        for (int m = 0; m < 8; ++m) {
          const int row = row0 + m * 16;
          f32x4 v = acc[m][nt];
#pragma unroll
          for (int e = 0; e < 4; ++e) v[e] = sigmoidf_(v[e] + bg[e]);
          u32x2 o = {cvtpk(v[0], v[1]), cvtpk(v[2], v[3])};
          *(u32x2*)(p.gates + (size_t)row * 6144 + c) = o;
        }
      }
    }
  }
}

__device__ __forceinline__ int swz128(int row, int col_elem) {
  return row * 128 + ((((col_elem >> 3) ^ (row & 7))) << 4) + (col_elem & 7) * 2;
}
__device__ __forceinline__ int swz256(int row, int col_elem) {
  return row * 256 + ((((col_elem >> 3) ^ (row & 7))) << 4) + (col_elem & 7) * 2;
}

__device__ void hg_local(const P& p, int unit, char* lds) {
  const int hh = unit >> 7, n = unit & 127, tok0 = n * 64, colh = hh * 128;
  const int tid = otid(), lane = tid & 63, wid = tid >> 6, fr = lane & 15, fq = lane >> 4;
  float* cum = (float*)lds;
  char* qe = lds + 32768; char* ke = lds + 49152; char* kdT = lds + 65536; char* iT = lds + 81920; char* sc = lds + 98304;
  const bf16_t* hq = p.zb; const bf16_t* hk = p.zb + (size_t)1 * S * HW; const bf16_t* hi = p.zb + (size_t)2 * S * HW;
#pragma unroll
  for (int i = 0; i < 4; ++i) { const int id = tid + NTHREADS * i, t = id >> 5, c4 = (id & 31) * 4;
    *(f32x4*)(cum + t * 128 + c4) = *(const f32x4*)(p.logf + (size_t)(tok0 + t) * HW + colh + c4); }
  __syncthreads();
  {
    const int k = tid & 127, part = tid >> 7;
    float run = 0.f;
    for (int t = 16 * part; t < 16 * part + 16; ++t) { run += cum[t * 128 + k]; cum[t * 128 + k] = run; }
    __syncthreads();
    float off = 0.f;
    for (int pp = 0; pp < part; ++pp) off += cum[(16 * pp + 15) * 128 + k];
    __syncthreads();
    if (part) for (int t = 16 * part; t < 16 * part + 16; ++t) cum[t * 128 + k] += off;
  }
  __syncthreads();
#pragma unroll
  for (int i = 0; i < 2; ++i) {
    const int id = tid + NTHREADS * i, t = id >> 4, k0 = (id & 15) * 8;
    const size_t gofs = (size_t)(tok0 + t) * HW + colh + k0;
    const u32x4 q8 = *(const u32x4*)(hq + gofs), k8 = *(const u32x4*)(hk + gofs), i8 = *(const u32x4*)(hi + gofs);
    float qv[8], kv[8], iv[8], c8[8], r8[8], l8[8];
#pragma unroll
    for (int j = 0; j < 4; ++j) { qv[2 * j] = bflo(q8[j]); qv[2 * j + 1] = bfhi(q8[j]); kv[2 * j] = bflo(k8[j]); kv[2 * j + 1] = bfhi(k8[j]); iv[2 * j] = bflo(i8[j]); iv[2 * j + 1] = bfhi(i8[j]); }
#pragma unroll
    for (int j = 0; j < 8; ++j) { c8[j] = cum[t * 128 + k0 + j]; r8[j] = cum[31 * 128 + k0 + j]; l8[j] = cum[63 * 128 + k0 + j]; }
    float qe8[8], ke8[8], qd8[8];
#pragma unroll
    for (int j = 0; j < 8; ++j) {
      qe8[j] = qv[j] * __expf(c8[j] - r8[j]);
      ke8[j] = kv[j] * __expf(r8[j] - c8[j]);
      qd8[j] = qv[j] * __expf(c8[j]);
      const float kd = kv[j] * __expf(l8[j] - c8[j]);
      *(bf16_t*)(kdT + swz128(k0 + j, t)) = f2bf(kd);
      *(bf16_t*)(iT + swz128(k0 + j, t)) = (bf16_t)((j & 1) ? (i8[j >> 1] >> 16) : (i8[j >> 1] & 0xffffu));
    }
    *(bf16x8*)(qe + swz256(t, k0)) = pack8f(qe8);
    *(bf16x8*)(ke + swz256(t, k0)) = pack8f(ke8);
    *(bf16x8*)(p.qd + gofs) = pack8f(qd8);
  }
  if (tid < 128) p.elast[(size_t)(hh * 128 + n) * 128 + tid] = __expf(cum[63 * 128 + tid]);
  __syncthreads();
  {
    const int tt = wid >> 1;
#pragma unroll
    for (int e = 0; e < 2; ++e) {
      const int st = (wid & 1) * 2 + e;
      f32x4 a = {0.f, 0.f, 0.f, 0.f};
      if (st <= tt) {
#pragma unroll
        for (int kk = 0; kk < 4; ++kk) {
          const bf16x8 X = *(const bf16x8*)(ke + swz256(st * 16 + fr, kk * 32 + fq * 8));
          const bf16x8 Y = *(const bf16x8*)(qe + swz256(tt * 16 + fr, kk * 32 + fq * 8));
          a = mfma16(X, Y, a);
        }
      }
      const int t = tt * 16 + fr, s0 = st * 16 + 4 * fq;
#pragma unroll
      for (int r = 0; r < 4; ++r) if (s0 + r > t) a[r] = 0.f;
      u32x2 o = {cvtpk(a[0], a[1]), cvtpk(a[2], a[3])};
      *(u32x2*)(sc + swz128(t, s0)) = o;
    }
  }
  __syncthreads();
  {
    const int tt = wid & 3;
#pragma unroll
    for (int e = 0; e < 4; ++e) {
      const int vt = (wid >> 2) * 4 + e;
      f32x4 a = {0.f, 0.f, 0.f, 0.f};
#pragma unroll
      for (int kk = 0; kk < 2; ++kk) {
        const bf16x8 X = *(const bf16x8*)(iT + swz128(vt * 16 + fr, kk * 32 + fq * 8));
        const bf16x8 Y = *(const bf16x8*)(sc + swz128(tt * 16 + fr, kk * 32 + fq * 8));
        a = mfma16(X, Y, a);
      }
      *(f32x4*)(p.oin + (size_t)(tok0 + tt * 16 + fr) * HW + colh + vt * 16 + 4 * fq) = a;
    }
  }
  {
    const int vt = wid;
#pragma unroll
    for (int kt = 0; kt < 8; ++kt) {
      f32x4 a = {0.f, 0.f, 0.f, 0.f};
#pragma unroll
      for (int kk = 0; kk < 2; ++kk) {
        const bf16x8 X = *(const bf16x8*)(kdT + swz128(kt * 16 + fr, kk * 32 + fq * 8));
        const bf16x8 Y = *(const bf16x8*)(iT + swz128(vt * 16 + fr, kk * 32 + fq * 8));
        a = mfma16(X, Y, a);
      }
      *(f32x4*)(p.SlocT + ((size_t)(hh * 128 + n) * 128 + vt * 16 + fr) * 128 + kt * 16 + 4 * fq) = a;
    }
  }
  __syncthreads();
}

__device__ void s5_local(const P& p, int l, int unit) {
  const int g = unit >> 1, half = unit & 1;
  const int tid = otid(), lane = tid & 63, wid = tid >> 6, fr = lane & 15, fq = lane >> 4;
  const int cb = half * 8 + wid, n = 16 * cb + fr;
  const bf16_t* su = p.zb + (size_t)4 * S * HW;
  const bf16_t* M1 = p.M1 + (size_t)(l * 64 + g) * 128 * 512;
  f32x4 acc[8];
#pragma unroll
  for (int i = 0; i < 8; ++i) acc[i] = (f32x4){0.f, 0.f, 0.f, 0.f};
#pragma unroll 4
  for (int kk = 0; kk < 16; ++kk) {
    const int s = 2 * kk + (fq >> 1);
    const bf16x8 Y = *(const bf16x8*)(su + (size_t)(n * SL + s) * HW + g * 16 + (fq & 1) * 8);
#pragma unroll
    for (int pt = 0; pt < 8; ++pt) {
      const bf16x8 X = *(const bf16x8*)(M1 + (size_t)(pt * 16 + fr) * 512 + kk * 32 + fq * 8);
      acc[pt] = mfma16(X, Y, acc[pt]);
    }
  }
#pragma unroll
  for (int pt = 0; pt < 8; ++pt) *(f32x4*)(p.Xloc + ((size_t)g * NCH + n) * 128 + pt * 16 + 4 * fq) = acc[pt];
}

__device__ void fox_cumsum(const P& p, int hh, char* lds) {
  float* wt = (float*)lds;
  const int tid = otid(), lane = tid & 63, wid = tid >> 6;
  float v[16];
  float run = 0.f;
#pragma unroll
  for (int j = 0; j < 16; ++j) { run += p.lsf[(tid * 16 + j) * 8 + hh]; v[j] = run; }
  float inc = run;
#pragma unroll
  for (int o = 1; o < 64; o <<= 1) { const float t = __shfl_up(inc, o); if (lane >= o) inc += t; }
  if (lane == 63) wt[wid] = inc;
  __syncthreads();
  float base = inc - run;
  for (int w = 0; w < wid; ++w) base += wt[w];
#pragma unroll
  for (int j = 0; j < 16; ++j) p.cc[hh * S + tid * 16 + j] = base + v[j];
  __syncthreads();
}

__device__ void phase_local(const P& p, int l, char* lds) {
  constexpr int NU = 1024 + 128 + 8;
  for (int u = blockIdx.x; u < NU; u += gridDim.x) {
    if (u < 1024) hg_local(p, u, lds);
    else if (u < 1152) s5_local(p, l, u - 1024);
    else fox_cumsum(p, u - 1152, lds);
  }
}

__device__ void phase_scan(const P& p, int l) {
  constexpr int NU = 128 + 8;
  const int tid = otid();
  for (int u = blockIdx.x; u < NU; u += gridDim.x) {
    if (u < 128) {
      const int e2 = u * NTHREADS + tid, hh = e2 >> 13, rem = e2 & 8191, v = rem >> 6, k = (rem & 63) * 2;
      float s0 = 0.f, s1 = 0.f;
#pragma unroll 16
      for (int n = 0; n < 128; ++n) {
        const size_t idx = ((size_t)(hh * 128 + n) * 128 + v) * 128 + k;
        const f32x2 loc = *(const f32x2*)(p.SlocT + idx);
        const f32x2 el = *(const f32x2*)(p.elast + (size_t)(hh * 128 + n) * 128 + k);
        *(unsigned*)(p.SprevT + idx) = cvtpk(s0, s1);
        s0 = el[0] * s0 + loc[0]; s1 = el[1] * s1 + loc[1];
      }
    } else {
      const int gid = (u - 128) * NTHREADS + tid, g = gid >> 6, pp = gid & 63;
      const float ar = p.AL[((l * 64 + g) * 64 + pp) * 2], ai = p.AL[((l * 64 + g) * 64 + pp) * 2 + 1];
      float sr = 0.f, si = 0.f;
#pragma unroll 16
      for (int n = 0; n < NCH; ++n) {
        const size_t idx = ((size_t)g * NCH + n) * 128 + pp;
        const float xr = p.Xloc[idx], xi = p.Xloc[idx + 64];
        p.Xprev[idx] = f2bf(sr); p.Xprev[idx + 64] = f2bf(si);
        const float nr = ar * sr - ai * si + xr, ni = ar * si + ai * sr + xi;
        sr = nr; si = ni;
      }
    }
  }
}

__device__ void hg_out(const P& p, int l, int bu) {
  const int hh = bu >> 6, np = bu & 63;
  const int tid = otid(), lane = tid & 63, wid = tid >> 6, fr = lane & 15, fq = lane >> 4;
  const int n = np * 2 + (wid >> 2), tt = wid & 3, colh = hh * 128;
  const int token = n * 64 + tt * 16 + fr;
  const bf16_t* sp = p.SprevT + (size_t)(hh * 128 + n) * 128 * 128;
  f32x4 acc[8];
#pragma unroll
  for (int i = 0; i < 8; ++i) acc[i] = (f32x4){0.f, 0.f, 0.f, 0.f};
#pragma unroll
  for (int kk = 0; kk < 4; ++kk) {
    const bf16x8 Y = *(const bf16x8*)(p.qd + (size_t)token * HW + colh + kk * 32 + fq * 8);
#pragma unroll
    for (int vt = 0; vt < 8; ++vt) {
      const bf16x8 X = *(const bf16x8*)(sp + (size_t)(vt * 16 + fr) * 128 + kk * 32 + fq * 8);
      acc[vt] = mfma16(X, Y, acc[vt]);
    }
  }
  float ss = 0.f;
#pragma unroll
  for (int vt = 0; vt < 8; ++vt) {
    const f32x4 o = *(const f32x4*)(p.oin + (size_t)token * HW + colh + vt * 16 + 4 * fq);
    acc[vt] += o;
    ss += acc[vt][0] * acc[vt][0] + acc[vt][1] * acc[vt][1] + acc[vt][2] * acc[vt][2] + acc[vt][3] * acc[vt][3];
  }
  ss += __shfl_xor(ss, 16);
  ss += __shfl_xor(ss, 32);
  const float rstd = rsqrtf(ss * (1.f / 128.f) + EPS);
  const bf16_t* sg = p.zb + (size_t)3 * S * HW;
#pragma unroll
  for (int vt = 0; vt < 8; ++vt) {
    const int c = colh + vt * 16 + 4 * fq;
    const f32x4 gn = *(const f32x4*)(p.hg_norm_g + l * HW + c);
    const u32x2 gt = *(const u32x2*)(sg + (size_t)token * HW + c);
    const float o0 = acc[vt][0] * rstd * gn[0] * bflo(gt[0]), o1 = acc[vt][1] * rstd * gn[1] * bfhi(gt[0]);
    const float o2 = acc[vt][2] * rstd * gn[2] * bflo(gt[1]), o3 = acc[vt][3] * rstd * gn[3] * bfhi(gt[1]);
    u32x2 o = {cvtpk(o0, o1), cvtpk(o2, o3)};
    *(u32x2*)(p.oa + (size_t)token * HW + c) = o;
  }
}

__device__ void s5_out(const P& p, int l, int unit, char* lds) {
  const int g = unit >> 1, half = unit & 1;
  const int tid = otid(), lane = tid & 63, wid = tid >> 6, fr = lane & 15, fq = lane >> 4;
  const int cb = half * 8 + wid, n = 16 * cb + fr;
  const bf16_t* su = p.zb + (size_t)4 * S * HW;
  const bf16_t* M2 = p.M2 + (size_t)(l * 64 + g) * 512 * 128;
  {
    const u32x4* src = (const u32x4*)(p.Ktab + (size_t)(l * 64 + g) * 32 * 256);
    u32x4* dst = (u32x4*)(lds + 512);
    dst[tid] = src[tid]; dst[tid + 512] = src[tid + 512];
    if (tid < 32) { unsigned z = 0u; asm volatile("" : "+v"(z)); ((u32x4*)lds)[tid] = (u32x4){z, z, z, z}; }
  }
  __syncthreads();
  const char* tb = lds + ((1 - (fq >> 1)) * 256 + fr * 16 + (fq & 1) * 8) * 2;
  const f32x4 dsk = *(const f32x4*)(p.s5_d + l * HW + g * 16 + 4 * fq);
#pragma unroll
  for (int th = 0; th < 2; ++th) {
    f32x4 acc[16];
#pragma unroll
    for (int ti = 0; ti < 16; ++ti) acc[ti] = (f32x4){0.f, 0.f, 0.f, 0.f};
#pragma unroll
    for (int kk = 0; kk < 4; ++kk) {
      const bf16x8 Xp = *(const bf16x8*)(p.Xprev + (g * NCH + n) * 128 + kk * 32 + fq * 8);
#pragma unroll
      for (int ti = 0; ti < 16; ++ti) {
        const int t = 16 * th + ti;
        const bf16x8 X = *(const bf16x8*)(M2 + (t * 16 + fr) * 128 + kk * 32 + fq * 8);
        acc[ti] = mfma16(X, Xp, acc[ti]);
        if ((ti & 7) == 7) __builtin_amdgcn_sched_barrier(0);
      }
    }
#pragma unroll
    for (int kk = 0; kk < 8 * th + 8; ++kk) {
      const bf16x8 U = *(const bf16x8*)(su + (n * SL + 2 * kk + (fq >> 1)) * HW + g * 16 + (fq & 1) * 8);
#pragma unroll
      for (int ti = 0; ti < 16; ++ti) {
        const int t = 16 * th + ti;
        if (t >= 2 * kk) {
          const bf16x8 X = *(const bf16x8*)(tb + (t - 2 * kk) * 512);
          acc[ti] = mfma16(X, U, acc[ti]);
        }
        if ((ti & 7) == 7) __builtin_amdgcn_sched_barrier(0);
      }
    }
#pragma unroll
    for (int ti = 0; ti < 16; ++ti) {
      const int t = 16 * th + ti;
      const int o = (n * SL + t) * HW + g * 16 + 4 * fq;
      const u32x2 uu = *(const u32x2*)(su + o);
      const float y0 = gelu_tanh(acc[ti][0] + dsk[0] * bflo(uu[0])), y1 = gelu_tanh(acc[ti][1] + dsk[1] * bfhi(uu[0]));
      const float y2 = gelu_tanh(acc[ti][2] + dsk[2] * bflo(uu[1])), y3 = gelu_tanh(acc[ti][3] + dsk[3] * bfhi(uu[1]));
      u32x2 ov = {cvtpk(y0, y1), cvtpk(y2, y3)};
      *(u32x2*)(p.yg + o) = ov;
      if ((ti & 3) == 3) __builtin_amdgcn_sched_barrier(0);
    }
  }
  __syncthreads();
}

__device__ void phase_out(const P& p, int l, char* lds) {
  constexpr int NU = 512 + 128;
  for (int u = blockIdx.x; u < NU; u += gridDim.x) {
    if (u < 512) hg_out(p, l, u);
    else s5_out(p, l, u - 512, lds);
  }
}

namespace fa {
constexpr int D = 128, QBLK = 32, KVBLK = 64, QB = 256, LD = 1024;
constexpr int SHM_V = 16384, SHM_K = 16384;
constexpr int OFF_WS = 2 * SHM_V + 2 * SHM_K, OFF_BIAS = OFF_WS + 2048;
constexpr float SCALE = 0.08838834764831845f, SQRTD = 11.313708498984761f, THR = 8.f;
constexpr unsigned WBIG = 0x40000000u;
#define KSWZ(row, colB) ((row) * 256 + ((colB) ^ (((row) & 7) << 4)))
#define SBAR() __builtin_amdgcn_sched_barrier(0)
__device__ __forceinline__ int v_st(int k, int c) { const int kk = (k & ~0xC) | ((k & 4) << 1) | ((k & 8) >> 1); return ((kk >> 3) * 4 + (c >> 5)) * 512 + ((kk & 7) * 32 + (c & 31)) * 2; }
__device__ __forceinline__ int v_rd_base(int lane) { return ((lane & 3) << 3) | (((lane >> 2) & 3) << 6) | (((lane >> 4) & 1) << 5) | (((lane >> 5) & 1) << 8); }
constexpr int v_rd_off(int d0, int ks, int half) { return d0 * 512 + ks * 4096 + half * 2048; }
__device__ __forceinline__ int crow(int r, int hi) { return (r & 3) + 8 * (r >> 2) + 4 * hi; }
__device__ __forceinline__ unsigned cvtpkv(float lo, float hi) { unsigned r; asm volatile("v_cvt_pk_bf16_f32 %0, %1, %2" : "=v"(r) : "v"(lo), "v"(hi)); return r; }

__device__ __forceinline__ void mask_tile(f32x16& p0, f32x16& p1, int dq, unsigned W) {
  const float NEG = -__builtin_inff();
#pragma unroll
  for (int r = 0; r < 16; ++r) {
    const int c = (r & 3) + 8 * (r >> 2);
    if ((unsigned)(dq - c) >= W) p0[r] = NEG;
    if ((unsigned)(dq - c - 32) >= W) p1[r] = NEG;
  }
}
__device__ __forceinline__ void partialSM(f32x16& p0, f32x16& p1, float& m_reg, float& mn, float& alpha) {
  float pmax = p0[0];
#pragma unroll
  for (int r = 1; r < 16; ++r) pmax = fmaxf(pmax, p0[r]);
#pragma unroll
  for (int r = 0; r < 16; ++r) pmax = fmaxf(pmax, p1[r]);
  { auto rr = __builtin_amdgcn_permlane32_swap(__float_as_uint(pmax), __float_as_uint(pmax), false, false);
    pmax = fmaxf(__uint_as_float(rr[0]), __uint_as_float(rr[1])); }
  constexpr float C2 = 1.4426950408889634f * SCALE;
  if (__builtin_expect(__all((pmax - m_reg) * SCALE <= THR), 1)) { mn = m_reg; alpha = 1.f; }
  else { mn = fmaxf(m_reg, pmax); alpha = __builtin_amdgcn_exp2f((m_reg - mn) * C2); m_reg = mn; }
  const float mnL = -mn * C2;
#pragma unroll
  for (int r = 0; r < 16; ++r) p0[r] = fmaf(p0[r], C2, mnL);
#pragma unroll
  for (int r = 0; r < 16; ++r) p1[r] = fmaf(p1[r], C2, mnL);
#pragma unroll
  for (int r = 0; r < 16; ++r) p0[r] = __builtin_amdgcn_exp2f(p0[r]);
}
__device__ __forceinline__ void finishSM(f32x16& p0, f32x16& p1, float alpha, float& l_reg, bf16x8& pa0, bf16x8& pa1, bf16x8& pa2, bf16x8& pa3) {
#pragma unroll
  for (int r = 0; r < 16; ++r) p1[r] = __builtin_amdgcn_exp2f(p1[r]);
  float ps = 0;
#pragma unroll
  for (int r = 0; r < 16; ++r) ps += p0[r];
#pragma unroll
  for (int r = 0; r < 16; ++r) ps += p1[r];
  { auto rr = __builtin_amdgcn_permlane32_swap(__float_as_uint(ps), __float_as_uint(ps), false, false);
    ps = __uint_as_float(rr[0]) + __uint_as_float(rr[1]); }
  l_reg = l_reg * alpha + ps;
#define PK4(Pv, B_, OUT) do { unsigned a0 = cvtpkv(Pv[B_+0], Pv[B_+1]), a1 = cvtpkv(Pv[B_+2], Pv[B_+3]); \
    unsigned b0 = cvtpkv(Pv[B_+4], Pv[B_+5]), b1 = cvtpkv(Pv[B_+6], Pv[B_+7]); \
    auto r0 = __builtin_amdgcn_permlane32_swap(a0, b0, false, false); auto r1 = __builtin_amdgcn_permlane32_swap(a1, b1, false, false); \
    u32x4 w = {r0[0], r1[0], r0[1], r1[1]}; OUT = *reinterpret_cast<bf16x8*>(&w); } while (0)
  PK4(p0, 0, pa0); PK4(p0, 8, pa1); PK4(p1, 0, pa2); PK4(p1, 8, pa3);
#undef PK4
}
template <int KB>
__device__ __forceinline__ void qkt(f32x16& p0, f32x16& p1, const char* lds, int r32, int hi, const bf16x8* qr) {
  const char* K_lds = lds + 2 * SHM_V;
  p0 = f32x16{}; p1 = f32x16{};
  const char* kb[4];
#pragma unroll
  for (int dd = 0; dd < 4; ++dd) kb[dd] = K_lds + KB * SHM_K + KSWZ(r32, (dd * 16 + hi * 8) * 2);
#pragma unroll
  for (int d0 = 0; d0 < 8; ++d0) { const char* a = kb[d0 & 3] + (d0 >> 2) * 128;
    bf16x8 b0 = *reinterpret_cast<const bf16x8*>(a);
    bf16x8 b1 = *reinterpret_cast<const bf16x8*>(a + 32 * 256);
    p0 = __builtin_amdgcn_mfma_f32_32x32x16_bf16(b0, qr[d0], p0, 0, 0, 0);
    p1 = __builtin_amdgcn_mfma_f32_32x32x16_bf16(b1, qr[d0], p1, 0, 0, 0); }
}
template <int KB>
__device__ __forceinline__ void add_bias(f32x16& p0, f32x16& p1, const char* lds, int hi) {
  const float* bb = (const float*)(lds + OFF_BIAS + KB * 256) + 4 * hi;
#pragma unroll
  for (int j = 0; j < 4; ++j) {
    const f32x4 t0 = *(const f32x4*)(bb + 8 * j), t1 = *(const f32x4*)(bb + 32 + 8 * j);
    p0[4 * j] += t0[0]; p0[4 * j + 1] += t0[1]; p0[4 * j + 2] += t0[2]; p0[4 * j + 3] += t0[3];
    p1[4 * j] += t1[0]; p1[4 * j + 1] += t1[1]; p1[4 * j + 2] += t1[2]; p1[4 * j + 3] += t1[3];
  }
}
template <int VB>
__device__ __forceinline__ void pv_tile(f32x16* o, int vb0, bf16x8 pa0, bf16x8 pa1, bf16x8 pa2, bf16x8 pa3) {
#define TRRD(dst, off) asm volatile("ds_read_b64_tr_b16 %0, %1 offset:%2" : "=&v"(dst) : "v"(vb0), "i"(off) : "memory")
#define PV_D0(d0) do { s16x4 l0, l1, l2, l3, h0, h1, h2, h3; constexpr int b_ = VB * SHM_V + v_rd_off(d0, 0, 0); \
    TRRD(l0, b_); TRRD(h0, b_ + 2048); TRRD(l1, b_ + 4096); TRRD(h1, b_ + 6144); TRRD(l2, b_ + 8192); TRRD(h2, b_ + 10240); TRRD(l3, b_ + 12288); TRRD(h3, b_ + 14336); \
    asm volatile("s_waitcnt lgkmcnt(0)" ::: "memory"); SBAR(); \
    o[d0] = __builtin_amdgcn_mfma_f32_32x32x16_bf16(pa0, (bf16x8){l0[0], l0[1], l0[2], l0[3], h0[0], h0[1], h0[2], h0[3]}, o[d0], 0, 0, 0); \
    o[d0] = __builtin_amdgcn_mfma_f32_32x32x16_bf16(pa1, (bf16x8){l1[0], l1[1], l1[2], l1[3], h1[0], h1[1], h1[2], h1[3]}, o[d0], 0, 0, 0); \
    o[d0] = __builtin_amdgcn_mfma_f32_32x32x16_bf16(pa2, (bf16x8){l2[0], l2[1], l2[2], l2[3], h2[0], h2[1], h2[2], h2[3]}, o[d0], 0, 0, 0); \
    o[d0] = __builtin_amdgcn_mfma_f32_32x32x16_bf16(pa3, (bf16x8){l3[0], l3[1], l3[2], l3[3], h3[0], h3[1], h3[2], h3[3]}, o[d0], 0, 0, 0); } while (0)
  PV_D0(0); PV_D0(1); PV_D0(2); PV_D0(3);
#undef PV_D0
#undef TRRD
}

struct BlockRef { const bf16_t* Q; const bf16_t* K; const bf16_t* V; const bf16_t* G; bf16_t* O; const float* C; int P0; };
struct Seam { bf16x8 qr[8]; bf16x8 st_v0, st_v1, st_k0, st_k1; float st_b; };

#define ROWP(pp, k0, rr) ((pp) + (size_t)((k0) + (rr)) * LD + sc)
#define VMW() asm volatile("s_waitcnt vmcnt(0)" ::: "memory")
#define VMWN(n) asm volatile("s_waitcnt vmcnt(%0)" :: "i"(n) : "memory")
#define LD8(ptr) (*reinterpret_cast<const bf16x8*>(ptr))
#define SLOAD_H(ref, k0) do { S.st_v0 = LD8(ROWP((ref).V, k0, sr)); S.st_v1 = LD8(ROWP((ref).V, k0, 32 + sr)); \
    S.st_k0 = LD8(ROWP((ref).K, k0, sr)); S.st_k1 = LD8(ROWP((ref).K, k0, 32 + sr)); \
    S.st_b = (ref).C[(k0) + (tid & 63)]; } while (0)
#define SWRITE_HK(bf) do { *(bf16x8*)(K_lds + (bf) * SHM_K + kws) = S.st_k0; *(bf16x8*)(K_lds + (bf) * SHM_K + kws + 32 * 256) = S.st_k1; \
    if (tid < 64) *(float*)(lds + OFF_BIAS + (bf) * 256 + tid * 4) = (cref - S.st_b) * SQRTD; } while (0)
#define SWRITE_HV(bf) do { *(bf16x8*)(V_lds + (bf) * SHM_V + vst0) = S.st_v0; *(bf16x8*)(V_lds + (bf) * SHM_V + vst1) = S.st_v1; } while (0)
#define SWRITE_H(bf) do { SWRITE_HV(bf); SWRITE_HK(bf); } while (0)

__device__ __forceinline__ void prime(const BlockRef& cur, char* lds, Seam& S) {
  const int tid = otid(), wid = __builtin_amdgcn_readfirstlane(tid >> 6), lane = tid & 63, r32 = lane & 31, hi = lane >> 5;
  const int sr = tid >> 4, sc = (tid & 15) * 8, kws = KSWZ(sr, sc * 2); char* K_lds = lds + 2 * SHM_V;
  const float cref = cur.C[cur.P0 + QB - 1];
#pragma unroll
  for (int d0 = 0; d0 < 8; ++d0) S.qr[d0] = LD8(cur.Q + (size_t)(wid * QBLK + r32) * LD + d0 * 16 + hi * 8);
  SLOAD_H(cur, 0); VMW(); SWRITE_HK(0);
  __syncthreads();
}

__device__ __forceinline__ void block(const BlockRef& cur, const BlockRef& nxt, char* lds, Seam& S) {
  const int tid = otid(), wid = __builtin_amdgcn_readfirstlane(tid >> 6), lane = tid & 63, r32 = lane & 31, hi = lane >> 5;
  const int NT = cur.P0 / KVBLK + QB / KVBLK;
  const float cref = cur.C[cur.P0 + QB - 1];
  const int qlo = cur.P0 + wid * QBLK, qm = qlo + r32 - 4 * hi;
  char* V_lds = lds; char* K_lds = lds + 2 * SHM_V;
  float* ws = (float*)(lds + OFF_WS) + wid * 64; float* li_l = ws, * al_l = ws + 32;
  float m_reg = -1e30f, l_reg = 0; f32x16 o[4] = {};
  const int sr = tid >> 4, sc = (tid & 15) * 8, vst0 = v_st(sr, sc), vst1 = v_st(32 + sr, sc), kws = KSWZ(sr, sc * 2);
  const int vb0 = (int)(uintptr_t)V_lds + v_rd_base(lane);
#define RESC(a) do { if (__any((a) < 1.f)) { if (hi == 0) al_l[r32] = (a); asm volatile("s_waitcnt lgkmcnt(0)" ::: "memory"); \
    for (int d_ = 0; d_ < 4; ++d_) for (int r = 0; r < 16; ++r) o[d_][r] *= al_l[crow(r, hi)]; } } while (0)
#define KBASE(t) ((t) * KVBLK)
#define MASKT(P0_, P1_, t) do { const int kb_ = KBASE(t); if (kb_ + KVBLK - 1 > qlo) mask_tile(P0_, P1_, qm - kb_, WBIG); } while (0)
  constexpr int NQL = 8;
#define SEAM_K0() do { VMWN(NQL); SWRITE_HK(0); SBAR(); } while (0)
  f32x16 pA0, pA1, pB0, pB1; float mnA, mnB, alA, alB; bf16x8 pa0, pa1, pa2, pa3;
  SWRITE_HV(0); SBAR();
  if (NT > 1) { SLOAD_H(cur, KBASE(1)); }
  SBAR(); qkt<0>(pA0, pA1, lds, r32, hi, S.qr);
  add_bias<0>(pA0, pA1, lds, hi); MASKT(pA0, pA1, 0); partialSM(pA0, pA1, m_reg, mnA, alA);
  if (NT > 1) { VMW(); SWRITE_H(1); }
  __syncthreads();
#define HALF_STEP(PX0, PX1, mnX, alX, PY0, PY1, alY, t, KB, VB, SB) do { \
    SBAR(); qkt<KB>(PX0, PX1, lds, r32, hi, S.qr); \
    finishSM(PY0, PY1, alY, l_reg, pa0, pa1, pa2, pa3); SBAR(); \
    if ((t) + 1 < NT) { SLOAD_H(cur, KBASE((t) + 1)); SBAR(); } \
    pv_tile<VB>(o, vb0, pa0, pa1, pa2, pa3); add_bias<KB>(PX0, PX1, lds, hi); MASKT(PX0, PX1, (t)); partialSM(PX0, PX1, m_reg, mnX, alX); \
    __syncthreads(); \
    if ((t) + 1 < NT) { VMW(); SWRITE_H(SB); } \
    RESC(alX); __syncthreads(); } while (0)
  for (int t = 1; t + 1 < NT; t += 2) {
    HALF_STEP(pB0, pB1, mnB, alB, pA0, pA1, alA, t, 1, 0, 0);
    HALF_STEP(pA0, pA1, mnA, alA, pB0, pB1, alB, t + 1, 0, 1, 1);
  }
  const bool even = (NT & 1) == 0;
  if (even) { SBAR(); qkt<1>(pB0, pB1, lds, r32, hi, S.qr); SBAR(); }
  finishSM(pA0, pA1, alA, l_reg, pa0, pa1, pa2, pa3); SBAR();
  pv_tile<0>(o, vb0, pa0, pa1, pa2, pa3);
  if (even) { add_bias<1>(pB0, pB1, lds, hi); MASKT(pB0, pB1, NT - 1); partialSM(pB0, pB1, m_reg, mnB, alB); __syncthreads(); RESC(alB);
    finishSM(pB0, pB1, alB, l_reg, pa0, pa1, pa2, pa3); SBAR(); pv_tile<1>(o, vb0, pa0, pa1, pa2, pa3); }
  SBAR();
  if (hi == 0) li_l[r32] = l_reg; asm volatile("s_waitcnt lgkmcnt(0)" ::: "memory");
  float rli[16];
#pragma unroll
  for (int r = 0; r < 16; ++r) rli[r] = __builtin_amdgcn_rcpf(li_l[crow(r, hi)]);
  bf16_t* Ow = cur.O + wid * QBLK * LD;
#pragma unroll
  for (int r = 0; r < 16; ++r) { const int orow = crow(r, hi);
#pragma unroll
    for (int d0 = 0; d0 < 4; ++d0) { const float v = o[d0][r] * rli[r];
      const float vn = __shfl_xor(v, 1);
      if ((r32 & 1) == 0) *(unsigned*)(Ow + orow * LD + d0 * 32 + r32) = cvtpkv(v, vn); }
  }
  __syncthreads();
#undef RESC
#undef KBASE
#undef MASKT
#undef SEAM_K0
#undef HALF_STEP
}
#undef ROWP
#undef VMW
#undef VMWN
#undef SLOAD_H
#undef SWRITE_HK
#undef SWRITE_HV
#undef SWRITE_H

__device__ __forceinline__ BlockRef mkref(const P& p, int hh, int qb) {
  BlockRef r; const size_t ho = (size_t)hh * 128, ro = (size_t)qb * QB * LD;
  r.Q = p.zb + (size_t)6 * S * HW + ro + ho; r.K = p.zb + (size_t)7 * S * HW + ho; r.V = p.zb + (size_t)8 * S * HW + ho;
  r.G = p.zb + (size_t)9 * S * HW + ro + ho; r.O = p.oc + ro + ho; r.C = p.cc + (size_t)hh * S; r.P0 = qb * QB;
  return r;
}
__device__ void item(const P& p, int it, char* lds) {
  const BlockRef b0 = mkref(p, it & 7, it >> 3);
  Seam S;
  prime(b0, lds, S);
  block(b0, b0, lds, S);
  __threadfence(); __syncthreads();
  const int tid = otid();
#pragma unroll 2
  for (int i = 0; i < 8; ++i) {
    const int id = tid + NTHREADS * i, row = id >> 4, ch = id & 15;
    bf16_t* op = b0.O + row * LD + ch * 8;
    const u32x4 ov = *(const u32x4*)op, gv = *(const u32x4*)(b0.G + row * LD + ch * 8);
    u32x4 r;
#pragma unroll
    for (int j = 0; j < 4; ++j) r[j] = cvtpk(bflo(ov[j]) * bflo(gv[j]), bfhi(ov[j]) * bfhi(gv[j]));
    *(u32x4*)op = r;
  }
  __syncthreads();
}
}

__device__ void glu_tile(const P& p, int l, int t, char* lds) {
  const int tid = otid(), lane = tid & 63, wid = tid >> 6, wr = wid >> 2, wc = wid & 3, fr = lane & 15, fq = lane >> 4;
  const int pm = t & 31, pn = t >> 5;
  f32x4 acc[8][4];
  zero_acc<4>(acc);
  gemm_main<4>(acc, p.yg + (size_t)pm * 256 * HW, HW, p.WgluT + ((size_t)l * 2048 + (size_t)pn * 256) * HW, HW, HW, lds);
  const bf16_t* sg = p.zb + (size_t)5 * S * HW;
#pragma unroll
  for (int m = 0; m < 8; ++m)
#pragma unroll
    for (int nt = 0; nt < 2; ++nt) {
      const int row = pm * 256 + wr * 128 + m * 16 + fr, c = pn * 128 + wc * 32 + nt * 16 + 4 * fq;
      const u32x2 gt = *(const u32x2*)(sg + (size_t)row * HW + c);
      const f32x4 v = acc[m][nt], gg = acc[m][nt + 2];
      const float o0 = v[0] * sigmoidf_(gg[0]) * bflo(gt[0]), o1 = v[1] * sigmoidf_(gg[1]) * bfhi(gt[0]);
      const float o2 = v[2] * sigmoidf_(gg[2]) * bflo(gt[1]), o3 = v[3] * sigmoidf_(gg[3]) * bfhi(gt[1]);
      u32x2 o = {cvtpk(o0, o1), cvtpk(o2, o3)};
      *(u32x2*)(p.ob + (size_t)row * HW + c) = o;
    }
}
__device__ void phase_attn_glu(const P& p, int l, char* lds) {
  const int G = gridDim.x, b = blockIdx.x, na = G >= 256 ? 128 : G / 2;
  if (b < na) {
#pragma unroll 1
    for (int j = b; j < 128; j += na) {
#pragma unroll 1
      for (int k = 0; k < 2; ++k) fa::item(p, k ? j : 255 - j, lds);
    }
  }
  else { for (int t = b - na; t < 256; t += G - na) glu_tile(p, l, t, lds); }
}

__device__ void phase_merge(const P& p, int l, char* lds) {
  const int tid = otid(), lane = tid & 63, wid = tid >> 6, wr = wid >> 2, wc = wid & 3, fr = lane & 15, fq = lane >> 4;
  for (int t = blockIdx.x; t < 32 * 16; t += gridDim.x) {
    const int pm = t & 31, pn = t >> 5;
    f32x4 macc[8][2];
    zero_acc<2>(macc);
#pragma unroll 1
    for (int br = 0; br < 3; ++br) {
      const bf16_t* A = (br == 0 ? p.oa : br == 1 ? p.ob : p.oc) + (size_t)pm * 256 * HW;
      f32x4 acc[8][2];
      zero_acc<2>(acc);
      gemm_main<2>(acc, A, HW, p.WbrT + ((size_t)(l * 3 + br) * DM + (size_t)pn * 128) * HW, HW, HW, lds);
#pragma unroll
      for (int m = 0; m < 8; ++m)
#pragma unroll
        for (int nt = 0; nt < 2; ++nt) {
          const int row = pm * 256 + wr * 128 + m * 16 + fr, c = pn * 128 + wc * 32 + nt * 16 + 4 * fq;
          const u32x2 gt = *(const u32x2*)(p.gates + (size_t)row * 6144 + br * DM + c);
          macc[m][nt][0] += bflo(gt[0]) * acc[m][nt][0]; macc[m][nt][1] += bfhi(gt[0]) * acc[m][nt][1];
          macc[m][nt][2] += bflo(gt[1]) * acc[m][nt][2]; macc[m][nt][3] += bfhi(gt[1]) * acc[m][nt][3];
        }
    }
#pragma unroll
    for (int m = 0; m < 8; ++m)
#pragma unroll
      for (int nt = 0; nt < 2; ++nt) {
        const int row = pm * 256 + wr * 128 + m * 16 + fr, c = pn * 128 + wc * 32 + nt * 16 + 4 * fq;
        u32x2 o = {cvtpk(macc[m][nt][0], macc[m][nt][1]), cvtpk(macc[m][nt][2], macc[m][nt][3])};
        *(u32x2*)(p.m + (size_t)row * DM + c) = o;
      }
  }
}

__device__ void phase_wout(const P& p, int l, char* lds) {
  const int tid = otid(), lane = tid & 63, wid = tid >> 6, wr = wid >> 2, wc = wid & 3, fr = lane & 15, fq = lane >> 4;
  const float* xin = l == 0 ? p.x : p.xbuf;
  for (int t = blockIdx.x; t < 32 * 8; t += gridDim.x) {
    const int pm = t & 31, pn = t >> 5;
    f32x4 acc[8][4];
    zero_acc<4>(acc);
    gemm_main<4>(acc, p.m + (size_t)pm * 256 * DM, DM, p.WoutT + ((size_t)l * DM + (size_t)pn * 256) * DM, DM, DM, lds);
#pragma unroll
    for (int m = 0; m < 8; ++m)
#pragma unroll
      for (int nt = 0; nt < 4; ++nt) {
        const int row = pm * 256 + wr * 128 + m * 16 + fr, c = pn * 256 + wc * 32 + ncol<4>(nt) + 4 * fq;
        const f32x4 xv = *(const f32x4*)(xin + (size_t)row * DM + c);
        *(f32x4*)(p.xbuf + (size_t)row * DM + c) = xv + acc[m][nt];
      }
  }
}

#if SINGLE_LAUNCH
constexpr int NPHASE = 18;
typedef const __attribute__((address_space(4))) P KP;
__device__ __forceinline__ void run_phase(KP* q, int ph, char* lds) {
#if defined(__HIP_DEVICE_COMPILE__)
  if (ph == 0) { const P p = *(const P*)q; phase_prep(p, lds); return; }
  if (ph == 17) { const P p = *(const P*)q; phase_final_norm(p); return; }
  const int l = (ph - 1) >> 3, s = (ph - 1) & 7;
#ifdef ONLY_S
  if (s != ONLY_S) return;
#endif
  switch (s) {
    case 0: { const P p = *(const P*)q; phase_norm(p, l, lds); } break;
    case 1: { const P p = *(const P*)q; phase_gemm_in(p, l, lds); } break;
    case 2: { const P p = *(const P*)q; phase_local(p, l, lds); } break;
    case 3: { const P p = *(const P*)q; phase_scan(p, l); } break;
    case 4: { const P p = *(const P*)q; phase_out(p, l, lds); } break;
    case 5: { const P p = *(const P*)q; phase_attn_glu(p, l, lds); } break;
    case 6: { const P p = *(const P*)q; phase_merge(p, l, lds); } break;
    default: { const P p = *(const P*)q; phase_wout(p, l, lds); } break;
  }
#endif
}

__global__ void __launch_bounds__(NTHREADS) fwd_kernel(P pdummy, int ph_lo, int ph_hi) {
  extern __shared__ __attribute__((aligned(16))) char lds[];
  cg::grid_group grid = cg::this_grid();
  (void)pdummy;
  for (int ph = ph_lo; ph < ph_hi; ++ph) {
    KP* q = (KP*)__builtin_amdgcn_kernarg_segment_ptr();
    asm volatile("" : "+s"(q));
    run_phase(q, ph, lds);
    if (ph + 1 < ph_hi) grid.sync();
  }
}

#else
constexpr int NPHASE = 18;
template <int SS> __global__ void __launch_bounds__(NTHREADS) phase_k(P p, int l) {
  extern __shared__ __attribute__((aligned(16))) char lds[];
  if (SS == 8) phase_prep(p, lds);
  else if (SS == 9) phase_final_norm(p);
  else if (SS == 0) phase_norm(p, l, lds);
  else if (SS == 1) phase_gemm_in(p, l, lds);
  else if (SS == 2) phase_local(p, l, lds);
  else if (SS == 3) phase_scan(p, l);
  else if (SS == 4) phase_out(p, l, lds);
  else if (SS == 5) phase_attn_glu(p, l, lds);
  else if (SS == 6) phase_merge(p, l, lds);
  else phase_wout(p, l, lds);
}
#endif

extern "C" void kernel_launch(void* const* d_in, const int* in_sizes, int n_in, void* d_out, int out_size, void* d_ws, size_t ws_size,
                              hipStream_t stream) {
  (void)in_sizes; (void)n_in; (void)out_size;
  static int grid_blocks = 0;
  if (!grid_blocks) {
    int dev = 0, cus = 0;
    (void)hipGetDevice(&dev);
    (void)hipDeviceGetAttribute(&cus, hipDeviceAttributeMultiprocessorCount, dev);
    if (cus <= 0) cus = 256;
#if SINGLE_LAUNCH
    int per_cu = 0;
    hipError_t e = hipFuncSetAttribute((const void*)fwd_kernel, hipFuncAttributeMaxDynamicSharedMemorySize, LDS_BYTES);
    if (e != hipSuccess) fprintf(stderr, "hipFuncSetAttribute failed: %s\n", hipGetErrorString(e));
    (void)hipOccupancyMaxActiveBlocksPerMultiprocessor(&per_cu, fwd_kernel, NTHREADS, LDS_BYTES);
    if (per_cu < 1) fprintf(stderr, "occupancy query returned %d\n", per_cu);
#else
#define SETA(SS) (void)hipFuncSetAttribute((const void*)phase_k<SS>, hipFuncAttributeMaxDynamicSharedMemorySize, LDS_BYTES)
    SETA(0); SETA(1); SETA(2); SETA(3); SETA(4); SETA(5); SETA(6); SETA(7); SETA(8); SETA(9);
#undef SETA
#endif
    grid_blocks = cus;
  }
  P p{};
  const float* const* in = (const float* const*)d_in;
  p.x = in[0]; p.norm_g = in[1]; p.w_in = in[2]; p.b_gate = in[3]; p.fox_bf = in[4]; p.hg_lb = in[5]; p.hg_norm_g = in[6];
  p.a_re = in[7]; p.a_im = in[8]; p.log_dt = in[9]; p.b_re = in[10]; p.b_im = in[11]; p.c_re = in[12]; p.c_im = in[13];
  p.s5_d = in[14]; p.w_glu = in[15]; p.w_a = in[16]; p.w_b = in[17]; p.w_c = in[18]; p.w_out = in[19]; p.final_g = in[20];
  p.out = (float*)d_out;
  char* w = (char*)d_ws; size_t off = 0;
  auto take = [&](size_t bytes) { char* r = w + off; off += (bytes + 255) & ~(size_t)255; return r; };
  p.WinT = (bf16_t*)take((size_t)2 * NZ * DM * 2);
  p.WgluT = (bf16_t*)take((size_t)2 * 2048 * HW * 2);
  p.WbrT = (bf16_t*)take((size_t)6 * DM * HW * 2);
  p.WoutT = (bf16_t*)take((size_t)2 * DM * DM * 2);
  p.Ktab = (bf16_t*)take((size_t)2 * 64 * 32 * 256 * 2);
  p.M1 = (bf16_t*)take((size_t)2 * 64 * 128 * 512 * 2);
  p.M2 = (bf16_t*)take((size_t)2 * 64 * 512 * 128 * 2);
  p.AL = (float*)take((size_t)2 * 64 * 64 * 2 * 4);
  p.xbuf = (float*)take((size_t)S * DM * 4);
  p.h = (bf16_t*)take((size_t)S * DM * 2);
  p.lsf = (float*)take((size_t)S * 8 * 4);
  p.cc = (float*)take((size_t)S * 8 * 4);
  p.zb = (bf16_t*)take((size_t)10 * S * HW * 2);
  p.logf = (float*)take((size_t)S * HW * 4);
  p.gates = (bf16_t*)take((size_t)S * 6144 * 2);
  p.oin = (float*)take((size_t)S * HW * 4);
  p.qd = (bf16_t*)take((size_t)S * HW * 2);
  p.SlocT = (float*)take((size_t)8 * 128 * 128 * 128 * 4);
  p.elast = (float*)take((size_t)8 * 128 * 128 * 4);
  p.SprevT = (bf16_t*)take((size_t)8 * 128 * 128 * 128 * 2);
  p.Xloc = (float*)take((size_t)64 * NCH * 128 * 4);
  p.Xprev = (bf16_t*)take((size_t)64 * NCH * 128 * 2);
  p.yg = (bf16_t*)take((size_t)S * HW * 2);
  p.oa = (bf16_t*)take((size_t)S * HW * 2);
  p.ob = (bf16_t*)take((size_t)S * HW * 2);
  p.oc = (bf16_t*)take((size_t)S * HW * 2);
  p.m = (bf16_t*)take((size_t)S * DM * 2);
  if (off > ws_size) { fprintf(stderr, "workspace too small: need %zu have %zu\n", off, ws_size); return; }
#if SINGLE_LAUNCH
  int lo = 0, hi = NPHASE;
  void* args[] = {&p, &lo, &hi};
  hipError_t e = hipLaunchCooperativeKernel((const void*)fwd_kernel, dim3(grid_blocks), dim3(NTHREADS), args, LDS_BYTES, stream);
  if (e != hipSuccess) fprintf(stderr, "cooperative launch failed: %s (grid %d)\n", hipGetErrorString(e), grid_blocks);
#else
#define LAUNCH(SS, L) phase_k<SS><<<dim3(grid_blocks), dim3(NTHREADS), LDS_BYTES, stream>>>(p, L)
  LAUNCH(8, 0);
  for (int l = 0; l < 2; ++l) { LAUNCH(0, l); LAUNCH(1, l); LAUNCH(2, l); LAUNCH(3, l); LAUNCH(4, l); LAUNCH(5, l); LAUNCH(6, l); LAUNCH(7, l); }
  LAUNCH(9, 0);
#undef LAUNCH
#endif
}
```

```cpp
#include <hip/hip_runtime.h>
#include <hip/hip_cooperative_groups.h>
#include <cstdint>
#include <cstdio>
namespace cg = cooperative_groups;

typedef unsigned short bf16_t;
typedef short bf16x8 __attribute__((ext_vector_type(8)));
typedef short s16x4 __attribute__((ext_vector_type(4)));
typedef float f32x4 __attribute__((ext_vector_type(4)));
typedef float f32x2 __attribute__((ext_vector_type(2)));
typedef float f32x16 __attribute__((ext_vector_type(16)));
typedef unsigned u32x4 __attribute__((ext_vector_type(4)));
typedef unsigned u32x2 __attribute__((ext_vector_type(2)));

#ifndef SINGLE_LAUNCH
#define SINGLE_LAUNCH 1
#endif

constexpr int S = 8192, DM = 2048, INW = 16392, NZ = 16384, HW = 1024;
constexpr int NTHREADS = 512;
constexpr int LDS_BYTES = 151552;
constexpr float EPS = 1e-6f;
constexpr int SL = 32, NCH = S / SL;

struct P {
  const float *x, *norm_g, *w_in, *b_gate, *fox_bf, *hg_lb, *hg_norm_g, *a_re, *a_im, *log_dt, *b_re, *b_im, *c_re, *c_im,
      *s5_d, *w_glu, *w_a, *w_b, *w_c, *w_out, *final_g;
  float* out;
  bf16_t *WinT, *WgluT, *WbrT, *WoutT, *Ktab, *M1, *M2;
  float* AL;
  float* xbuf; bf16_t* h; float* lsf; float* cc;
  bf16_t* zb; float* logf; bf16_t* gates;
  float* oin; bf16_t* qd; float* SlocT; float* elast; bf16_t* SprevT;
  float* Xloc; bf16_t* Xprev; bf16_t* yg;
  bf16_t *oa, *ob, *oc, *m;
  unsigned long long* ts;
  unsigned* bar;
  float* opart; float* mlpart; float* mtmp;
};

typedef __bf16 bf16x2_t __attribute__((ext_vector_type(2)));
__device__ __forceinline__ unsigned cvtpk(float lo, float hi) { f32x2 v = {lo, hi}; bf16x2_t b = __builtin_convertvector(v, bf16x2_t); return *reinterpret_cast<unsigned*>(&b); }
__device__ __forceinline__ bf16_t f2bf(float v) { return (bf16_t)(cvtpk(v, 0.f) & 0xffffu); }
__device__ __forceinline__ float bf2f(bf16_t h) { return __uint_as_float(((unsigned)h) << 16); }
__device__ __forceinline__ float bflo(unsigned u) { return __uint_as_float(u << 16); }
__device__ __forceinline__ float bfhi(unsigned u) { return __uint_as_float(u & 0xffff0000u); }
__device__ __forceinline__ float sigmoidf_(float x) { return __builtin_amdgcn_rcpf(1.f + __expf(-x)); }
__device__ __forceinline__ float siluf_(float x) { return x * sigmoidf_(x); }
__device__ __forceinline__ float logsigf_(float x) { return fminf(x, 0.f) - log1pf(__expf(-fabsf(x))); }
__device__ __forceinline__ float gelu_tanh(float y) {
  const float u2 = 1.5957691216057308f * (y + 0.044715f * y * y * y); return y * __builtin_amdgcn_rcpf(1.f + __expf(-u2)); }
__device__ __forceinline__ int otid() { int t = threadIdx.x; asm volatile("" : "+v"(t)); return t; }
__device__ __forceinline__ int obid() { int b = blockIdx.x; asm volatile("" : "+s"(b)); return b; }
__device__ __forceinline__ int ogdim() { int g = gridDim.x; asm volatile("" : "+s"(g)); return g; }
__device__ __forceinline__ f32x4 mfma16(bf16x8 a, bf16x8 b, f32x4 c) { return __builtin_amdgcn_mfma_f32_16x16x32_bf16(a, b, c, 0, 0, 0); }
__device__ __forceinline__ float wave_sum(float v) {
#pragma unroll
  for (int o = 32; o >= 1; o >>= 1) v += __shfl_xor(v, o);
  return v;
}
__device__ __forceinline__ bf16x8 pack8f(const float* v) {
  u32x4 w = {cvtpk(v[0], v[1]), cvtpk(v[2], v[3]), cvtpk(v[4], v[5]), cvtpk(v[6], v[7])};
  return *reinterpret_cast<bf16x8*>(&w);
}

#define XB_TMO      128
#define XB_XCNT(j)  (256  + 64 * (j))
#define XB_XSUB(j)  (1280 + 64 * (j))
#define XB_XGEN(j)  (2304 + 64 * (j))
#define XB_TOP      3328
#define XB_TOPGEN   3392
#define XCD_BAR_WORDS 3456
#define XB_SPIN_CAP (1u << 18)
#define LAS __attribute__((address_space(3)))

__device__ __forceinline__ unsigned xb_ld(unsigned* p)              { return __hip_atomic_load(p, __ATOMIC_RELAXED, __HIP_MEMORY_SCOPE_AGENT); }
__device__ __forceinline__ unsigned xb_add(unsigned* p, unsigned v) { return __hip_atomic_fetch_add(p, v, __ATOMIC_RELAXED, __HIP_MEMORY_SCOPE_AGENT); }
__device__ __forceinline__ unsigned xb_xcc_id() { return (unsigned)__builtin_amdgcn_s_getreg((3 << 11) | 20) & 0xFu; }
#define XB_SPIN(cond, bar) do { unsigned _sp = 0; while (cond) { __builtin_amdgcn_s_sleep(1); \
    if ((++_sp & 255u) == 0u) { if (xb_ld(&(bar)[XB_TMO])) break; if (_sp > XB_SPIN_CAP) { atomicAdd(&(bar)[XB_TMO], 1u); break; } } } } while (0)

struct XcdBarrier {
    unsigned* bar; unsigned x;
    volatile LAS unsigned* st;
};

__device__ __forceinline__ XcdBarrier xcd_barrier_post(unsigned* bar, volatile LAS unsigned* st) {
    XcdBarrier b; b.bar = bar; b.x = xb_xcc_id(); b.st = st;
    if (threadIdx.x == 0) (void)xb_add(&bar[XB_XCNT(b.x)], 1u);
    return b;
}
__device__ __forceinline__ void xcd_barrier_complete(unsigned* bar, unsigned x, unsigned& nloc, unsigned& nx) {
    const unsigned G = gridDim.x * gridDim.y * gridDim.z;
    unsigned sum, cnt, mine, sp = 0u;
    for (;;) {
        sum = 0u; cnt = 0u; mine = 0u;
#pragma unroll
        for (unsigned j = 0; j < 16; ++j) { const unsigned c = xb_ld(&bar[XB_XCNT(j)]); sum += c; cnt += (c > 0u) ? 1u : 0u; mine = (j == x) ? c : mine; }
        if (sum == G) break;
        __builtin_amdgcn_s_sleep(1);
        if ((++sp & 255u) == 0u) { if (xb_ld(&bar[XB_TMO])) break; if (sp > XB_SPIN_CAP) { atomicAdd(&bar[XB_TMO], 1u); break; } }
    }
    nloc = mine > 0u ? mine : 1u; nx = cnt > 0u ? cnt : 1u;
}

__device__ __forceinline__ void xcd_barrier(const XcdBarrier& b) {
    asm volatile("s_waitcnt vmcnt(0)" ::: "memory");
    __syncthreads();
    if (threadIdx.x == 0) {
        unsigned* bar = b.bar;
        __builtin_amdgcn_s_waitcnt(0);
        unsigned nloc = b.st[0], nx = b.st[1];
        if (nloc == 0u) { xcd_barrier_complete(bar, b.x, nloc, nx); b.st[0] = nloc; b.st[1] = nx; }
        const unsigned old = xb_add(&bar[XB_XSUB(b.x)], 1u);
        const unsigned gen = old / nloc;
        if (old + 1u == (gen + 1u) * nloc) {
            __builtin_amdgcn_fence(__ATOMIC_RELEASE, "agent");
            asm volatile("s_waitcnt vmcnt(0)" ::: "memory");
            const unsigned og = xb_add(&bar[XB_TOP], 1u);
            const unsigned tg = og / nx;
            if (og + 1u == (tg + 1u) * nx) xb_add(&bar[XB_TOPGEN], 1u);
            else XB_SPIN(xb_ld(&bar[XB_TOPGEN]) == tg, bar);
            __builtin_amdgcn_fence(__ATOMIC_ACQUIRE, "agent");
            xb_add(&bar[XB_XGEN(b.x)], 1u);
            asm volatile("s_waitcnt vmcnt(0)" ::: "memory");
        } else {
            XB_SPIN(xb_ld(&bar[XB_XGEN(b.x)]) == gen, bar);
            __builtin_amdgcn_fence(__ATOMIC_ACQUIRE, "agent");
            asm volatile("s_waitcnt vmcnt(0)" ::: "memory");
        }
    }
    __syncthreads();
}


template <int NT> __device__ __forceinline__ int ncol(int nt) { return NT == 4 ? ((nt >> 1) * 128 + (nt & 1) * 16) : nt * 16; }

template <int NT>
__device__ __forceinline__ void gemm_main(f32x4 (&acc)[8][NT], const bf16_t* __restrict__ A, int lda, const bf16_t* __restrict__ Bt, int ldb, int K, char* lds) {
  constexpr int BN = NT * 64;
  constexpr int BUF = 32768 + BN * 128;
  const int tid = otid(), lane = tid & 63, wid = tid >> 6, wr = wid >> 2, wc = wid & 3, fr = lane & 15, fq = lane >> 4;
  const int lrow = tid >> 3, sch = (tid & 7) ^ (lrow & 7);
  const char* ga = (const char*)(A + (size_t)lrow * lda + sch * 8);
  const char* gb = (const char*)(Bt + (size_t)lrow * ldb + sch * 8);
#define GDMA(bufp, kt) do { _Pragma("unroll") for (int i = 0; i < 4; ++i) \
      __builtin_amdgcn_global_load_lds((const unsigned*)(ga + ((size_t)i * 64 * lda + (kt) * 64) * 2), (__attribute__((address_space(3))) unsigned*)((bufp) + i * 8192 + tid * 16), 16, 0, 0); \
    _Pragma("unroll") for (int i = 0; i < NT; ++i) \
      __builtin_amdgcn_global_load_lds((const unsigned*)(gb + ((size_t)i * 64 * ldb + (kt) * 64) * 2), (__attribute__((address_space(3))) unsigned*)((bufp) + 32768 + i * 8192 + tid * 16), 16, 0, 0); } while (0)
  const int a0 = (wr * 128 + fr) * 128 + ((fq ^ (fr & 7)) << 4);
  const int a1 = (wr * 128 + fr) * 128 + (((4 + fq) ^ (fr & 7)) << 4);
  const int b0 = 32768 + (wc * 32 + fr) * 128 + ((fq ^ (fr & 7)) << 4);
  const int b1 = 32768 + (wc * 32 + fr) * 128 + (((4 + fq) ^ (fr & 7)) << 4);
  const int nk = K >> 6;
  GDMA(lds, 0); GDMA(lds + BUF, 1);
  asm volatile("s_waitcnt vmcnt(%0)" :: "i"(4 + NT) : "memory");
  __builtin_amdgcn_s_barrier();
  int cur = 0;
#pragma unroll 1
  for (int kt = 0; kt < nk; ++kt) {
    const char* buf = lds + cur * BUF;
    const int nxt2 = cur == 0 ? 2 : cur - 1;
    if (kt + 2 < nk) GDMA(lds + nxt2 * BUF, kt + 2);
    {
      bf16x8 af[8], bfr[NT];
#pragma unroll
      for (int m = 0; m < 8; ++m) af[m] = *(const bf16x8*)(buf + a0 + m * 2048);
#pragma unroll
      for (int nt = 0; nt < NT; ++nt) bfr[nt] = *(const bf16x8*)(buf + b0 + ncol<NT>(nt) * 128);
#pragma unroll
      for (int m = 0; m < 8; ++m)
#pragma unroll
        for (int nt = 0; nt < NT; ++nt) acc[m][nt] = mfma16(bfr[nt], af[m], acc[m][nt]);
    }
    {
      bf16x8 af[8], bfr[NT];
#pragma unroll
      for (int m = 0; m < 8; ++m) af[m] = *(const bf16x8*)(buf + a1 + m * 2048);
#pragma unroll
      for (int nt = 0; nt < NT; ++nt) bfr[nt] = *(const bf16x8*)(buf + b1 + ncol<NT>(nt) * 128);
#pragma unroll
      for (int m = 0; m < 8; ++m)
#pragma unroll
        for (int nt = 0; nt < NT; ++nt) acc[m][nt] = mfma16(bfr[nt], af[m], acc[m][nt]);
    }
    if (kt + 2 < nk) asm volatile("s_waitcnt vmcnt(%0)" :: "i"(4 + NT) : "memory");
    else asm volatile("s_waitcnt vmcnt(0)" ::: "memory");
    asm volatile("s_waitcnt lgkmcnt(0)" ::: "memory");
    __builtin_amdgcn_s_barrier();
    cur = cur == 2 ? 0 : cur + 1;
  }
#undef GDMA
}

template <int NT> __device__ __forceinline__ void zero_acc(f32x4 (&acc)[8][NT]) {
#pragma unroll
  for (int m = 0; m < 8; ++m)
#pragma unroll
    for (int nt = 0; nt < NT; ++nt) acc[m][nt] = (f32x4){0.f, 0.f, 0.f, 0.f};
}

namespace g8 {
constexpr int BK = 64, HALF = 128, HT = HALF * BK;
__device__ __forceinline__ int lds_byte(int r, int c) { const int st = (r >> 4) * 2 + (c >> 5), rr = r & 15, cc = c & 31, ob = rr * 64 + cc * 2; return st * 1024 + (ob ^ (((ob >> 9) & 1) << 5)); }
__device__ __forceinline__ void stage_rc(int b, int& R, int& C) { const int st = b / 1024, sb = b % 1024, swz = sb ^ (((sb >> 9) & 1) << 5); R = (st >> 1) * 16 + swz / 64; C = (st & 1) * 32 + (swz % 64) / 2; }
}
__device__ __forceinline__ void gemm8_main(f32x4 (&acc)[8][4], const bf16_t* __restrict__ A, const bf16_t* __restrict__ Bt, int K, char* lds) {
  using namespace g8;
  bf16_t* shm = (bf16_t*)lds;
  const int tid = otid();
#define SA(b, h) (shm + ((b) * 2 + (h)) * HT)
#define SB(b, h) (shm + (4 + (b) * 2 + (h)) * HT)
#define STAGE(Pp, BASE, br, kt) do { const char* _g = (const char*)((BASE) + (long)(br) * K + (long)(kt) * BK); \
    __builtin_amdgcn_global_load_lds((const unsigned*)(_g + goff0), (__attribute__((address_space(3))) unsigned*)((char*)(Pp) + tid * 16), 16, 0, 0); \
    __builtin_amdgcn_global_load_lds((const unsigned*)(_g + goff1), (__attribute__((address_space(3))) unsigned*)((char*)(Pp) + tid * 16 + 8192), 16, 0, 0); } while (0)
#define LDA(dst, b, h) _Pragma("unroll") for (int m = 0; m < 4; ++m) _Pragma("unroll") for (int k = 0; k < 2; ++k) \
    dst[m][k] = *reinterpret_cast<const bf16x8*>(lds + ((b) * 2 + (h)) * 16384 + aoff + m * 2048 + k * 1024)
#define LDB(dst, b, h) _Pragma("unroll") for (int n = 0; n < 2; ++n) _Pragma("unroll") for (int k = 0; k < 2; ++k) \
    dst[n][k] = *reinterpret_cast<const bf16x8*>(lds + (4 + (b) * 2 + (h)) * 16384 + boff + n * 2048 + k * 1024)
#define MMA(ai, bj, At_, Bt_) do { __builtin_amdgcn_s_setprio(1); \
    _Pragma("unroll") for (int m = 0; m < 4; ++m) _Pragma("unroll") for (int n = 0; n < 2; ++n) _Pragma("unroll") for (int k = 0; k < 2; ++k) \
      acc[(ai) * 4 + m][(bj) * 2 + n] = __builtin_amdgcn_mfma_f32_16x16x32_bf16(Bt_[n][k], At_[m][k], acc[(ai) * 4 + m][(bj) * 2 + n], 0, 0, 0); \
    __builtin_amdgcn_s_setprio(0); } while (0)
#define WAIT_V(n) asm volatile("s_waitcnt vmcnt(" #n ")" ::: "memory")
#define WAIT_L(n) asm volatile("s_waitcnt lgkmcnt(" #n ")" ::: "memory")
#define BAR __builtin_amdgcn_s_barrier()
#define SCHED __builtin_amdgcn_sched_barrier(0)
  const int wid = tid >> 6, lane = tid & 63, wr = wid >> 2, wc = wid & 3, fr = lane & 15, fq = lane >> 4;
  bf16x8 At[4][2], B0[2][2], B1[2][2];
  const int nt = K / BK;
  const int swz_ = (fr * 64 + fq * 16) ^ ((((fr * 64 + fq * 16) >> 9) & 1) << 5);
  const int aoff = wr * 8192 + swz_, boff = wc * 4096 + swz_;
  unsigned goff0, goff1;
  { int r_, c_; stage_rc(tid * 16, r_, c_); goff0 = (unsigned)(r_ * K + c_) * 2u; stage_rc(tid * 16 + 8192, r_, c_); goff1 = (unsigned)(r_ * K + c_) * 2u; }
  STAGE(SB(0, 0), Bt, 0, 0); STAGE(SA(0, 0), A, 0, 0);
  STAGE(SB(0, 1), Bt, HALF, 0); STAGE(SA(0, 1), A, HALF, 0);
  if (wr == 1) BAR;
  WAIT_V(4); BAR;
  STAGE(SB(1, 0), Bt, 0, 1); STAGE(SA(1, 0), A, 0, 1); STAGE(SB(1, 1), Bt, HALF, 1);
  WAIT_V(6); BAR;
  for (int t = 0; t < nt - 2; t += 2) {
    LDB(B0, 0, 0); SCHED; LDA(At, 0, 0); STAGE(SA(1, 1), A, HALF, t + 1);
    WAIT_L(8); BAR; WAIT_L(0); MMA(0, 0, At, B0); BAR; SCHED;
    LDB(B1, 0, 1); STAGE(SB(0, 0), Bt, 0, t + 2);
    BAR; WAIT_L(0); MMA(0, 1, At, B1); BAR;
    LDA(At, 0, 1); STAGE(SA(0, 0), A, 0, t + 2);
    BAR; WAIT_L(0); MMA(1, 0, At, B0); BAR; SCHED;
    STAGE(SB(0, 1), Bt, HALF, t + 2);
    WAIT_V(6); BAR; MMA(1, 1, At, B1); BAR;
    LDB(B0, 1, 0); SCHED; LDA(At, 1, 0); STAGE(SA(0, 1), A, HALF, t + 2);
    WAIT_L(8); BAR; WAIT_L(0); MMA(0, 0, At, B0); BAR; SCHED;
    LDB(B1, 1, 1); STAGE(SB(1, 0), Bt, 0, t + 3);
    BAR; WAIT_L(0); MMA(0, 1, At, B1); BAR;
    LDA(At, 1, 1); STAGE(SA(1, 0), A, 0, t + 3);
    BAR; WAIT_L(0); MMA(1, 0, At, B0); BAR; SCHED;
    STAGE(SB(1, 1), Bt, HALF, t + 3);
    WAIT_V(6); BAR; MMA(1, 1, At, B1); BAR;
  }
  { LDB(B0, 0, 0); LDA(At, 0, 0); STAGE(SA(1, 1), A, HALF, nt - 1);
    BAR; WAIT_L(0); MMA(0, 0, At, B0); BAR;
    LDB(B1, 0, 1); BAR; WAIT_L(0); MMA(0, 1, At, B1); BAR;
    LDA(At, 0, 1); WAIT_V(4); BAR; WAIT_L(0); MMA(1, 0, At, B0); MMA(1, 1, At, B1); BAR; }
  { LDB(B0, 1, 0); LDA(At, 1, 0); WAIT_V(2); BAR; WAIT_L(0); MMA(0, 0, At, B0); BAR;
    LDB(B1, 1, 1); WAIT_V(0); BAR; WAIT_L(0); MMA(0, 1, At, B1); BAR;
    LDA(At, 1, 1); BAR; WAIT_L(0); MMA(1, 0, At, B0); MMA(1, 1, At, B1); BAR; }
  if (wr == 0) BAR;
  __syncthreads();
#undef SA
#undef SB
#undef STAGE
#undef LDA
#undef LDB
#undef MMA
#undef WAIT_V
#undef WAIT_L
#undef BAR
#undef SCHED
}

__device__ __forceinline__ void tr_tile(const float* __restrict__ src, int ld_src, int k0, int scol0, int scol1, bf16_t* __restrict__ dst, int ld_dst, int n_dst0, char* lds) {
  float* t = (float*)lds;
  const int tid = otid();
  {
    const int c4 = (tid & 63) * 4, kq = tid >> 6;
    const int sc = c4 < 128 ? scol0 + c4 : scol1 + (c4 - 128);
    f32x4 v[8];
#pragma unroll
    for (int i = 0; i < 8; ++i) v[i] = *(const f32x4*)(src + (size_t)(k0 + kq + 8 * i) * ld_src + sc);
#pragma unroll
    for (int i = 0; i < 8; ++i) { float* tp = t + (kq + 8 * i) * 257 + c4; tp[0] = v[i][0]; tp[1] = v[i][1]; tp[2] = v[i][2]; tp[3] = v[i][3]; }
  }
  __syncthreads();
  {
    const int n = tid >> 1, kh = (tid & 1) * 32;
    bf16_t* d = dst + (size_t)(n_dst0 + n) * ld_dst + k0 + kh;
#pragma unroll
    for (int q = 0; q < 4; ++q) {
      float v[8];
#pragma unroll
      for (int j = 0; j < 8; ++j) v[j] = t[(kh + q * 8 + j) * 257 + n];
      *(bf16x8*)(d + q * 8) = pack8f(v);
    }
  }
  __syncthreads();
}

__device__ __forceinline__ void s5_tables(const P& p, int unit, char* lds) {
  const int l = unit >> 6, g = unit & 63, lg = l * 64 + g, tid = threadIdx.x;
  f32x2* pw = (f32x2*)lds;
  f32x2* bb = (f32x2*)(lds + 17408);
  f32x2* cw = (f32x2*)(lds + 25600);
  const float dtf = expf(p.log_dt[lg]);
#pragma unroll 1
  for (int idx = tid; idx < 64 * 33; idx += NTHREADS) {
    const int pp = idx / 33, j = idx - pp * 33;
    const float ar = p.a_re[lg * 64 + pp], ai = p.a_im[lg * 64 + pp];
    double rev = (double)ai * (double)dtf * (double)j * 0.15915494309189535;
    rev -= rint(rev);
    const float mag = expf(ar * dtf * (float)j);
    const float rf = (float)rev;
    pw[pp * 34 + j] = (f32x2){mag * __builtin_amdgcn_cosf(rf), mag * __builtin_amdgcn_sinf(rf)};
  }
#pragma unroll 1
  for (int idx = tid; idx < 1024; idx += NTHREADS) {
    const int pp = idx >> 4, c = idx & 15;
    const float ar = p.a_re[lg * 64 + pp], ai = p.a_im[lg * 64 + pp];
    double rev = (double)ai * (double)dtf * 0.15915494309189535;
    rev -= rint(rev);
    const float mag = expf(ar * dtf), rf = (float)rev;
    const float abr = mag * __builtin_amdgcn_cosf(rf), abi = mag * __builtin_amdgcn_sinf(rf);
    const float nr = abr - 1.f, den = ar * ar + ai * ai;
    const float zr = (nr * ar + abi * ai) / den, zi = (abi * ar - nr * ai) / den;
    const float br = p.b_re[(size_t)(lg * 64 + pp) * 16 + c], bi = p.b_im[(size_t)(lg * 64 + pp) * 16 + c];
    bb[idx] = (f32x2){zr * br - zi * bi, zr * bi + zi * br};
    const int c2 = idx >> 6, p2 = idx & 63;
    cw[idx] = (f32x2){p.c_re[(size_t)(lg * 16 + c2) * 64 + p2], p.c_im[(size_t)(lg * 16 + c2) * 64 + p2]};
  }
  __syncthreads();
#pragma unroll 1
  for (int idx = tid; idx < 32 * 256; idx += NTHREADS) {
    const int d = idx >> 8, c = (idx >> 4) & 15, c1 = idx & 15;
    float sum = 0.f;
#pragma unroll 4
    for (int pp = 0; pp < 64; ++pp) {
      const f32x2 w = pw[pp * 34 + d], b = bb[pp * 16 + c1], cv = cw[c * 64 + pp];
      const float tr = w[0] * b[0] - w[1] * b[1], ti = w[0] * b[1] + w[1] * b[0];
      sum += cv[0] * tr - cv[1] * ti;
    }
    p.Ktab[(size_t)(lg * 32 + d) * 256 + c * 16 + c1] = f2bf(sum);
  }
#pragma unroll 2
  for (int idx = tid; idx < 128 * 512; idx += NTHREADS) {
    const int pr = idx >> 9, col = idx & 511, s = col >> 4, c1 = col & 15, pp = pr & 63, im = pr >> 6;
    const f32x2 w = pw[pp * 34 + (SL - 1 - s)], b = bb[pp * 16 + c1];
    const float tr = w[0] * b[0] - w[1] * b[1], ti = w[0] * b[1] + w[1] * b[0];
    p.M1[(size_t)(lg * 128 + pr) * 512 + col] = f2bf(im ? ti : tr);
  }
#pragma unroll 2
  for (int idx = tid; idx < 512 * 128; idx += NTHREADS) {
    const int row = idx >> 7, pr = idx & 127, t = row >> 4, c = row & 15, pp = pr & 63, im = pr >> 6;
    const f32x2 w = pw[pp * 34 + t + 1], cv = cw[c * 64 + pp];
    const float tr = cv[0] * w[0] - cv[1] * w[1], ti = cv[0] * w[1] + cv[1] * w[0];
    p.M2[(size_t)(lg * 512 + row) * 128 + pr] = f2bf(im ? -ti : tr);
  }
  if (tid < 64) { const f32x2 w = pw[tid * 34 + SL]; p.AL[(lg * 64 + tid) * 2] = w[0]; p.AL[(lg * 64 + tid) * 2 + 1] = w[1]; }
  __syncthreads();
}

__device__ __forceinline__ void phase_prep(const P& p, char* lds) {
  constexpr int NT_ALL = 4096 + 256 + 768 + 512;
  const int G = ogdim(), b = obid();
  const bool bal = (G == 256);
  if (bal ? (b < 128) : true) { for (int u = b; u < 128; u += (bal ? 128 : G)) s5_tables(p, u, lds); }
  const int first = bal ? (b < 128 ? b : 2176 + (b - 128)) : b, step = bal ? 128 : G, count = bal ? (b < 128 ? 17 : 27) : (NT_ALL + G - 1) / G;
#pragma unroll 1
  for (int i = 0; i < count; ++i) {
    int u = first + i * step;
    if (u >= NT_ALL) break;
    if (u < 4096) {
      const int l = u >> 11, rem = u & 2047, kt = rem >> 6, ntile = rem & 63, n0 = ntile * 256, s0 = n0 + (n0 >= 9216 ? 8 : 0);
      tr_tile(p.w_in + (size_t)l * DM * INW, INW, kt * 64, s0, s0 + 128, p.WinT + (size_t)l * NZ * DM, DM, n0, lds);
      continue;
    }
    u -= 4096;
    if (u < 256) {
      const int l = u >> 7, rem = u & 127, kt = rem >> 3, j = rem & 7;
      tr_tile(p.w_glu + (size_t)l * HW * 2048, 2048, kt * 64, j * 128, 1024 + j * 128, p.WgluT + (size_t)l * 2048 * HW, HW, j * 256, lds);
      continue;
    }
    u -= 256;
    if (u < 768) {
      const int mat = u >> 7, rem = u & 127, kt = rem >> 3, ntile = rem & 7, l = mat / 3, br = mat - l * 3;
      const float* s = (br == 0 ? p.w_a : br == 1 ? p.w_b : p.w_c) + (size_t)l * HW * DM;
      tr_tile(s, DM, kt * 64, ntile * 256, ntile * 256 + 128, p.WbrT + (size_t)mat * DM * HW, HW, ntile * 256, lds);
      continue;
    }
    u -= 768;
    {
      const int l = u >> 8, rem = u & 255, kt = rem >> 3, ntile = rem & 7;
      tr_tile(p.w_out + (size_t)l * DM * DM, DM, kt * 64, ntile * 256, ntile * 256 + 128, p.WoutT + (size_t)l * DM * DM, DM, ntile * 256, lds);
    }
  }
}

__device__ __forceinline__ void phase_norm(const P& p, int l, char* lds) {
  const float* xin = l == 0 ? p.x : p.xbuf;
  const int tid = otid(), lane = tid & 63, wid = __builtin_amdgcn_readfirstlane(tid >> 6);
  const float* wl = p.w_in + (size_t)l * DM * INW;
#pragma unroll
  for (int i = 0; i < 8; ++i) { const int idx = tid + NTHREADS * i, k = idx >> 1, hf = idx & 1; *(f32x4*)(lds + k * 32 + hf * 16 + (k >> 2) * 16) = *(const f32x4*)(wl + (size_t)k * INW + 9216 + hf * 4); }
  __syncthreads();
  const float* g = p.norm_g + l * DM;
#pragma unroll 1
  for (int row = obid() * 8 + wid; row < S; row += ogdim() * 8) {
    const float* xr = xin + (size_t)row * DM; bf16_t* hrow = p.h + (size_t)row * DM;
    f32x4 xv[8];
    float ss = 0.f;
#pragma unroll
    for (int j = 0; j < 8; ++j) { xv[j] = *(const f32x4*)(xr + (unsigned)(lane + 64 * j) * 4u); ss += xv[j][0] * xv[j][0] + xv[j][1] * xv[j][1] + xv[j][2] * xv[j][2] + xv[j][3] * xv[j][3]; }
    ss = wave_sum(ss);
    const float rstd = rsqrtf(ss * (1.f / DM) + EPS);
    float fa[8] = {0.f, 0.f, 0.f, 0.f, 0.f, 0.f, 0.f, 0.f};
#pragma unroll
    for (int j = 0; j < 8; ++j) {
      const unsigned c = (unsigned)(lane + 64 * j) * 4u;
      const f32x4 gv = *(const f32x4*)(g + c);
      float hv[4];
#pragma unroll
      for (int e = 0; e < 4; ++e) hv[e] = xv[j][e] * rstd * gv[e];
      u32x2 o = {cvtpk(hv[0], hv[1]), cvtpk(hv[2], hv[3])};
      *(u32x2*)(hrow + c) = o;
#pragma unroll
      for (int e = 0; e < 4; ++e) {
        const f32x4 w0 = *(const f32x4*)(lds + (c + e) * 32 + (c >> 2) * 16), w1 = *(const f32x4*)(lds + (c + e) * 32 + 16 + (c >> 2) * 16);
        fa[0] += hv[e] * w0[0]; fa[1] += hv[e] * w0[1]; fa[2] += hv[e] * w0[2]; fa[3] += hv[e] * w0[3];
        fa[4] += hv[e] * w1[0]; fa[5] += hv[e] * w1[1]; fa[6] += hv[e] * w1[2]; fa[7] += hv[e] * w1[3];
      }
      __builtin_amdgcn_sched_barrier(0);
    }
#pragma unroll
    for (int j = 0; j < 8; ++j) fa[j] = wave_sum(fa[j]);
    {
      float v = fa[0];
#pragma unroll
      for (int j = 1; j < 8; ++j) v = (lane == j) ? fa[j] : v;
      if (lane < 8) p.lsf[row * 8 + lane] = logsigf_(v + p.fox_bf[l * 8 + lane]);
    }
  }
  __syncthreads();
}

__device__ __forceinline__ void phase_final_norm(const P& p) {
  const int tid = otid(), lane = tid & 63, wid = __builtin_amdgcn_readfirstlane(tid >> 6);
#pragma unroll 1
  for (int row = obid() * 8 + wid; row < S; row += ogdim() * 8) {
    const float* xr = p.xbuf + (size_t)row * DM;
    f32x4 xv[8];
    float ss = 0.f;
#pragma unroll
    for (int j = 0; j < 8; ++j) { xv[j] = *(const f32x4*)(xr + (lane + 64 * j) * 4); ss += xv[j][0] * xv[j][0] + xv[j][1] * xv[j][1] + xv[j][2] * xv[j][2] + xv[j][3] * xv[j][3]; }
    ss = wave_sum(ss);
    const float rstd = rsqrtf(ss * (1.f / DM) + EPS);
#pragma unroll
    for (int j = 0; j < 8; ++j) {
      const int c = (lane + 64 * j) * 4;
      const f32x4 gv = *(const f32x4*)(p.final_g + c);
      f32x4 o;
#pragma unroll
      for (int e = 0; e < 4; ++e) o[e] = xv[j][e] * rstd * gv[e];
      *(f32x4*)(p.out + (size_t)row * DM + c) = o;
    }
  }
}

__device__ __forceinline__ void phase_gemm_in(const P& p, int l, char* lds) {
  const int tid = otid(), lane = tid & 63, wid = tid >> 6, wr = wid >> 2, wc = wid & 3, fr = lane & 15, fq = lane >> 4;
  for (int t = obid(); t < 32 * 64; t += ogdim()) {
    const int pm = t & 31, pn = t >> 5;
    f32x4 acc[8][4];
    zero_acc<4>(acc);
    gemm8_main(acc, p.h + (size_t)pm * 256 * DM, p.WinT + ((size_t)l * NZ + (size_t)pn * 256) * DM, DM, lds);
    const int region = pn >> 2;
    const int row0 = pm * 256 + wr * 64 + fr;
    const int cbase = (pn & 3) * 256 + wc * 32 + 4 * fq;
    if (region == 1) {
#pragma unroll
      for (int nt = 0; nt < 4; ++nt) {
        const int c = cbase + ncol<4>(nt);
        float lb[4], la[4], l1m[4];
#pragma unroll
        for (int e = 0; e < 4; ++e) {
          lb[e] = l == 0 ? 0.f : sigmoidf_(p.hg_lb[HW + c + e] - p.hg_lb[c + e]);
          la[e] = l == 0 ? -1e30f : __logf(lb[e]);
          l1m[e] = l == 0 ? 0.f : __logf(1.f - lb[e]);
        }
#pragma unroll
        for (int m = 0; m < 8; ++m) {
          const int row = row0 + (m >> 2) * 128 + (m & 3) * 16;
          f32x4 lf; float kk[4];
#pragma unroll
          for (int e = 0; e < 4; ++e) {
            const float z = acc[m][nt][e];
            const float ez = __expf(-fabsf(z));
            const float ls = fminf(z, 0.f) - __logf(1.f + ez);
            const float b = l1m[e] + ls, a = la[e], mx = fmaxf(a, b);
            lf[e] = mx + __logf(1.f + __expf(-fabsf(a - b)));
            const float sneg = (z >= 0.f ? ez : 1.f) * __builtin_amdgcn_rcpf(1.f + ez);
            kk[e] = (1.f - lb[e]) * sneg;
          }
          *(f32x4*)(p.logf + (size_t)row * HW + c) = lf;
          u32x2 o = {cvtpk(kk[0], kk[1]), cvtpk(kk[2], kk[3])};
          *(u32x2*)(p.zb + (size_t)1 * S * HW + (size_t)row * HW + c) = o;
          __builtin_amdgcn_sched_barrier(0);
        }
      }
    } else if (region < 10) {
      const bool act = (region == 3 || region == 5 || region == 9), hm = (region >= 6 && region <= 8);
      bf16_t* dst = p.zb + (size_t)region * S * HW;
#pragma unroll
      for (int m = 0; m < 8; ++m)
#pragma unroll
        for (int nt = 0; nt < 4; ++nt) {
          const int row = row0 + (m >> 2) * 128 + (m & 3) * 16, c = cbase + ncol<4>(nt);
          f32x4 v = acc[m][nt];
          if (act) {
#pragma unroll
            for (int e = 0; e < 4; ++e) v[e] = siluf_(v[e]);
          }
          u32x2 o = {cvtpk(v[0], v[1]), cvtpk(v[2], v[3])};
          if (hm) *(u32x2*)(dst + ((size_t)(c >> 7) * S + row) * 128 + (c & 127)) = o;
          else *(u32x2*)(dst + (size_t)row * HW + c) = o;
          if (nt == 3) __builtin_amdgcn_sched_barrier(0);
        }
    } else {
      const int gc0 = (pn - 40) * 256 + wc * 32 + 4 * fq;
#pragma unroll
      for (int nt = 0; nt < 4; ++nt) {
        const int c = gc0 + ncol<4>(nt);
        const f32x4 bg = *(const f32x4*)(p.b_gate + (size_t)l * 6144 + c);
#pragma unroll
        for (int m = 0; m < 8; ++m) {
          const int row = row0 + (m >> 2) * 128 + (m & 3) * 16;
          f32x4 v = acc[m][nt];
#pragma unroll
          for (int e = 0; e < 4; ++e) v[e] = sigmoidf_(v[e] + bg[e]);
          u32x2 o = {cvtpk(v[0], v[1]), cvtpk(v[2], v[3])};
          *(u32x2*)(p.gates + (size_t)row * 6144 + c) = o;
          if ((m & 3) == 3) __builtin_amdgcn_sched_barrier(0);
        }
      }
    }
  }
}

__device__ __forceinline__ int swz128(int row, int col_elem) {
  return row * 128 + ((((col_elem >> 3) ^ (row & 7))) << 4) + (col_elem & 7) * 2;
}
__device__ __forceinline__ int swz256(int row, int col_elem) {
  return row * 256 + ((((col_elem >> 3) ^ (row & 7))) << 4) + (col_elem & 7) * 2;
}

__device__ __forceinline__ void hg_local(const P& p, int unit, char* lds) {
  const int hh = unit >> 7, n = unit & 127, tok0 = n * 64, colh = hh * 128;
  const int tid = otid(), lane = tid & 63, wid = tid >> 6, fr = lane & 15, fq = lane >> 4;
  float* cum = (float*)lds;
  char* qe = lds + 32768; char* ke = lds + 49152; char* kdT = lds + 65536; char* iT = lds + 81920; char* sc = lds + 98304;
  const bf16_t* hq = p.zb; const bf16_t* hk = p.zb + (size_t)1 * S * HW; const bf16_t* hi = p.zb + (size_t)2 * S * HW;
#pragma unroll
  for (int i = 0; i < 4; ++i) { const int id = tid + NTHREADS * i, t = id >> 5, c4 = (id & 31) * 4;
    *(f32x4*)(cum + t * 128 + c4) = *(const f32x4*)(p.logf + (size_t)(tok0 + t) * HW + colh + c4); }
  u32x4 q8a[2], k8a[2], i8a[2];
#pragma unroll
  for (int i = 0; i < 2; ++i) {
    const int id = tid + NTHREADS * i, t = id >> 4, k0 = (id & 15) * 8;
    const size_t gofs = (size_t)(tok0 + t) * HW + colh + k0;
    q8a[i] = *(const u32x4*)(hq + gofs); k8a[i] = *(const u32x4*)(hk + gofs); i8a[i] = *(const u32x4*)(hi + gofs);
  }
  __syncthreads();
  {
    const int k = tid & 127, part = tid >> 7;
    float run = 0.f;
    for (int t = 16 * part; t < 16 * part + 16; ++t) { run += cum[t * 128 + k]; cum[t * 128 + k] = run; }
    __syncthreads();
    float off = 0.f;
    for (int pp = 0; pp < part; ++pp) off += cum[(16 * pp + 15) * 128 + k];
    __syncthreads();
    if (part) for (int t = 16 * part; t < 16 * part + 16; ++t) cum[t * 128 + k] += off;
  }
  __syncthreads();
#pragma unroll
  for (int i = 0; i < 2; ++i) {
    const int id = tid + NTHREADS * i, t = id >> 4, k0 = (id & 15) * 8;
    const size_t gofs = (size_t)(tok0 + t) * HW + colh + k0;
    const u32x4 q8 = q8a[i], k8 = k8a[i], i8 = i8a[i];
    float qv[8], kv[8], iv[8], c8[8], r8[8], l8[8];
#pragma unroll
    for (int j = 0; j < 4; ++j) { qv[2 * j] = bflo(q8[j]); qv[2 * j + 1] = bfhi(q8[j]); kv[2 * j] = bflo(k8[j]); kv[2 * j + 1] = bfhi(k8[j]); iv[2 * j] = bflo(i8[j]); iv[2 * j + 1] = bfhi(i8[j]); }
#pragma unroll
    for (int j = 0; j < 8; ++j) { c8[j] = cum[t * 128 + k0 + j]; r8[j] = cum[31 * 128 + k0 + j]; l8[j] = cum[63 * 128 + k0 + j]; }
    float qe8[8], ke8[8], qd8[8];
#pragma unroll
    for (int j = 0; j < 8; ++j) {
      qe8[j] = qv[j] * __expf(c8[j] - r8[j]);
      ke8[j] = kv[j] * __expf(r8[j] - c8[j]);
      qd8[j] = qv[j] * __expf(c8[j]);
      const float kd = kv[j] * __expf(l8[j] - c8[j]);
      *(bf16_t*)(kdT + swz128(k0 + j, t)) = f2bf(kd);
      *(bf16_t*)(iT + swz128(k0 + j, t)) = (bf16_t)((j & 1) ? (i8[j >> 1] >> 16) : (i8[j >> 1] & 0xffffu));
    }
    *(bf16x8*)(qe + swz256(t, k0)) = pack8f(qe8);
    *(bf16x8*)(ke + swz256(t, k0)) = pack8f(ke8);
    *(bf16x8*)(p.qd + gofs) = pack8f(qd8);
  }
  if (tid < 128) p.elast[(size_t)(hh * 128 + n) * 128 + tid] = __expf(cum[63 * 128 + tid]);
  __syncthreads();
  {
    const int tt = wid >> 1;
#pragma unroll
    for (int e = 0; e < 2; ++e) {
      const int st = (wid & 1) * 2 + e;
      f32x4 a = {0.f, 0.f, 0.f, 0.f};
      if (st <= tt) {
#pragma unroll
        for (int kk = 0; kk < 4; ++kk) {
          const bf16x8 X = *(const bf16x8*)(ke + swz256(st * 16 + fr, kk * 32 + fq * 8));
          const bf16x8 Y = *(const bf16x8*)(qe + swz256(tt * 16 + fr, kk * 32 + fq * 8));
          a = mfma16(X, Y, a);
        }
      }
      const int t = tt * 16 + fr, s0 = st * 16 + 4 * fq;
#pragma unroll
      for (int r = 0; r < 4; ++r) if (s0 + r > t) a[r] = 0.f;
      u32x2 o = {cvtpk(a[0], a[1]), cvtpk(a[2], a[3])};
      *(u32x2*)(sc + swz128(t, s0)) = o;
    }
  }
  __syncthreads();
  {
    const int tt = wid & 3;
#pragma unroll
    for (int e = 0; e < 4; ++e) {
      const int vt = (wid >> 2) * 4 + e;
      f32x4 a = {0.f, 0.f, 0.f, 0.f};
#pragma unroll
      for (int kk = 0; kk < 2; ++kk) {
        const bf16x8 X = *(const bf16x8*)(iT + swz128(vt * 16 + fr, kk * 32 + fq * 8));
        const bf16x8 Y = *(const bf16x8*)(sc + swz128(tt * 16 + fr, kk * 32 + fq * 8));
        a = mfma16(X, Y, a);
      }
      *(f32x4*)(p.oin + (size_t)(tok0 + tt * 16 + fr) * HW + colh + vt * 16 + 4 * fq) = a;
    }
  }
  {
    const int vt = wid;
#pragma unroll
    for (int kt = 0; kt < 8; ++kt) {
      f32x4 a = {0.f, 0.f, 0.f, 0.f};
#pragma unroll
      for (int kk = 0; kk < 2; ++kk) {
        const bf16x8 X = *(const bf16x8*)(kdT + swz128(kt * 16 + fr, kk * 32 + fq * 8));
        const bf16x8 Y = *(const bf16x8*)(iT + swz128(vt * 16 + fr, kk * 32 + fq * 8));
        a = mfma16(X, Y, a);
      }
      { u32x2 o = {cvtpk(a[0], a[1]), cvtpk(a[2], a[3])}; *(u32x2*)((bf16_t*)p.SlocT + ((size_t)(hh * 128 + n) * 128 + vt * 16 + fr) * 128 + kt * 16 + 4 * fq) = o; }
    }
  }
  __syncthreads();
}

__device__ __forceinline__ void s5_local(const P& p, int l, int unit, char* lds) {
  const int g = unit >> 1, half = unit & 1;
  const int tid = otid(), lane = tid & 63, wid = tid >> 6, fr = lane & 15, fq = lane >> 4;
  const int cb = half * 8 + wid, n = 16 * cb + fr;
  const bf16_t* su = p.zb + (size_t)4 * S * HW;
  const bf16_t* M1 = p.M1 + (size_t)(l * 64 + g) * 128 * 512;
#pragma unroll 4
  for (int i = 0; i < 16; ++i) {
    const int idx = tid + NTHREADS * i, row = idx >> 6, ch = idx & 63;
    *(u32x4*)(lds + row * 1024 + ((ch ^ (row & 15)) << 4)) = *(const u32x4*)(M1 + row * 512 + ch * 8);
  }
  bf16x8 Y[16];
#pragma unroll
  for (int kk = 0; kk < 16; ++kk) Y[kk] = *(const bf16x8*)(su + (size_t)(n * SL + 2 * kk + (fq >> 1)) * HW + g * 16 + (fq & 1) * 8);
  __syncthreads();
  f32x4 acc[8];
#pragma unroll
  for (int i = 0; i < 8; ++i) acc[i] = (f32x4){0.f, 0.f, 0.f, 0.f};
#pragma unroll
  for (int kk = 0; kk < 16; ++kk) {
#pragma unroll
    for (int pt = 0; pt < 8; ++pt) {
      const bf16x8 X = *(const bf16x8*)(lds + (pt * 16 + fr) * 1024 + (((kk * 4 + fq) ^ fr) << 4));
      acc[pt] = mfma16(X, Y[kk], acc[pt]);
    }
    if ((kk & 1) == 1) __builtin_amdgcn_sched_barrier(0);
  }
#pragma unroll
  for (int pt = 0; pt < 8; ++pt) *(f32x4*)(p.Xloc + ((size_t)g * NCH + n) * 128 + pt * 16 + 4 * fq) = acc[pt];
  __syncthreads();
}

__device__ __forceinline__ void fox_cumsum(const P& p, int hh, char* lds) {
  float* wt = (float*)lds;
  const int tid = otid(), lane = tid & 63, wid = tid >> 6;
  float v[16];
  float run = 0.f;
#pragma unroll
  for (int j = 0; j < 16; ++j) { run += p.lsf[(tid * 16 + j) * 8 + hh]; v[j] = run; }
  float inc = run;
#pragma unroll
  for (int o = 1; o < 64; o <<= 1) { const float t = __shfl_up(inc, o); if (lane >= o) inc += t; }
  if (lane == 63) wt[wid] = inc;
  __syncthreads();
  float base = inc - run;
  for (int w = 0; w < wid; ++w) base += wt[w];
#pragma unroll
  for (int j = 0; j < 16; ++j) p.cc[hh * S + tid * 16 + j] = base + v[j];
  __syncthreads();
}

__device__ __forceinline__ void phase_local(const P& p, int l, char* lds) {
  constexpr int NU = 1024 + 128 + 8;
  for (int u = obid(); u < NU; u += ogdim()) {
    if (u < 1024) hg_local(p, u, lds);
    else if (u < 1152) { const int j = u - 1024; s5_local(p, l, ((j & 7) << 4) | (j >> 3), lds); }
    else fox_cumsum(p, u - 1152, lds);
  }
}

__device__ __forceinline__ void phase_scan(const P& p, int l) {
  constexpr int NU = 128 + 8;
  const int tid = otid();
  for (int u = obid(); u < NU; u += ogdim()) {
    if (u < 128) {
      const int e2 = u * NTHREADS + tid, hh = e2 >> 13, rem = e2 & 8191, v = rem >> 6, k = (rem & 63) * 2;
      float s0 = 0.f, s1 = 0.f;
#pragma unroll 16
      for (int n = 0; n < 128; ++n) {
        const size_t idx = ((size_t)(hh * 128 + n) * 128 + v) * 128 + k;
        const unsigned lu = *(const unsigned*)((const bf16_t*)p.SlocT + idx); const f32x2 loc = {bflo(lu), bfhi(lu)};
        const f32x2 el = *(const f32x2*)(p.elast + (size_t)(hh * 128 + n) * 128 + k);
        *(unsigned*)(p.SprevT + idx) = cvtpk(s0, s1);
        s0 = el[0] * s0 + loc[0]; s1 = el[1] * s1 + loc[1];
      }
    } else {
      const int gid = (u - 128) * NTHREADS + tid, g = gid >> 6, pp = gid & 63;
      const float ar = p.AL[((l * 64 + g) * 64 + pp) * 2], ai = p.AL[((l * 64 + g) * 64 + pp) * 2 + 1];
      float sr = 0.f, si = 0.f;
#pragma unroll 16
      for (int n = 0; n < NCH; ++n) {
        const size_t idx = ((size_t)g * NCH + n) * 128 + pp;
        const float xr = p.Xloc[idx], xi = p.Xloc[idx + 64];
        p.Xprev[idx] = f2bf(sr); p.Xprev[idx + 64] = f2bf(si);
        const float nr = ar * sr - ai * si + xr, ni = ar * si + ai * sr + xi;
        sr = nr; si = ni;
      }
    }
  }
}

__device__ __forceinline__ void hg_out(const P& p, int l, int bu) {
  const int hh = bu >> 6, np = bu & 63;
  const int tid = otid(), lane = tid & 63, wid = tid >> 6, fr = lane & 15, fq = lane >> 4;
  const int n = np * 2 + (wid >> 2), tt = wid & 3, colh = hh * 128;
  const int token = n * 64 + tt * 16 + fr;
  const bf16_t* sp = p.SprevT + (size_t)(hh * 128 + n) * 128 * 128;
  f32x4 acc[8];
#pragma unroll
  for (int i = 0; i < 8; ++i) acc[i] = (f32x4){0.f, 0.f, 0.f, 0.f};
#pragma unroll
  for (int kk = 0; kk < 4; ++kk) {
    const bf16x8 Y = *(const bf16x8*)(p.qd + (size_t)token * HW + colh + kk * 32 + fq * 8);
#pragma unroll
    for (int vt = 0; vt < 8; ++vt) {
      const bf16x8 X = *(const bf16x8*)(sp + (size_t)(vt * 16 + fr) * 128 + kk * 32 + fq * 8);
      acc[vt] = mfma16(X, Y, acc[vt]);
    }
  }
  float ss = 0.f;
#pragma unroll
  for (int vt = 0; vt < 8; ++vt) {
    const f32x4 o = *(const f32x4*)(p.oin + (size_t)token * HW + colh + vt * 16 + 4 * fq);
    acc[vt] += o;
    ss += acc[vt][0] * acc[vt][0] + acc[vt][1] * acc[vt][1] + acc[vt][2] * acc[vt][2] + acc[vt][3] * acc[vt][3];
  }
  ss += __shfl_xor(ss, 16);
  ss += __shfl_xor(ss, 32);
  const float rstd = rsqrtf(ss * (1.f / 128.f) + EPS);
  const bf16_t* sg = p.zb + (size_t)3 * S * HW;
#pragma unroll
  for (int vt = 0; vt < 8; ++vt) {
    const int c = colh + vt * 16 + 4 * fq;
    const f32x4 gn = *(const f32x4*)(p.hg_norm_g + l * HW + c);
    const u32x2 gt = *(const u32x2*)(sg + (size_t)token * HW + c);
    const float o0 = acc[vt][0] * rstd * gn[0] * bflo(gt[0]), o1 = acc[vt][1] * rstd * gn[1] * bfhi(gt[0]);
    const float o2 = acc[vt][2] * rstd * gn[2] * bflo(gt[1]), o3 = acc[vt][3] * rstd * gn[3] * bfhi(gt[1]);
    u32x2 o = {cvtpk(o0, o1), cvtpk(o2, o3)};
    *(u32x2*)(p.oa + (size_t)token * HW + c) = o;
  }
}

__device__ __forceinline__ void s5_out(const P& p, int l, int unit, char* lds) {
  const int g = unit >> 1, half = unit & 1;
  const int tid = otid(), lane = tid & 63, wid = tid >> 6, fr = lane & 15, fq = lane >> 4;
  const int cb = half * 8 + wid, n = 16 * cb + fr;
  const bf16_t* su = p.zb + (size_t)4 * S * HW;
  const bf16_t* M2 = p.M2 + (size_t)(l * 64 + g) * 512 * 128;
  {
    const u32x4* src = (const u32x4*)(p.Ktab + (size_t)(l * 64 + g) * 32 * 256);
    u32x4* dst = (u32x4*)(lds + 512);
    dst[tid] = src[tid]; dst[tid + 512] = src[tid + 512];
    if (tid < 32) { unsigned z = 0u; asm volatile("" : "+v"(z)); ((u32x4*)lds)[tid] = (u32x4){z, z, z, z}; }
#pragma unroll 4
    for (int i = 0; i < 16; ++i) {
      const int idx = tid + NTHREADS * i, row = idx >> 4, ch = idx & 15;
      *(u32x4*)(lds + 17408 + row * 256 + ((ch ^ (row & 15)) << 4)) = *(const u32x4*)(M2 + row * 128 + ch * 8);
    }
  }
  __syncthreads();
  const char* tb = lds + ((1 - (fq >> 1)) * 256 + fr * 16 + (fq & 1) * 8) * 2;
  bf16x8 U[16], Xp[4];
#pragma unroll
  for (int kk = 0; kk < 16; ++kk) U[kk] = *(const bf16x8*)(su + (n * SL + 2 * kk + (fq >> 1)) * HW + g * 16 + (fq & 1) * 8);
#pragma unroll
  for (int kk = 0; kk < 4; ++kk) Xp[kk] = *(const bf16x8*)(p.Xprev + (g * NCH + n) * 128 + kk * 32 + fq * 8);
  const f32x4 dsk = *(const f32x4*)(p.s5_d + l * HW + g * 16 + 4 * fq);
#pragma unroll
  for (int th = 0; th < 2; ++th) {
    f32x4 acc[16];
#pragma unroll
    for (int ti = 0; ti < 16; ++ti) acc[ti] = (f32x4){0.f, 0.f, 0.f, 0.f};
#pragma unroll
    for (int kk = 0; kk < 4; ++kk) {
#pragma unroll
      for (int ti = 0; ti < 16; ++ti) {
        const int t = 16 * th + ti;
        const bf16x8 X = *(const bf16x8*)(lds + 17408 + (t * 16 + fr) * 256 + (((kk * 4 + fq) ^ fr) << 4));
        acc[ti] = mfma16(X, Xp[kk], acc[ti]);
        if ((ti & 7) == 7) __builtin_amdgcn_sched_barrier(0);
      }
    }
#pragma unroll
    for (int kk = 0; kk < 8 * th + 8; ++kk) {
#pragma unroll
      for (int ti = 0; ti < 16; ++ti) {
        const int t = 16 * th + ti;
        if (t >= 2 * kk) {
          const bf16x8 X = *(const bf16x8*)(tb + (t - 2 * kk) * 512);
          acc[ti] = mfma16(X, U[kk], acc[ti]);
        }
        if ((ti & 7) == 7) __builtin_amdgcn_sched_barrier(0);
      }
    }
#pragma unroll
    for (int ti = 0; ti < 16; ++ti) {
      const int t = 16 * th + ti;
      const int o = (n * SL + t) * HW + g * 16 + 4 * fq;
      const u32x2 uu = *(const u32x2*)(su + o);
      const float y0 = gelu_tanh(acc[ti][0] + dsk[0] * bflo(uu[0])), y1 = gelu_tanh(acc[ti][1] + dsk[1] * bfhi(uu[0]));
      const float y2 = gelu_tanh(acc[ti][2] + dsk[2] * bflo(uu[1])), y3 = gelu_tanh(acc[ti][3] + dsk[3] * bfhi(uu[1]));
      u32x2 ov = {cvtpk(y0, y1), cvtpk(y2, y3)};
      *(u32x2*)(p.yg + o) = ov;
      if ((ti & 3) == 3) __builtin_amdgcn_sched_barrier(0);
    }
  }
  __syncthreads();
}

__device__ __forceinline__ void phase_out(const P& p, int l, char* lds) {
  const int G = ogdim(), b = obid();
  if (G == 256) {
    if (b < 128) s5_out(p, l, ((b & 7) << 4) | (b >> 3), lds);
    const int u0 = b < 128 ? 384 + b : (b - 128) * 3, n = b < 128 ? 1 : 3;
#pragma unroll 1
    for (int i = 0; i < n; ++i) hg_out(p, l, u0 + i);
  } else {
#pragma unroll 1
    for (int u = b; u < 512; u += G) hg_out(p, l, u);
#pragma unroll 1
    for (int u = b; u < 128; u += G) s5_out(p, l, u, lds);
  }
}

namespace fa {
constexpr int D = 128, QBLK = 32, KVBLK = 64, QB = 256, LD = 1024, LDQ = 128;
constexpr int SHM_V = 16384, SHM_K = 16384;
constexpr int OFF_WS = 2 * SHM_V + 2 * SHM_K, OFF_BIAS = 69632;
constexpr float SCALE = 0.08838834764831845f, SQRTD = 11.313708498984761f, THR = 8.f;
constexpr unsigned WBIG = 0x40000000u;
#define KSWZ(row, colB) ((row) * 256 + ((colB) ^ (((row) & 7) << 4)))
#define SBAR() __builtin_amdgcn_sched_barrier(0)
__device__ __forceinline__ int v_st(int k, int c) { const int kk = (k & ~0xC) | ((k & 4) << 1) | ((k & 8) >> 1); return ((kk >> 3) * 4 + (c >> 5)) * 512 + ((kk & 7) * 32 + (c & 31)) * 2; }
__device__ __forceinline__ int v_rd_base(int lane) { return ((lane & 3) << 3) | (((lane >> 2) & 3) << 6) | (((lane >> 4) & 1) << 5) | (((lane >> 5) & 1) << 8); }
constexpr int v_rd_off(int d0, int ks, int half) { return d0 * 512 + ks * 4096 + half * 2048; }
__device__ __forceinline__ int crow(int r, int hi) { return (r & 3) + 8 * (r >> 2) + 4 * hi; }
__device__ __forceinline__ unsigned cvtpkv(float lo, float hi) { unsigned r; asm volatile("v_cvt_pk_bf16_f32 %0, %1, %2" : "=v"(r) : "v"(lo), "v"(hi)); return r; }

__device__ __forceinline__ void mask_tile(f32x16& p0, f32x16& p1, int dq, unsigned W) {
  const float NEG = -__builtin_inff();
#pragma unroll
  for (int r = 0; r < 16; ++r) {
    const int c = (r & 3) + 8 * (r >> 2);
    if ((unsigned)(dq - c) >= W) p0[r] = NEG;
    if ((unsigned)(dq - c - 32) >= W) p1[r] = NEG;
  }
}
__device__ __forceinline__ void partialSM(f32x16& p0, f32x16& p1, float& m_reg, float& mn, float& alpha) {
  float pmax = p0[0];
#pragma unroll
  for (int r = 1; r < 16; ++r) pmax = fmaxf(pmax, p0[r]);
#pragma unroll
  for (int r = 0; r < 16; ++r) pmax = fmaxf(pmax, p1[r]);
  { auto rr = __builtin_amdgcn_permlane32_swap(__float_as_uint(pmax), __float_as_uint(pmax), false, false);
    pmax = fmaxf(__uint_as_float(rr[0]), __uint_as_float(rr[1])); }
  constexpr float C2 = 1.4426950408889634f * SCALE;
  if (__builtin_expect(__all((pmax - m_reg) * SCALE <= THR), 1)) { mn = m_reg; alpha = 1.f; }
  else { mn = fmaxf(m_reg, pmax); alpha = __builtin_amdgcn_exp2f((m_reg - mn) * C2); m_reg = mn; }
  const float mnL = -mn * C2;
#pragma unroll
  for (int r = 0; r < 16; ++r) p0[r] = fmaf(p0[r], C2, mnL);
#pragma unroll
  for (int r = 0; r < 16; ++r) p1[r] = fmaf(p1[r], C2, mnL);
#pragma unroll
  for (int r = 0; r < 16; ++r) p0[r] = __builtin_amdgcn_exp2f(p0[r]);
}
__device__ __forceinline__ void finishSM(f32x16& p0, f32x16& p1, float alpha, float& l_reg, bf16x8& pa0, bf16x8& pa1, bf16x8& pa2, bf16x8& pa3) {
#pragma unroll
  for (int r = 0; r < 16; ++r) p1[r] = __builtin_amdgcn_exp2f(p1[r]);
  float ps = 0;
#pragma unroll
  for (int r = 0; r < 16; ++r) ps += p0[r];
#pragma unroll
  for (int r = 0; r < 16; ++r) ps += p1[r];
  { auto rr = __builtin_amdgcn_permlane32_swap(__float_as_uint(ps), __float_as_uint(ps), false, false);
    ps = __uint_as_float(rr[0]) + __uint_as_float(rr[1]); }
  l_reg = l_reg * alpha + ps;
#define PK4(Pv, B_, OUT) do { unsigned a0 = cvtpkv(Pv[B_+0], Pv[B_+1]), a1 = cvtpkv(Pv[B_+2], Pv[B_+3]); \
    unsigned b0 = cvtpkv(Pv[B_+4], Pv[B_+5]), b1 = cvtpkv(Pv[B_+6], Pv[B_+7]); \
    auto r0 = __builtin_amdgcn_permlane32_swap(a0, b0, false, false); auto r1 = __builtin_amdgcn_permlane32_swap(a1, b1, false, false); \
    u32x4 w = {r0[0], r1[0], r0[1], r1[1]}; OUT = *reinterpret_cast<bf16x8*>(&w); } while (0)
  PK4(p0, 0, pa0); PK4(p0, 8, pa1); PK4(p1, 0, pa2); PK4(p1, 8, pa3);
#undef PK4
}
template <int KB>
__device__ __forceinline__ void qkt(f32x16& p0, f32x16& p1, const char* lds, int r32, int hi, const bf16x8* qr) {
  const char* K_lds = lds + 2 * SHM_V;
  p0 = f32x16{}; p1 = f32x16{};
  const char* kb[4];
#pragma unroll
  for (int dd = 0; dd < 4; ++dd) kb[dd] = K_lds + KB * SHM_K + KSWZ(r32, (dd * 16 + hi * 8) * 2);
#pragma unroll
  for (int d0 = 0; d0 < 8; ++d0) { const char* a = kb[d0 & 3] + (d0 >> 2) * 128;
    bf16x8 b0 = *reinterpret_cast<const bf16x8*>(a);
    bf16x8 b1 = *reinterpret_cast<const bf16x8*>(a + 32 * 256);
    p0 = __builtin_amdgcn_mfma_f32_32x32x16_bf16(b0, qr[d0], p0, 0, 0, 0);
    p1 = __builtin_amdgcn_mfma_f32_32x32x16_bf16(b1, qr[d0], p1, 0, 0, 0); }
}
__device__ __forceinline__ void add_bias(f32x16& p0, f32x16& p1, const char* lds, int hi, int kbase) {
  const float* bb = (const float*)(lds + OFF_BIAS) + kbase + 4 * hi;
#pragma unroll
  for (int j = 0; j < 4; ++j) {
    const f32x4 t0 = *(const f32x4*)(bb + 8 * j), t1 = *(const f32x4*)(bb + 32 + 8 * j);
    p0[4 * j] += t0[0]; p0[4 * j + 1] += t0[1]; p0[4 * j + 2] += t0[2]; p0[4 * j + 3] += t0[3];
    p1[4 * j] += t1[0]; p1[4 * j + 1] += t1[1]; p1[4 * j + 2] += t1[2]; p1[4 * j + 3] += t1[3];
  }
}
template <int VB>
__device__ __forceinline__ void pv_tile(f32x16* o, int vb0, bf16x8 pa0, bf16x8 pa1, bf16x8 pa2, bf16x8 pa3) {
#define TRRD(dst, off) asm volatile("ds_read_b64_tr_b16 %0, %1 offset:%2" : "=&v"(dst) : "v"(vb0), "i"(off) : "memory")
#define PV_D0(d0) do { s16x4 l0, l1, l2, l3, h0, h1, h2, h3; constexpr int b_ = VB * SHM_V + v_rd_off(d0, 0, 0); \
    TRRD(l0, b_); TRRD(h0, b_ + 2048); TRRD(l1, b_ + 4096); TRRD(h1, b_ + 6144); TRRD(l2, b_ + 8192); TRRD(h2, b_ + 10240); TRRD(l3, b_ + 12288); TRRD(h3, b_ + 14336); \
    asm volatile("s_waitcnt lgkmcnt(0)" ::: "memory"); SBAR(); \
    o[d0] = __builtin_amdgcn_mfma_f32_32x32x16_bf16(pa0, (bf16x8){l0[0], l0[1], l0[2], l0[3], h0[0], h0[1], h0[2], h0[3]}, o[d0], 0, 0, 0); \
    o[d0] = __builtin_amdgcn_mfma_f32_32x32x16_bf16(pa1, (bf16x8){l1[0], l1[1], l1[2], l1[3], h1[0], h1[1], h1[2], h1[3]}, o[d0], 0, 0, 0); \
    o[d0] = __builtin_amdgcn_mfma_f32_32x32x16_bf16(pa2, (bf16x8){l2[0], l2[1], l2[2], l2[3], h2[0], h2[1], h2[2], h2[3]}, o[d0], 0, 0, 0); \
    o[d0] = __builtin_amdgcn_mfma_f32_32x32x16_bf16(pa3, (bf16x8){l3[0], l3[1], l3[2], l3[3], h3[0], h3[1], h3[2], h3[3]}, o[d0], 0, 0, 0); } while (0)
  PV_D0(0); PV_D0(1); PV_D0(2); PV_D0(3);
#undef PV_D0
#undef TRRD
}

struct BlockRef { const bf16_t* Q; const bf16_t* K; const bf16_t* V; const bf16_t* G; bf16_t* O; const float* C; int P0; };
struct Seam { bf16x8 qr[8]; bf16x8 st_v0, st_v1, st_k0, st_k1; };

#define ROWP(pp, k0, rr) ((pp) + (size_t)((k0) + (rr)) * LDQ + sc)
#define VMW() asm volatile("s_waitcnt vmcnt(0)" ::: "memory")
#define VMWN(n) asm volatile("s_waitcnt vmcnt(%0)" :: "i"(n) : "memory")
#define LD8(ptr) (*reinterpret_cast<const bf16x8*>(ptr))
#define SLOAD_H(ref, k0) do { S.st_v0 = LD8(ROWP((ref).V, k0, sr)); S.st_v1 = LD8(ROWP((ref).V, k0, 32 + sr)); \
    S.st_k0 = LD8(ROWP((ref).K, k0, sr)); S.st_k1 = LD8(ROWP((ref).K, k0, 32 + sr)); } while (0)
#define SWRITE_HK(bf) do { *(bf16x8*)(K_lds + (bf) * SHM_K + kws) = S.st_k0; *(bf16x8*)(K_lds + (bf) * SHM_K + kws + 32 * 256) = S.st_k1; } while (0)
#define SWRITE_HV(bf) do { *(bf16x8*)(V_lds + (bf) * SHM_V + vst0) = S.st_v0; *(bf16x8*)(V_lds + (bf) * SHM_V + vst1) = S.st_v1; } while (0)
#define SWRITE_H(bf) do { SWRITE_HV(bf); SWRITE_HK(bf); } while (0)

__device__ __forceinline__ void prime(const BlockRef& cur, int j_lo, int j_hi, char* lds, Seam& S) {
  const int tid = otid(), wid = __builtin_amdgcn_readfirstlane(tid >> 6), lane = tid & 63, r32 = lane & 31, hi = lane >> 5;
  const int sr = tid >> 4, sc = (tid & 15) * 8, kws = KSWZ(sr, sc * 2); char* K_lds = lds + 2 * SHM_V;
  const float cref = cur.C[cur.P0 + QB - 1];
#pragma unroll
  for (int d0 = 0; d0 < 8; ++d0) S.qr[d0] = LD8(cur.Q + (size_t)(wid * QBLK + r32) * LDQ + d0 * 16 + hi * 8);
  SLOAD_H(cur, j_lo * KVBLK);
  { float* ct = (float*)(lds + OFF_BIAS); const int k1 = j_hi * KVBLK;
#pragma unroll 4
    for (int i = j_lo * KVBLK + tid; i < k1; i += NTHREADS) ct[i] = (cref - cur.C[i]) * SQRTD; }
  VMW(); SWRITE_HK(0);
  __syncthreads();
}

__device__ __forceinline__ void block(const BlockRef& cur, int j_lo, int j_hi, float* opart, float* mlpart, char* lds, Seam& S) {
  const int tid = otid(), wid = __builtin_amdgcn_readfirstlane(tid >> 6), lane = tid & 63, r32 = lane & 31, hi = lane >> 5;
  const int NT = j_hi - j_lo;
  const int qlo = cur.P0 + wid * QBLK, qm = qlo + r32 - 4 * hi;
  char* V_lds = lds; char* K_lds = lds + 2 * SHM_V;
  float* ws = (float*)(lds + OFF_WS) + wid * 64; float* li_l = ws, * al_l = ws + 32;
  float m_reg = -1e30f, l_reg = 0; f32x16 o[4] = {};
  const int sr = tid >> 4, sc = (tid & 15) * 8, vst0 = v_st(sr, sc), vst1 = v_st(32 + sr, sc), kws = KSWZ(sr, sc * 2);
  const int vb0 = (int)(uintptr_t)V_lds + v_rd_base(lane);
#define RESC(a) do { if (__any((a) < 1.f)) { if (hi == 0) al_l[r32] = (a); asm volatile("s_waitcnt lgkmcnt(0)" ::: "memory"); \
    for (int d_ = 0; d_ < 4; ++d_) for (int r = 0; r < 16; ++r) o[d_][r] *= al_l[crow(r, hi)]; } } while (0)
#define KBASE(t) ((j_lo + (t)) * KVBLK)
#define MASKT(P0_, P1_, t) do { const int kb_ = KBASE(t); if (kb_ + KVBLK - 1 > qlo) mask_tile(P0_, P1_, qm - kb_, WBIG); } while (0)
  constexpr int NQL = 8;
#define SEAM_K0() do { VMWN(NQL); SWRITE_HK(0); SBAR(); } while (0)
  f32x16 pA0, pA1, pB0, pB1; float mnA, mnB, alA, alB; bf16x8 pa0, pa1, pa2, pa3;
  SWRITE_HV(0); SBAR();
  if (NT > 1) { SLOAD_H(cur, KBASE(1)); }
  SBAR(); qkt<0>(pA0, pA1, lds, r32, hi, S.qr);
  add_bias(pA0, pA1, lds, hi, KBASE(0)); MASKT(pA0, pA1, 0); partialSM(pA0, pA1, m_reg, mnA, alA);
  if (NT > 1) { VMW(); SWRITE_H(1); }
  __syncthreads();
#define HALF_STEP(PX0, PX1, mnX, alX, PY0, PY1, alY, t, KB, VB, SB) do { \
    SBAR(); qkt<KB>(PX0, PX1, lds, r32, hi, S.qr); \
    finishSM(PY0, PY1, alY, l_reg, pa0, pa1, pa2, pa3); SBAR(); \
    if ((t) + 1 < NT) { SLOAD_H(cur, KBASE((t) + 1)); SBAR(); } \
    pv_tile<VB>(o, vb0, pa0, pa1, pa2, pa3); add_bias(PX0, PX1, lds, hi, KBASE(t)); MASKT(PX0, PX1, (t)); partialSM(PX0, PX1, m_reg, mnX, alX); \
    __syncthreads(); \
    if ((t) + 1 < NT) { VMW(); SWRITE_H(SB); } \
    RESC(alX); __syncthreads(); } while (0)
  for (int t = 1; t + 1 < NT; t += 2) {
    HALF_STEP(pB0, pB1, mnB, alB, pA0, pA1, alA, t, 1, 0, 0);
    HALF_STEP(pA0, pA1, mnA, alA, pB0, pB1, alB, t + 1, 0, 1, 1);
  }
  const bool even = (NT & 1) == 0;
  if (even) { SBAR(); qkt<1>(pB0, pB1, lds, r32, hi, S.qr); SBAR(); }
  finishSM(pA0, pA1, alA, l_reg, pa0, pa1, pa2, pa3); SBAR();
  pv_tile<0>(o, vb0, pa0, pa1, pa2, pa3);
  if (even) { add_bias(pB0, pB1, lds, hi, KBASE(NT - 1)); MASKT(pB0, pB1, NT - 1); partialSM(pB0, pB1, m_reg, mnB, alB); __syncthreads(); RESC(alB);
    finishSM(pB0, pB1, alB, l_reg, pa0, pa1, pa2, pa3); SBAR(); pv_tile<1>(o, vb0, pa0, pa1, pa2, pa3); }
  SBAR();
  if (opart) {
    if (hi == 0) { mlpart[wid * QBLK + r32] = m_reg; mlpart[256 + wid * QBLK + r32] = l_reg; }
    float* Ow = opart + wid * QBLK * 128;
#pragma unroll
    for (int r = 0; r < 16; ++r) { const int orow = crow(r, hi);
#pragma unroll
      for (int d0 = 0; d0 < 4; ++d0) Ow[orow * 128 + d0 * 32 + r32] = o[d0][r]; }
  } else {
    if (hi == 0) li_l[r32] = l_reg; asm volatile("s_waitcnt lgkmcnt(0)" ::: "memory");
    float rli[16];
#pragma unroll
    for (int r = 0; r < 16; ++r) rli[r] = __builtin_amdgcn_rcpf(li_l[crow(r, hi)]);
    bf16_t* Ow = cur.O + wid * QBLK * LD;
#pragma unroll
    for (int r = 0; r < 16; ++r) { const int orow = crow(r, hi);
#pragma unroll
      for (int d0 = 0; d0 < 4; ++d0) { const float v = o[d0][r] * rli[r];
        const float vn = __shfl_xor(v, 1);
        if ((r32 & 1) == 0) *(unsigned*)(Ow + orow * LD + d0 * 32 + r32) = cvtpkv(v, vn); }
    }
  }
  __syncthreads();
#undef RESC
#undef KBASE
#undef MASKT
#undef SEAM_K0
#undef HALF_STEP
}
#undef ROWP
#undef VMW
#undef VMWN
#undef SLOAD_H
#undef SWRITE_HK
#undef SWRITE_HV
#undef SWRITE_H

__device__ __forceinline__ BlockRef mkref(const P& p, int hh, int qb) {
  BlockRef r; const size_t ho = (size_t)hh * 128, ro = (size_t)qb * QB * LD, hm = (size_t)hh * S * 128;
  r.Q = p.zb + (size_t)6 * S * HW + hm + (size_t)qb * QB * 128; r.K = p.zb + (size_t)7 * S * HW + hm; r.V = p.zb + (size_t)8 * S * HW + hm;
  r.G = p.zb + (size_t)9 * S * HW + ro + ho; r.O = p.oc + ro + ho; r.C = p.cc + (size_t)hh * S; r.P0 = qb * QB;
  return r;
}
__device__ __forceinline__ void pair_work(const P& p, int l, int w, char* lds) {
  const int tid = otid();
  const int hh = w & 7, role = (w >> 3) & 1, x = w >> 4, pi = x * 8 + hh;
  float* opart = p.opart + (size_t)(pi * 2 + role) * 32768; float* mlpart = p.mlpart + (size_t)(pi * 2 + role) * 512;
#pragma unroll 1
  for (int k = 0; k <= role; ++k) {
    const BlockRef b0 = mkref(p, hh, k ? x : 31 - x);
    const int split = x <= 13 ? 68 : 66;
    const int j_lo = (k == 0 && role) ? split : 0;
    const int j_hi = k ? 4 * (x + 1) : (role ? 4 * (32 - x) : split);
    Seam S;
    prime(b0, j_lo, j_hi, lds, S);
    block(b0, j_lo, j_hi, k ? nullptr : opart, mlpart, lds, S);
    if (k) {
      asm volatile("s_waitcnt vmcnt(0)" ::: "memory"); __syncthreads();
      if (tid == 0) { __builtin_amdgcn_fence(__ATOMIC_ACQUIRE, "agent"); asm volatile("s_waitcnt vmcnt(0)" ::: "memory"); }
      __syncthreads();
#pragma unroll 2
      for (int i = 0; i < 8; ++i) {
        const int id = tid + NTHREADS * i, row = id >> 4, ch = id & 15;
        bf16_t* op = b0.O + row * LD + ch * 8;
        const u32x4 ov = *(const u32x4*)op, gv = *(const u32x4*)(b0.G + row * LD + ch * 8);
        u32x4 r;
#pragma unroll
        for (int j = 0; j < 4; ++j) r[j] = cvtpk(bflo(ov[j]) * bflo(gv[j]), bfhi(ov[j]) * bfhi(gv[j]));
        *(u32x4*)op = r;
      }
      __syncthreads();
    }
  }
  asm volatile("s_waitcnt vmcnt(0)" ::: "memory"); __syncthreads();
  unsigned* flag = (unsigned*)(lds + OFF_WS);
  if (tid == 0) {
    __builtin_amdgcn_fence(__ATOMIC_RELEASE, "agent"); asm volatile("s_waitcnt vmcnt(0)" ::: "memory");
    const unsigned o_ = __hip_atomic_fetch_add(p.bar + XCD_BAR_WORDS + l * 128 + pi, 1u, __ATOMIC_RELAXED, __HIP_MEMORY_SCOPE_AGENT);
    if (o_ == 1u) { __builtin_amdgcn_fence(__ATOMIC_ACQUIRE, "agent"); asm volatile("s_waitcnt vmcnt(0)" ::: "memory"); }
    *flag = o_;
  }
  __syncthreads();
  const unsigned old = *flag;
  __syncthreads();
  if (old == 1u) {
    const BlockRef hv = mkref(p, hh, 31 - x);
    const float* oA = p.opart + (size_t)(pi * 2) * 32768; const float* oB = oA + 32768;
    const float* mA = p.mlpart + (size_t)(pi * 2) * 512; const float* mB = mA + 512;
    const int row = tid >> 1, c0 = (tid & 1) * 64;
    constexpr float C2 = 1.4426950408889634f * SCALE;
    const float ma = mA[row], la = mA[256 + row], mb = mB[row], lb = mB[256 + row];
    const float M = fmaxf(ma, mb), wa = __builtin_amdgcn_exp2f((ma - M) * C2), wb = __builtin_amdgcn_exp2f((mb - M) * C2);
    const float inv = 1.f / (la * wa + lb * wb);
#pragma unroll 4
    for (int j = 0; j < 16; ++j) {
      const f32x4 a = *(const f32x4*)(oA + row * 128 + c0 + 4 * j), b = *(const f32x4*)(oB + row * 128 + c0 + 4 * j);
      const u32x2 g = *(const u32x2*)(hv.G + row * LD + c0 + 4 * j);
      const float v0 = (a[0] * wa + b[0] * wb) * inv * bflo(g[0]), v1 = (a[1] * wa + b[1] * wb) * inv * bfhi(g[0]);
      const float v2 = (a[2] * wa + b[2] * wb) * inv * bflo(g[1]), v3 = (a[3] * wa + b[3] * wb) * inv * bfhi(g[1]);
      u32x2 ov = {cvtpk(v0, v1), cvtpk(v2, v3)};
      *(u32x2*)(hv.O + row * LD + c0 + 4 * j) = ov;
    }
  }
  __syncthreads();
}
}

__device__ __forceinline__ void glu_tile(const P& p, int l, int t, char* lds) {
  const int tid = otid(), lane = tid & 63, wid = tid >> 6, wr = wid >> 2, wc = wid & 3, fr = lane & 15, fq = lane >> 4;
  const int pm = t & 31, pn = t >> 5;
  f32x4 acc[8][4];
  zero_acc<4>(acc);
  gemm8_main(acc, p.yg + (size_t)pm * 256 * HW, p.WgluT + ((size_t)l * 2048 + (size_t)pn * 256) * HW, HW, lds);
  const bf16_t* sg = p.zb + (size_t)5 * S * HW;
#pragma unroll
  for (int m = 0; m < 8; ++m)
#pragma unroll
    for (int nt = 0; nt < 2; ++nt) {
      const int row = pm * 256 + (m >> 2) * 128 + wr * 64 + (m & 3) * 16 + fr, c = pn * 128 + wc * 32 + nt * 16 + 4 * fq;
      const u32x2 gt = *(const u32x2*)(sg + (size_t)row * HW + c);
      const f32x4 v = acc[m][nt], gg = acc[m][nt + 2];
      const float o0 = v[0] * sigmoidf_(gg[0]) * bflo(gt[0]), o1 = v[1] * sigmoidf_(gg[1]) * bfhi(gt[0]);
      const float o2 = v[2] * sigmoidf_(gg[2]) * bflo(gt[1]), o3 = v[3] * sigmoidf_(gg[3]) * bfhi(gt[1]);
      u32x2 o = {cvtpk(o0, o1), cvtpk(o2, o3)};
      *(u32x2*)(p.ob + (size_t)row * HW + c) = o;
      if (nt == 1) __builtin_amdgcn_sched_barrier(0);
    }
}
__device__ __forceinline__ void phase_attn_glu(const P& p, int l, char* lds) {
  const int G = ogdim(), b = obid();
#pragma unroll 1
  for (int w = b; w < 256; w += G) fa::pair_work(p, l, w, lds);
#pragma unroll 1
  for (int t = b; t < 256; t += G) glu_tile(p, l, t, lds);
}

__device__ __forceinline__ void phase_merge(const P& p, int l, char* lds) {
  const int tid = otid(), lane = tid & 63, wid = tid >> 6, wr = wid >> 2, wc = wid & 3, fr = lane & 15, fq = lane >> 4;
  for (int t = obid(); t < 32 * 16; t += ogdim()) {
    const int pm = t & 31, pn = t >> 5;
    f32x4 macc[8][2];
    zero_acc<2>(macc);
#pragma unroll 1
    for (int br = 0; br < 3; ++br) {
      const bf16_t* A = (br == 0 ? p.oa : br == 1 ? p.ob : p.oc) + (size_t)pm * 256 * HW;
      f32x4 acc[8][2];
      zero_acc<2>(acc);
      gemm_main<2>(acc, A, HW, p.WbrT + ((size_t)(l * 3 + br) * DM + (size_t)pn * 128) * HW, HW, HW, lds);
#pragma unroll
      for (int m = 0; m < 8; ++m)
#pragma unroll
        for (int nt = 0; nt < 2; ++nt) {
          const int row = pm * 256 + wr * 128 + m * 16 + fr, c = pn * 128 + wc * 32 + nt * 16 + 4 * fq;
          const u32x2 gt = *(const u32x2*)(p.gates + (size_t)row * 6144 + br * DM + c);
          macc[m][nt][0] += bflo(gt[0]) * acc[m][nt][0]; macc[m][nt][1] += bfhi(gt[0]) * acc[m][nt][1];
          macc[m][nt][2] += bflo(gt[1]) * acc[m][nt][2]; macc[m][nt][3] += bfhi(gt[1]) * acc[m][nt][3];
        }
    }
#pragma unroll
    for (int m = 0; m < 8; ++m)
#pragma unroll
      for (int nt = 0; nt < 2; ++nt) {
        const int row = pm * 256 + wr * 128 + m * 16 + fr, c = pn * 128 + wc * 32 + nt * 16 + 4 * fq;
        u32x2 o = {cvtpk(macc[m][nt][0], macc[m][nt][1]), cvtpk(macc[m][nt][2], macc[m][nt][3])};
        *(u32x2*)(p.m + (size_t)row * DM + c) = o;
      }
  }
}

__device__ __forceinline__ void phase_wout(const P& p, int l, char* lds) {
  const int tid = otid(), lane = tid & 63, wid = tid >> 6, wr = wid >> 2, wc = wid & 3, fr = lane & 15, fq = lane >> 4;
  const float* xin = l == 0 ? p.x : p.xbuf;
  for (int t = obid(); t < 32 * 8; t += ogdim()) {
    const int pm = t & 31, pn = t >> 5;
    f32x4 acc[8][4];
    zero_acc<4>(acc);
    gemm8_main(acc, p.m + (size_t)pm * 256 * DM, p.WoutT + ((size_t)l * DM + (size_t)pn * 256) * DM, DM, lds);
#pragma unroll
    for (int m = 0; m < 8; ++m)
#pragma unroll
      for (int nt = 0; nt < 4; ++nt) {
        const int row = pm * 256 + (m >> 2) * 128 + wr * 64 + (m & 3) * 16 + fr, c = pn * 256 + wc * 32 + ncol<4>(nt) + 4 * fq;
        const f32x4 xv = *(const f32x4*)(xin + (size_t)row * DM + c);
        *(f32x4*)(p.xbuf + (size_t)row * DM + c) = xv + acc[m][nt];
        if (nt == 3) __builtin_amdgcn_sched_barrier(0);
      }
  }
}

#if SINGLE_LAUNCH
typedef const __attribute__((address_space(4))) P KP;
#if defined(__HIP_DEVICE_COMPILE__)
#define LOADP() KP* q_ = (KP*)__builtin_amdgcn_kernarg_segment_ptr(); asm volatile("" : "+s"(q_)); const P p = *(const P*)q_
#else
#define LOADP() const P p{}
#endif
constexpr int XB_ST_OFF = LDS_BYTES - 16;
__device__ __forceinline__ void gsync(char* lds) {
#if defined(__HIP_DEVICE_COMPILE__)
  KP* q_ = (KP*)__builtin_amdgcn_kernarg_segment_ptr(); asm volatile("" : "+s"(q_));
  XcdBarrier b; b.bar = ((const P*)q_)->bar; b.x = xb_xcc_id(); b.st = (volatile LAS unsigned*)(lds + XB_ST_OFF);
  xcd_barrier(b);
#endif
}
template <int L> __device__ __forceinline__ void run_layer(char* lds) {
#ifndef ONLY_S
#define PH_ON(s) 1
#else
#define PH_ON(s) ((s) == ONLY_S)
#endif
  if (L != 0) { if (PH_ON(0)) { LOADP(); phase_norm(p, L, lds); } gsync(lds); }
#if defined(DOUBLE_S) && DOUBLE_S == 0
  { LOADP(); phase_norm(p, L, lds); } gsync(lds);
#endif
  if (PH_ON(1)) { LOADP(); phase_gemm_in(p, L, lds); } gsync(lds);
#if defined(DOUBLE_S) && DOUBLE_S == 1
  { LOADP(); phase_gemm_in(p, L, lds); } gsync(lds);
#endif
  if (PH_ON(2)) { LOADP(); phase_local(p, L, lds); } gsync(lds);
#if defined(DOUBLE_S) && DOUBLE_S == 2
  { LOADP(); phase_local(p, L, lds); } gsync(lds);
#endif
  if (PH_ON(3)) { LOADP(); phase_scan(p, L); } gsync(lds);
#if defined(DOUBLE_S) && DOUBLE_S == 3
  { LOADP(); phase_scan(p, L); } gsync(lds);
#endif
  if (PH_ON(4)) { LOADP(); phase_out(p, L, lds); } gsync(lds);
#if defined(DOUBLE_S) && DOUBLE_S == 4
  { LOADP(); phase_out(p, L, lds); } gsync(lds);
#endif
  if (PH_ON(5)) { LOADP(); phase_attn_glu(p, L, lds); } gsync(lds);
#if defined(DOUBLE_S) && DOUBLE_S == 5
  { LOADP(); phase_attn_glu(p, L, lds); } gsync(lds);
#endif
  if (PH_ON(6)) { LOADP(); phase_merge(p, L, lds); } gsync(lds);
#if defined(DOUBLE_S) && DOUBLE_S == 6
  { LOADP(); phase_merge(p, L, lds); } gsync(lds);
#endif
  if (PH_ON(7)) { LOADP(); phase_wout(p, L, lds); } gsync(lds);
}

__global__ void __launch_bounds__(NTHREADS) fwd_kernel(P pdummy) {
  extern __shared__ __attribute__((aligned(16))) char lds[];
  cg::grid_group grid = cg::this_grid();
  (void)pdummy;
  if (threadIdx.x < 4) ((volatile LAS unsigned*)(lds + XB_ST_OFF))[threadIdx.x] = 0u;
  __syncthreads();
  { LOADP(); (void)xcd_barrier_post(p.bar, (volatile LAS unsigned*)(lds + XB_ST_OFF)); }
  { LOADP(); phase_prep(p, lds); if (p.out == nullptr) grid.sync(); }
  { LOADP(); phase_norm(p, 0, lds); }
  gsync(lds);
#if defined(DOUBLE_S) && DOUBLE_S == 9
  for (int i = 0; i < 16; ++i) gsync(lds);
#endif
  run_layer<0>(lds);
  run_layer<1>(lds);
  { LOADP(); phase_final_norm(p); }
}

#else
constexpr int NPHASE = 18;
#ifdef PROBE_A
__global__ void stamp_k(unsigned long long* ts, int i) { if (threadIdx.x == 0 && blockIdx.x == 0) ts[i] = wall_clock64(); }
__global__ void fill_k(float* out, const unsigned long long* ts) {
  const float c = (float)(ts[PROBE_A + 1] - ts[PROBE_A]) * 1e-4f, a = (float)(ts[PROBE_B + 1] - ts[PROBE_B]) * 1e-2f;
  for (unsigned i = blockIdx.x * blockDim.x + threadIdx.x; i < (unsigned)(S * DM); i += gridDim.x * blockDim.x) out[i] = i == 0 ? a : c;
}
#endif
template <int SS> __global__ void __launch_bounds__(NTHREADS) phase_k(P p, int l) {
  extern __shared__ __attribute__((aligned(16))) char lds[];
  if (SS == 8) phase_prep(p, lds);
  else if (SS == 9) phase_final_norm(p);
  else if (SS == 0) phase_norm(p, l, lds);
  else if (SS == 1) phase_gemm_in(p, l, lds);
  else if (SS == 2) phase_local(p, l, lds);
  else if (SS == 3) phase_scan(p, l);
  else if (SS == 4) phase_out(p, l, lds);
  else if (SS == 5) phase_attn_glu(p, l, lds);
  else if (SS == 6) phase_merge(p, l, lds);
  else phase_wout(p, l, lds);
}
#endif

extern "C" void kernel_launch(void* const* d_in, const int* in_sizes, int n_in, void* d_out, int out_size, void* d_ws, size_t ws_size,
                              hipStream_t stream) {
  (void)in_sizes; (void)n_in; (void)out_size;
  static int grid_blocks = 0;
  if (!grid_blocks) {
    int dev = 0, cus = 0;
    (void)hipGetDevice(&dev);
    (void)hipDeviceGetAttribute(&cus, hipDeviceAttributeMultiprocessorCount, dev);
    if (cus <= 0) cus = 256;
#if SINGLE_LAUNCH
    int per_cu = 0;
    hipError_t e = hipFuncSetAttribute((const void*)fwd_kernel, hipFuncAttributeMaxDynamicSharedMemorySize, LDS_BYTES);
    if (e != hipSuccess) fprintf(stderr, "hipFuncSetAttribute failed: %s\n", hipGetErrorString(e));
    (void)hipOccupancyMaxActiveBlocksPerMultiprocessor(&per_cu, fwd_kernel, NTHREADS, LDS_BYTES);
    if (per_cu < 1) fprintf(stderr, "occupancy query returned %d\n", per_cu);
#else
#define SETA(SS) (void)hipFuncSetAttribute((const void*)phase_k<SS>, hipFuncAttributeMaxDynamicSharedMemorySize, LDS_BYTES)
    SETA(0); SETA(1); SETA(2); SETA(3); SETA(4); SETA(5); SETA(6); SETA(7); SETA(8); SETA(9);
#undef SETA
#endif
    grid_blocks = cus;
  }
  P p{};
  const float* const* in = (const float* const*)d_in;
  p.x = in[0]; p.norm_g = in[1]; p.w_in = in[2]; p.b_gate = in[3]; p.fox_bf = in[4]; p.hg_lb = in[5]; p.hg_norm_g = in[6];
  p.a_re = in[7]; p.a_im = in[8]; p.log_dt = in[9]; p.b_re = in[10]; p.b_im = in[11]; p.c_re = in[12]; p.c_im = in[13];
  p.s5_d = in[14]; p.w_glu = in[15]; p.w_a = in[16]; p.w_b = in[17]; p.w_c = in[18]; p.w_out = in[19]; p.final_g = in[20];
  p.out = (float*)d_out;
  char* w = (char*)d_ws; size_t off = 0;
  auto take = [&](size_t bytes) { char* r = w + off; off += (bytes + 255) & ~(size_t)255; return r; };
  p.WinT = (bf16_t*)take((size_t)2 * NZ * DM * 2);
  p.WgluT = (bf16_t*)take((size_t)2 * 2048 * HW * 2);
  p.WbrT = (bf16_t*)take((size_t)6 * DM * HW * 2);
  p.WoutT = (bf16_t*)take((size_t)2 * DM * DM * 2);
  p.Ktab = (bf16_t*)take((size_t)2 * 64 * 32 * 256 * 2);
  p.M1 = (bf16_t*)take((size_t)2 * 64 * 128 * 512 * 2);
  p.M2 = (bf16_t*)take((size_t)2 * 64 * 512 * 128 * 2);
  p.AL = (float*)take((size_t)2 * 64 * 64 * 2 * 4);
  p.xbuf = (float*)take((size_t)S * DM * 4);
  p.h = (bf16_t*)take((size_t)S * DM * 2);
  p.lsf = (float*)take((size_t)S * 8 * 4);
  p.cc = (float*)take((size_t)S * 8 * 4);
  p.zb = (bf16_t*)take((size_t)10 * S * HW * 2);
  p.logf = (float*)take((size_t)S * HW * 4);
  p.gates = (bf16_t*)take((size_t)S * 6144 * 2);
  p.oin = (float*)take((size_t)S * HW * 4);
  p.qd = (bf16_t*)take((size_t)S * HW * 2);
  p.SlocT = (float*)take((size_t)8 * 128 * 128 * 128 * 4);
  p.elast = (float*)take((size_t)8 * 128 * 128 * 4);
  p.SprevT = (bf16_t*)take((size_t)8 * 128 * 128 * 128 * 2);
  p.Xloc = (float*)take((size_t)64 * NCH * 128 * 4);
  p.Xprev = (bf16_t*)take((size_t)64 * NCH * 128 * 2);
  p.yg = (bf16_t*)take((size_t)S * HW * 2);
  p.oa = (bf16_t*)take((size_t)S * HW * 2);
  p.ob = (bf16_t*)take((size_t)S * HW * 2);
  p.oc = (bf16_t*)take((size_t)S * HW * 2);
  p.m = (bf16_t*)take((size_t)S * DM * 2);
  p.ts = (unsigned long long*)take(4096);
  p.bar = (unsigned*)take((size_t)(XCD_BAR_WORDS + 256) * 4);
  p.opart = (float*)take((size_t)256 * 32768 * 4);
  p.mlpart = (float*)take((size_t)256 * 512 * 4);
  p.mtmp = (float*)take((size_t)256 * 65536 * 4);
  if (off > ws_size) { fprintf(stderr, "workspace too small: need %zu have %zu\n", off, ws_size); return; }
#if SINGLE_LAUNCH
  (void)hipMemsetAsync(p.bar, 0, (size_t)(XCD_BAR_WORDS + 256) * 4, stream);
  void* args[] = {&p};
  hipError_t e = hipLaunchCooperativeKernel((const void*)fwd_kernel, dim3(grid_blocks), dim3(NTHREADS), args, LDS_BYTES, stream);
  if (e != hipSuccess) fprintf(stderr, "cooperative launch failed: %s (grid %d)\n", hipGetErrorString(e), grid_blocks);
#else
#ifdef PROBE_A
  int sidx = 0;
#define LAUNCH(SS, L) do { stamp_k<<<1, 64, 0, stream>>>(p.ts, sidx++); phase_k<SS><<<dim3(grid_blocks), dim3(NTHREADS), LDS_BYTES, stream>>>(p, L); } while (0)
#else
#define LAUNCH(SS, L) phase_k<SS><<<dim3(grid_blocks), dim3(NTHREADS), LDS_BYTES, stream>>>(p, L)
#endif
  LAUNCH(8, 0);
  for (int l = 0; l < 2; ++l) { LAUNCH(0, l); LAUNCH(1, l); LAUNCH(2, l); LAUNCH(3, l); LAUNCH(4, l); LAUNCH(5, l); LAUNCH(6, l); LAUNCH(7, l); }
  LAUNCH(9, 0);
#ifdef PROBE_A
  stamp_k<<<1, 64, 0, stream>>>(p.ts, sidx++);
  fill_k<<<1024, 256, 0, stream>>>(p.out, p.ts);
#endif
#undef LAUNCH
#endif
}
```

```cpp
#include <hip/hip_runtime.h>
#include <hip/hip_cooperative_groups.h>
#include <cstdint>
#include <cstdio>
namespace cg = cooperative_groups;

typedef unsigned short bf16_t;
typedef short bf16x8 __attribute__((ext_vector_type(8)));
typedef short s16x4 __attribute__((ext_vector_type(4)));
typedef float f32x4 __attribute__((ext_vector_type(4)));
typedef float f32x2 __attribute__((ext_vector_type(2)));
typedef float f32x16 __attribute__((ext_vector_type(16)));
typedef unsigned u32x4 __attribute__((ext_vector_type(4)));
typedef unsigned u32x2 __attribute__((ext_vector_type(2)));

#ifndef SINGLE_LAUNCH
#define SINGLE_LAUNCH 1
#endif

constexpr int S = 8192, DM = 2048, INW = 16392, NZ = 16384, HW = 1024;
constexpr int NTHREADS = 512;
constexpr int LDS_BYTES = 151552;
constexpr float EPS = 1e-6f;
constexpr int SL = 32, NCH = S / SL;

struct P {
  const float *x, *norm_g, *w_in, *b_gate, *fox_bf, *hg_lb, *hg_norm_g, *a_re, *a_im, *log_dt, *b_re, *b_im, *c_re, *c_im,
      *s5_d, *w_glu, *w_a, *w_b, *w_c, *w_out, *final_g;
  float* out;
  bf16_t *WinT, *WgluT, *WbrT, *WoutT, *Ktab, *M1, *M2;
  float* AL;
  float* xbuf; bf16_t* h; float* lsf; float* cc;
  bf16_t* zb; float* logf; bf16_t* gates;
  float* oin; bf16_t* qd; float* SlocT; float* elast; bf16_t* SprevT;
  float* Xloc; bf16_t* Xprev; bf16_t* yg;
  bf16_t *oa, *ob, *oc, *m;
  unsigned long long* ts;
  unsigned* bar;
  float* opart; float* mlpart; float* mtmp;
};

typedef __bf16 bf16x2_t __attribute__((ext_vector_type(2)));
__device__ __forceinline__ unsigned cvtpk(float lo, float hi) { f32x2 v = {lo, hi}; bf16x2_t b = __builtin_convertvector(v, bf16x2_t); return *reinterpret_cast<unsigned*>(&b); }
__device__ __forceinline__ bf16_t f2bf(float v) { return (bf16_t)(cvtpk(v, 0.f) & 0xffffu); }
__device__ __forceinline__ float bf2f(bf16_t h) { return __uint_as_float(((unsigned)h) << 16); }
__device__ __forceinline__ float bflo(unsigned u) { return __uint_as_float(u << 16); }
__device__ __forceinline__ float bfhi(unsigned u) { return __uint_as_float(u & 0xffff0000u); }
__device__ __forceinline__ float sigmoidf_(float x) { return __builtin_amdgcn_rcpf(1.f + __expf(-x)); }
__device__ __forceinline__ float siluf_(float x) { return x * sigmoidf_(x); }
__device__ __forceinline__ float logsigf_(float x) { return fminf(x, 0.f) - log1pf(__expf(-fabsf(x))); }
__device__ __forceinline__ float gelu_tanh(float y) {
  const float u2 = 1.5957691216057308f * (y + 0.044715f * y * y * y); return y * __builtin_amdgcn_rcpf(1.f + __expf(-u2)); }
__device__ __forceinline__ int otid() { int t = threadIdx.x; asm volatile("" : "+v"(t)); return t; }
__device__ __forceinline__ int obid() { int b = blockIdx.x; asm volatile("" : "+s"(b)); return b; }
__device__ __forceinline__ int ogdim() { int g = gridDim.x; asm volatile("" : "+s"(g)); return g; }
__device__ __forceinline__ f32x4 mfma16(bf16x8 a, bf16x8 b, f32x4 c) { return __builtin_amdgcn_mfma_f32_16x16x32_bf16(a, b, c, 0, 0, 0); }
__device__ __forceinline__ float wave_sum(float v) {
#pragma unroll
  for (int o = 32; o >= 1; o >>= 1) v += __shfl_xor(v, o);
  return v;
}
__device__ __forceinline__ bf16x8 pack8f(const float* v) {
  u32x4 w = {cvtpk(v[0], v[1]), cvtpk(v[2], v[3]), cvtpk(v[4], v[5]), cvtpk(v[6], v[7])};
  return *reinterpret_cast<bf16x8*>(&w);
}

#define XB_TMO      128
#define XB_XCNT(j)  (256  + 64 * (j))
#define XB_XSUB(j)  (1280 + 64 * (j))
#define XB_XGEN(j)  (2304 + 64 * (j))
#define XB_TOP      3328
#define XB_TOPGEN   3392
#define XCD_BAR_WORDS 3456
#define XB_SPIN_CAP (1u << 18)
#define LAS __attribute__((address_space(3)))

__device__ __forceinline__ unsigned xb_ld(unsigned* p)              { return __hip_atomic_load(p, __ATOMIC_RELAXED, __HIP_MEMORY_SCOPE_AGENT); }
__device__ __forceinline__ unsigned xb_add(unsigned* p, unsigned v) { return __hip_atomic_fetch_add(p, v, __ATOMIC_RELAXED, __HIP_MEMORY_SCOPE_AGENT); }
__device__ __forceinline__ unsigned xb_xcc_id() { return (unsigned)__builtin_amdgcn_s_getreg((3 << 11) | 20) & 0xFu; }
#define XB_SPIN(cond, bar) do { unsigned _sp = 0; while (cond) { __builtin_amdgcn_s_sleep(1); \
    if ((++_sp & 255u) == 0u) { if (xb_ld(&(bar)[XB_TMO])) break; if (_sp > XB_SPIN_CAP) { atomicAdd(&(bar)[XB_TMO], 1u); break; } } } } while (0)

struct XcdBarrier {
    unsigned* bar; unsigned x;
    volatile LAS unsigned* st;
};

__device__ __forceinline__ XcdBarrier xcd_barrier_post(unsigned* bar, volatile LAS unsigned* st) {
    XcdBarrier b; b.bar = bar; b.x = xb_xcc_id(); b.st = st;
    if (threadIdx.x == 0) (void)xb_add(&bar[XB_XCNT(b.x)], 1u);
    return b;
}
__device__ __forceinline__ void xcd_barrier_complete(unsigned* bar, unsigned x, unsigned& nloc, unsigned& nx) {
    const unsigned G = gridDim.x * gridDim.y * gridDim.z;
    unsigned sum, cnt, mine, sp = 0u;
    for (;;) {
        sum = 0u; cnt = 0u; mine = 0u;
#pragma unroll
        for (unsigned j = 0; j < 16; ++j) { const unsigned c = xb_ld(&bar[XB_XCNT(j)]); sum += c; cnt += (c > 0u) ? 1u : 0u; mine = (j == x) ? c : mine; }
        if (sum == G) break;
        __builtin_amdgcn_s_sleep(1);
        if ((++sp & 255u) == 0u) { if (xb_ld(&bar[XB_TMO])) break; if (sp > XB_SPIN_CAP) { atomicAdd(&bar[XB_TMO], 1u); break; } }
    }
    nloc = mine > 0u ? mine : 1u; nx = cnt > 0u ? cnt : 1u;
}

__device__ __forceinline__ void xcd_barrier(const XcdBarrier& b) {
    asm volatile("s_waitcnt vmcnt(0)" ::: "memory");
    __syncthreads();
    if (threadIdx.x == 0) {
        unsigned* bar = b.bar;
        __builtin_amdgcn_s_waitcnt(0);
        unsigned nloc = b.st[0], nx = b.st[1];
        if (nloc == 0u) { xcd_barrier_complete(bar, b.x, nloc, nx); b.st[0] = nloc; b.st[1] = nx; }
        const unsigned old = xb_add(&bar[XB_XSUB(b.x)], 1u);
        const unsigned gen = old / nloc;
        if (old + 1u == (gen + 1u) * nloc) {
            __builtin_amdgcn_fence(__ATOMIC_RELEASE, "agent");
            asm volatile("s_waitcnt vmcnt(0)" ::: "memory");
            const unsigned og = xb_add(&bar[XB_TOP], 1u);
            const unsigned tg = og / nx;
            if (og + 1u == (tg + 1u) * nx) xb_add(&bar[XB_TOPGEN], 1u);
            else XB_SPIN(xb_ld(&bar[XB_TOPGEN]) == tg, bar);
            __builtin_amdgcn_fence(__ATOMIC_ACQUIRE, "agent");
            xb_add(&bar[XB_XGEN(b.x)], 1u);
            asm volatile("s_waitcnt vmcnt(0)" ::: "memory");
        } else {
            XB_SPIN(xb_ld(&bar[XB_XGEN(b.x)]) == gen, bar);
            __builtin_amdgcn_fence(__ATOMIC_ACQUIRE, "agent");
            asm volatile("s_waitcnt vmcnt(0)" ::: "memory");
        }
    }
    __syncthreads();
}


template <int NT> __device__ __forceinline__ int ncol(int nt) { return NT == 4 ? ((nt >> 1) * 128 + (nt & 1) * 16) : nt * 16; }

template <int NT>
__device__ __forceinline__ void gemm_main(f32x4 (&acc)[8][NT], const bf16_t* __restrict__ A, int lda, const bf16_t* __restrict__ Bt, int ldb, int K, char* lds) {
  constexpr int BN = NT * 64;
  constexpr int BUF = 32768 + BN * 128;
  const int tid = otid(), lane = tid & 63, wid = tid >> 6, wr = wid >> 2, wc = wid & 3, fr = lane & 15, fq = lane >> 4;
  const int lrow = tid >> 3, sch = (tid & 7) ^ (lrow & 7);
  const char* ga = (const char*)(A + (size_t)lrow * lda + sch * 8);
  const char* gb = (const char*)(Bt + (size_t)lrow * ldb + sch * 8);
#define GDMA(bufp, kt) do { _Pragma("unroll") for (int i = 0; i < 4; ++i) \
      __builtin_amdgcn_global_load_lds((const unsigned*)(ga + ((size_t)i * 64 * lda + (kt) * 64) * 2), (__attribute__((address_space(3))) unsigned*)((bufp) + i * 8192 + tid * 16), 16, 0, 0); \
    _Pragma("unroll") for (int i = 0; i < NT; ++i) \
      __builtin_amdgcn_global_load_lds((const unsigned*)(gb + ((size_t)i * 64 * ldb + (kt) * 64) * 2), (__attribute__((address_space(3))) unsigned*)((bufp) + 32768 + i * 8192 + tid * 16), 16, 0, 0); } while (0)
  const int a0 = (wr * 128 + fr) * 128 + ((fq ^ (fr & 7)) << 4);
  const int a1 = (wr * 128 + fr) * 128 + (((4 + fq) ^ (fr & 7)) << 4);
  const int b0 = 32768 + (wc * 32 + fr) * 128 + ((fq ^ (fr & 7)) << 4);
  const int b1 = 32768 + (wc * 32 + fr) * 128 + (((4 + fq) ^ (fr & 7)) << 4);
  const int nk = K >> 6;
  GDMA(lds, 0); GDMA(lds + BUF, 1);
  asm volatile("s_waitcnt vmcnt(%0)" :: "i"(4 + NT) : "memory");
  __builtin_amdgcn_s_barrier();
  int cur = 0;
#pragma unroll 1
  for (int kt = 0; kt < nk; ++kt) {
    const char* buf = lds + cur * BUF;
    const int nxt2 = cur == 0 ? 2 : cur - 1;
    if (kt + 2 < nk) GDMA(lds + nxt2 * BUF, kt + 2);
    {
      bf16x8 af[8], bfr[NT];
#pragma unroll
      for (int m = 0; m < 8; ++m) af[m] = *(const bf16x8*)(buf + a0 + m * 2048);
#pragma unroll
      for (int nt = 0; nt < NT; ++nt) bfr[nt] = *(const bf16x8*)(buf + b0 + ncol<NT>(nt) * 128);
#pragma unroll
      for (int m = 0; m < 8; ++m)
#pragma unroll
        for (int nt = 0; nt < NT; ++nt) acc[m][nt] = mfma16(bfr[nt], af[m], acc[m][nt]);
    }
    {
      bf16x8 af[8], bfr[NT];
#pragma unroll
      for (int m = 0; m < 8; ++m) af[m] = *(const bf16x8*)(buf + a1 + m * 2048);
#pragma unroll
      for (int nt = 0; nt < NT; ++nt) bfr[nt] = *(const bf16x8*)(buf + b1 + ncol<NT>(nt) * 128);
#pragma unroll
      for (int m = 0; m < 8; ++m)
#pragma unroll
        for (int nt = 0; nt < NT; ++nt) acc[m][nt] = mfma16(bfr[nt], af[m], acc[m][nt]);
    }
    if (kt + 2 < nk) asm volatile("s_waitcnt vmcnt(%0)" :: "i"(4 + NT) : "memory");
    else asm volatile("s_waitcnt vmcnt(0)" ::: "memory");
    asm volatile("s_waitcnt lgkmcnt(0)" ::: "memory");
    __builtin_amdgcn_s_barrier();
    cur = cur == 2 ? 0 : cur + 1;
  }
#undef GDMA
}

template <int NT> __device__ __forceinline__ void zero_acc(f32x4 (&acc)[8][NT]) {
#pragma unroll
  for (int m = 0; m < 8; ++m)
#pragma unroll
    for (int nt = 0; nt < NT; ++nt) acc[m][nt] = (f32x4){0.f, 0.f, 0.f, 0.f};
}

namespace g8 {
constexpr int BK = 64, HALF = 128, HT = HALF * BK;
__device__ __forceinline__ int lds_byte(int r, int c) { const int st = (r >> 4) * 2 + (c >> 5), rr = r & 15, cc = c & 31, ob = rr * 64 + cc * 2; return st * 1024 + (ob ^ (((ob >> 9) & 1) << 5)); }
__device__ __forceinline__ void stage_rc(int b, int& R, int& C) { const int st = b / 1024, sb = b % 1024, swz = sb ^ (((sb >> 9) & 1) << 5); R = (st >> 1) * 16 + swz / 64; C = (st & 1) * 32 + (swz % 64) / 2; }
}
__device__ __forceinline__ void gemm8_main(f32x4 (&acc)[8][4], const bf16_t* __restrict__ A, const bf16_t* __restrict__ Bt, int K, char* lds) {
  using namespace g8;
  bf16_t* shm = (bf16_t*)lds;
  const int tid = otid();
#define SA(b, h) (shm + ((b) * 2 + (h)) * HT)
#define SB(b, h) (shm + (4 + (b) * 2 + (h)) * HT)
#define STAGE(Pp, BASE, br, kt) do { const char* _g = (const char*)((BASE) + (long)(br) * K + (long)(kt) * BK); \
    __builtin_amdgcn_global_load_lds((const unsigned*)(_g + goff0), (__attribute__((address_space(3))) unsigned*)((char*)(Pp) + tid * 16), 16, 0, 0); \
    __builtin_amdgcn_global_load_lds((const unsigned*)(_g + goff1), (__attribute__((address_space(3))) unsigned*)((char*)(Pp) + tid * 16 + 8192), 16, 0, 0); } while (0)
#define LDA(dst, b, h) _Pragma("unroll") for (int m = 0; m < 4; ++m) _Pragma("unroll") for (int k = 0; k < 2; ++k) \
    dst[m][k] = *reinterpret_cast<const bf16x8*>(lds + ((b) * 2 + (h)) * 16384 + aoff + m * 2048 + k * 1024)
#define LDB(dst, b, h) _Pragma("unroll") for (int n = 0; n < 2; ++n) _Pragma("unroll") for (int k = 0; k < 2; ++k) \
    dst[n][k] = *reinterpret_cast<const bf16x8*>(lds + (4 + (b) * 2 + (h)) * 16384 + boff + n * 2048 + k * 1024)
#define MMA(ai, bj, At_, Bt_) do { __builtin_amdgcn_s_setprio(1); \
    _Pragma("unroll") for (int m = 0; m < 4; ++m) _Pragma("unroll") for (int n = 0; n < 2; ++n) _Pragma("unroll") for (int k = 0; k < 2; ++k) \
      acc[(ai) * 4 + m][(bj) * 2 + n] = __builtin_amdgcn_mfma_f32_16x16x32_bf16(Bt_[n][k], At_[m][k], acc[(ai) * 4 + m][(bj) * 2 + n], 0, 0, 0); \
    __builtin_amdgcn_s_setprio(0); } while (0)
#define WAIT_V(n) asm volatile("s_waitcnt vmcnt(" #n ")" ::: "memory")
#define WAIT_L(n) asm volatile("s_waitcnt lgkmcnt(" #n ")" ::: "memory")
#define BAR __builtin_amdgcn_s_barrier()
#define SCHED __builtin_amdgcn_sched_barrier(0)
  const int wid = tid >> 6, lane = tid & 63, wr = wid >> 2, wc = wid & 3, fr = lane & 15, fq = lane >> 4;
  bf16x8 At[4][2], B0[2][2], B1[2][2];
  const int nt = K / BK;
  const int swz_ = (fr * 64 + fq * 16) ^ ((((fr * 64 + fq * 16) >> 9) & 1) << 5);
  const int aoff = wr * 8192 + swz_, boff = wc * 4096 + swz_;
  unsigned goff0, goff1;
  { int r_, c_; stage_rc(tid * 16, r_, c_); goff0 = (unsigned)(r_ * K + c_) * 2u; stage_rc(tid * 16 + 8192, r_, c_); goff1 = (unsigned)(r_ * K + c_) * 2u; }
  STAGE(SB(0, 0), Bt, 0, 0); STAGE(SA(0, 0), A, 0, 0);
  STAGE(SB(0, 1), Bt, HALF, 0); STAGE(SA(0, 1), A, HALF, 0);
  if (wr == 1) BAR;
  WAIT_V(4); BAR;
  STAGE(SB(1, 0), Bt, 0, 1); STAGE(SA(1, 0), A, 0, 1); STAGE(SB(1, 1), Bt, HALF, 1);
  WAIT_V(6); BAR;
  for (int t = 0; t < nt - 2; t += 2) {
    LDB(B0, 0, 0); SCHED; LDA(At, 0, 0); STAGE(SA(1, 1), A, HALF, t + 1);
    WAIT_L(8); BAR; WAIT_L(0); MMA(0, 0, At, B0); BAR; SCHED;
    LDB(B1, 0, 1); STAGE(SB(0, 0), Bt, 0, t + 2);
    BAR; WAIT_L(0); MMA(0, 1, At, B1); BAR;
    LDA(At, 0, 1); STAGE(SA(0, 0), A, 0, t + 2);
    BAR; WAIT_L(0); MMA(1, 0, At, B0); BAR; SCHED;
    STAGE(SB(0, 1), Bt, HALF, t + 2);
    WAIT_V(6); BAR; MMA(1, 1, At, B1); BAR;
    LDB(B0, 1, 0); SCHED; LDA(At, 1, 0); STAGE(SA(0, 1), A, HALF, t + 2);
    WAIT_L(8); BAR; WAIT_L(0); MMA(0, 0, At, B0); BAR; SCHED;
    LDB(B1, 1, 1); STAGE(SB(1, 0), Bt, 0, t + 3);
    BAR; WAIT_L(0); MMA(0, 1, At, B1); BAR;
    LDA(At, 1, 1); STAGE(SA(1, 0), A, 0, t + 3);
    BAR; WAIT_L(0); MMA(1, 0, At, B0); BAR; SCHED;
    STAGE(SB(1, 1), Bt, HALF, t + 3);
    WAIT_V(6); BAR; MMA(1, 1, At, B1); BAR;
  }
  { LDB(B0, 0, 0); LDA(At, 0, 0); STAGE(SA(1, 1), A, HALF, nt - 1);
    BAR; WAIT_L(0); MMA(0, 0, At, B0); BAR;
    LDB(B1, 0, 1); BAR; WAIT_L(0); MMA(0, 1, At, B1); BAR;
    LDA(At, 0, 1); WAIT_V(4); BAR; WAIT_L(0); MMA(1, 0, At, B0); MMA(1, 1, At, B1); BAR; }
  { LDB(B0, 1, 0); LDA(At, 1, 0); WAIT_V(2); BAR; WAIT_L(0); MMA(0, 0, At, B0); BAR;
    LDB(B1, 1, 1); WAIT_V(0); BAR; WAIT_L(0); MMA(0, 1, At, B1); BAR;
    LDA(At, 1, 1); BAR; WAIT_L(0); MMA(1, 0, At, B0); MMA(1, 1, At, B1); BAR; }
  if (wr == 0) BAR;
  __syncthreads();
#undef SA
#undef SB
#undef STAGE
#undef LDA
#undef LDB
#undef MMA
#undef WAIT_V
#undef WAIT_L
#undef BAR
#undef SCHED
}

__device__ __forceinline__ void tr_tile(const float* __restrict__ src, int ld_src, int k0, int scol0, int scol1, bf16_t* __restrict__ dst, int ld_dst, int n_dst0, char* lds) {
  float* t = (float*)lds;
  const int tid = otid();
  {
    const int c4 = (tid & 63) * 4, kq = tid >> 6;
    const int sc = c4 < 128 ? scol0 + c4 : scol1 + (c4 - 128);
    f32x4 v[8];
#pragma unroll
    for (int i = 0; i < 8; ++i) v[i] = *(const f32x4*)(src + (size_t)(k0 + kq + 8 * i) * ld_src + sc);
#pragma unroll
    for (int i = 0; i < 8; ++i) { float* tp = t + (kq + 8 * i) * 257 + c4; tp[0] = v[i][0]; tp[1] = v[i][1]; tp[2] = v[i][2]; tp[3] = v[i][3]; }
  }
  __syncthreads();
  {
    const int n = tid >> 1, kh = (tid & 1) * 32;
    bf16_t* d = dst + (size_t)(n_dst0 + n) * ld_dst + k0 + kh;
#pragma unroll
    for (int q = 0; q < 4; ++q) {
      float v[8];
#pragma unroll
      for (int j = 0; j < 8; ++j) v[j] = t[(kh + q * 8 + j) * 257 + n];
      *(bf16x8*)(d + q * 8) = pack8f(v);
    }
  }
  __syncthreads();
}

__device__ __forceinline__ void s5_tables(const P& p, int unit, char* lds) {
  const int l = unit >> 6, g = unit & 63, lg = l * 64 + g, tid = threadIdx.x;
  f32x2* pw = (f32x2*)lds;
  f32x2* bb = (f32x2*)(lds + 17408);
  f32x2* cw = (f32x2*)(lds + 25600);
  const float dtf = expf(p.log_dt[lg]);
#pragma unroll 1
  for (int idx = tid; idx < 64 * 33; idx += NTHREADS) {
    const int pp = idx / 33, j = idx - pp * 33;
    const float ar = p.a_re[lg * 64 + pp], ai = p.a_im[lg * 64 + pp];
    double rev = (double)ai * (double)dtf * (double)j * 0.15915494309189535;
    rev -= rint(rev);
    const float mag = expf(ar * dtf * (float)j);
    const float rf = (float)rev;
    pw[pp * 34 + j] = (f32x2){mag * __builtin_amdgcn_cosf(rf), mag * __builtin_amdgcn_sinf(rf)};
  }
#pragma unroll 1
  for (int idx = tid; idx < 1024; idx += NTHREADS) {
    const int pp = idx >> 4, c = idx & 15;
    const float ar = p.a_re[lg * 64 + pp], ai = p.a_im[lg * 64 + pp];
    double rev = (double)ai * (double)dtf * 0.15915494309189535;
    rev -= rint(rev);
    const float mag = expf(ar * dtf), rf = (float)rev;
    const float abr = mag * __builtin_amdgcn_cosf(rf), abi = mag * __builtin_amdgcn_sinf(rf);
    const float nr = abr - 1.f, den = ar * ar + ai * ai;
    const float zr = (nr * ar + abi * ai) / den, zi = (abi * ar - nr * ai) / den;
    const float br = p.b_re[(size_t)(lg * 64 + pp) * 16 + c], bi = p.b_im[(size_t)(lg * 64 + pp) * 16 + c];
    bb[idx] = (f32x2){zr * br - zi * bi, zr * bi + zi * br};
    const int c2 = idx >> 6, p2 = idx & 63;
    cw[idx] = (f32x2){p.c_re[(size_t)(lg * 16 + c2) * 64 + p2], p.c_im[(size_t)(lg * 16 + c2) * 64 + p2]};
  }
  __syncthreads();
#pragma unroll 1
  for (int idx = tid; idx < 32 * 256; idx += NTHREADS) {
    const int d = idx >> 8, c = (idx >> 4) & 15, c1 = idx & 15;
    float sum = 0.f;
#pragma unroll 4
    for (int pp = 0; pp < 64; ++pp) {
      const f32x2 w = pw[pp * 34 + d], b = bb[pp * 16 + c1], cv = cw[c * 64 + pp];
      const float tr = w[0] * b[0] - w[1] * b[1], ti = w[0] * b[1] + w[1] * b[0];
      sum += cv[0] * tr - cv[1] * ti;
    }
    p.Ktab[(size_t)(lg * 32 + d) * 256 + c * 16 + c1] = f2bf(sum);
  }
#pragma unroll 2
  for (int idx = tid; idx < 128 * 512; idx += NTHREADS) {
    const int pr = idx >> 9, col = idx & 511, s = col >> 4, c1 = col & 15, pp = pr & 63, im = pr >> 6;
    const f32x2 w = pw[pp * 34 + (SL - 1 - s)], b = bb[pp * 16 + c1];
    const float tr = w[0] * b[0] - w[1] * b[1], ti = w[0] * b[1] + w[1] * b[0];
    p.M1[(size_t)(lg * 128 + pr) * 512 + col] = f2bf(im ? ti : tr);
  }
#pragma unroll 2
  for (int idx = tid; idx < 512 * 128; idx += NTHREADS) {
    const int row = idx >> 7, pr = idx & 127, t = row >> 4, c = row & 15, pp = pr & 63, im = pr >> 6;
    const f32x2 w = pw[pp * 34 + t + 1], cv = cw[c * 64 + pp];
    const float tr = cv[0] * w[0] - cv[1] * w[1], ti = cv[0] * w[1] + cv[1] * w[0];
    p.M2[(size_t)(lg * 512 + row) * 128 + pr] = f2bf(im ? -ti : tr);
  }
  if (tid < 64) { const f32x2 w = pw[tid * 34 + SL]; p.AL[(lg * 64 + tid) * 2] = w[0]; p.AL[(lg * 64 + tid) * 2 + 1] = w[1]; }
  __syncthreads();
}

__device__ __forceinline__ void phase_prep(const P& p, char* lds) {
  constexpr int NT_ALL = 4096 + 256 + 768 + 512;
  const int G = ogdim(), b = obid();
  const bool bal = (G == 256);
  if (bal ? (b < 128) : true) { for (int u = b; u < 128; u += (bal ? 128 : G)) s5_tables(p, u, lds); }
  const int first = bal ? (b < 128 ? b : 2176 + (b - 128)) : b, step = bal ? 128 : G, count = bal ? (b < 128 ? 17 : 27) : (NT_ALL + G - 1) / G;
#pragma unroll 1
  for (int i = 0; i < count; ++i) {
    int u = first + i * step;
    if (u >= NT_ALL) break;
    if (u < 4096) {
      const int l = u >> 11, rem = u & 2047, kt = rem >> 6, ntile = rem & 63, n0 = ntile * 256, s0 = n0 + (n0 >= 9216 ? 8 : 0);
      tr_tile(p.w_in + (size_t)l * DM * INW, INW, kt * 64, s0, s0 + 128, p.WinT + (size_t)l * NZ * DM, DM, n0, lds);
      continue;
    }
    u -= 4096;
    if (u < 256) {
      const int l = u >> 7, rem = u & 127, kt = rem >> 3, j = rem & 7;
      tr_tile(p.w_glu + (size_t)l * HW * 2048, 2048, kt * 64, j * 128, 1024 + j * 128, p.WgluT + (size_t)l * 2048 * HW, HW, j * 256, lds);
      continue;
    }
    u -= 256;
    if (u < 768) {
      const int mat = u >> 7, rem = u & 127, kt = rem >> 3, ntile = rem & 7, l = mat / 3, br = mat - l * 3;
      const float* s = (br == 0 ? p.w_a : br == 1 ? p.w_b : p.w_c) + (size_t)l * HW * DM;
      tr_tile(s, DM, kt * 64, ntile * 256, ntile * 256 + 128, p.WbrT + (size_t)mat * DM * HW, HW, ntile * 256, lds);
      continue;
    }
    u -= 768;
    {
      const int l = u >> 8, rem = u & 255, kt = rem >> 3, ntile = rem & 7;
      tr_tile(p.w_out + (size_t)l * DM * DM, DM, kt * 64, ntile * 256, ntile * 256 + 128, p.WoutT + (size_t)l * DM * DM, DM, ntile * 256, lds);
    }
  }
}

__device__ __forceinline__ void phase_norm(const P& p, int l, char* lds) {
  const float* xin = l == 0 ? p.x : p.xbuf;
  const int tid = otid(), lane = tid & 63, wid = __builtin_amdgcn_readfirstlane(tid >> 6);
  const float* wl = p.w_in + (size_t)l * DM * INW;
#pragma unroll
  for (int i = 0; i < 8; ++i) { const int idx = tid + NTHREADS * i, k = idx >> 1, hf = idx & 1; *(f32x4*)(lds + k * 32 + hf * 16 + (k >> 2) * 16) = *(const f32x4*)(wl + (size_t)k * INW + 9216 + hf * 4); }
  __syncthreads();
  const float* g = p.norm_g + l * DM;
#pragma unroll 1
  for (int row = obid() * 8 + wid; row < S; row += ogdim() * 8) {
    const float* xr = xin + (size_t)row * DM; bf16_t* hrow = p.h + (size_t)row * DM;
    f32x4 xv[8];
    float ss = 0.f;
#pragma unroll
    for (int j = 0; j < 8; ++j) { xv[j] = *(const f32x4*)(xr + (unsigned)(lane + 64 * j) * 4u); ss += xv[j][0] * xv[j][0] + xv[j][1] * xv[j][1] + xv[j][2] * xv[j][2] + xv[j][3] * xv[j][3]; }
    ss = wave_sum(ss);
    const float rstd = rsqrtf(ss * (1.f / DM) + EPS);
    float fa[8] = {0.f, 0.f, 0.f, 0.f, 0.f, 0.f, 0.f, 0.f};
#pragma unroll
    for (int j = 0; j < 8; ++j) {
      const unsigned c = (unsigned)(lane + 64 * j) * 4u;
      const f32x4 gv = *(const f32x4*)(g + c);
      float hv[4];
#pragma unroll
      for (int e = 0; e < 4; ++e) hv[e] = xv[j][e] * rstd * gv[e];
      u32x2 o = {cvtpk(hv[0], hv[1]), cvtpk(hv[2], hv[3])};
      *(u32x2*)(hrow + c) = o;
#pragma unroll
      for (int e = 0; e < 4; ++e) {
        const f32x4 w0 = *(const f32x4*)(lds + (c + e) * 32 + (c >> 2) * 16), w1 = *(const f32x4*)(lds + (c + e) * 32 + 16 + (c >> 2) * 16);
        fa[0] += hv[e] * w0[0]; fa[1] += hv[e] * w0[1]; fa[2] += hv[e] * w0[2]; fa[3] += hv[e] * w0[3];
        fa[4] += hv[e] * w1[0]; fa[5] += hv[e] * w1[1]; fa[6] += hv[e] * w1[2]; fa[7] += hv[e] * w1[3];
      }
      __builtin_amdgcn_sched_barrier(0);
    }
#pragma unroll
    for (int j = 0; j < 8; ++j) fa[j] = wave_sum(fa[j]);
    {
      float v = fa[0];
#pragma unroll
      for (int j = 1; j < 8; ++j) v = (lane == j) ? fa[j] : v;
      if (lane < 8) p.lsf[row * 8 + lane] = logsigf_(v + p.fox_bf[l * 8 + lane]);
    }
  }
  __syncthreads();
}

__device__ __forceinline__ void phase_final_norm(const P& p) {
  const int tid = otid(), lane = tid & 63, wid = __builtin_amdgcn_readfirstlane(tid >> 6);
#pragma unroll 1
  for (int row = obid() * 8 + wid; row < S; row += ogdim() * 8) {
    const float* xr = p.xbuf + (size_t)row * DM;
    f32x4 xv[8];
    float ss = 0.f;
#pragma unroll
    for (int j = 0; j < 8; ++j) { xv[j] = *(const f32x4*)(xr + (lane + 64 * j) * 4); ss += xv[j][0] * xv[j][0] + xv[j][1] * xv[j][1] + xv[j][2] * xv[j][2] + xv[j][3] * xv[j][3]; }
    ss = wave_sum(ss);
    const float rstd = rsqrtf(ss * (1.f / DM) + EPS);
#pragma unroll
    for (int j = 0; j < 8; ++j) {
      const int c = (lane + 64 * j) * 4;
      const f32x4 gv = *(const f32x4*)(p.final_g + c);
      f32x4 o;
#pragma unroll
      for (int e = 0; e < 4; ++e) o[e] = xv[j][e] * rstd * gv[e];
      *(f32x4*)(p.out + (size_t)row * DM + c) = o;
    }
  }
}

__device__ __forceinline__ void phase_gemm_in(const P& p, int l, char* lds) {
  const int tid = otid(), lane = tid & 63, wid = tid >> 6, wr = wid >> 2, wc = wid & 3, fr = lane & 15, fq = lane >> 4;
  for (int t = obid(); t < 32 * 64; t += ogdim()) {
    const int pm = t & 31, pn = t >> 5;
    f32x4 acc[8][4];
    zero_acc<4>(acc);
    gemm8_main(acc, p.h + (size_t)pm * 256 * DM, p.WinT + ((size_t)l * NZ + (size_t)pn * 256) * DM, DM, lds);
    const int region = pn >> 2;
    const int row0 = pm * 256 + wr * 64 + fr;
    const int cbase = (pn & 3) * 256 + wc * 32 + 4 * fq;
    if (region == 1) {
#pragma unroll
      for (int nt = 0; nt < 4; ++nt) {
        const int c = cbase + ncol<4>(nt);
        float lb[4], la[4], l1m[4];
#pragma unroll
        for (int e = 0; e < 4; ++e) {
          lb[e] = l == 0 ? 0.f : sigmoidf_(p.hg_lb[HW + c + e] - p.hg_lb[c + e]);
          la[e] = l == 0 ? -1e30f : __logf(lb[e]);
          l1m[e] = l == 0 ? 0.f : __logf(1.f - lb[e]);
        }
#pragma unroll
        for (int m = 0; m < 8; ++m) {
          const int row = row0 + (m >> 2) * 128 + (m & 3) * 16;
          f32x4 lf; float kk[4];
#pragma unroll
          for (int e = 0; e < 4; ++e) {
            const float z = acc[m][nt][e];
            const float ez = __expf(-fabsf(z));
            const float ls = fminf(z, 0.f) - __logf(1.f + ez);
            const float b = l1m[e] + ls, a = la[e], mx = fmaxf(a, b);
            lf[e] = mx + __logf(1.f + __expf(-fabsf(a - b)));
            const float sneg = (z >= 0.f ? ez : 1.f) * __builtin_amdgcn_rcpf(1.f + ez);
            kk[e] = (1.f - lb[e]) * sneg;
          }
          *(f32x4*)(p.logf + (size_t)row * HW + c) = lf;
          u32x2 o = {cvtpk(kk[0], kk[1]), cvtpk(kk[2], kk[3])};
          *(u32x2*)(p.zb + (size_t)1 * S * HW + (size_t)row * HW + c) = o;
          __builtin_amdgcn_sched_barrier(0);
        }
      }
    } else if (region < 10) {
      const bool act = (region == 3 || region == 5 || region == 9), hm = (region >= 6 && region <= 8);
      bf16_t* dst = p.zb + (size_t)region * S * HW;
#pragma unroll
      for (int m = 0; m < 8; ++m)
#pragma unroll
        for (int nt = 0; nt < 4; ++nt) {
          const int row = row0 + (m >> 2) * 128 + (m & 3) * 16, c = cbase + ncol<4>(nt);
          f32x4 v = acc[m][nt];
          if (act) {
#pragma unroll
            for (int e = 0; e < 4; ++e) v[e] = siluf_(v[e]);
          }
          u32x2 o = {cvtpk(v[0], v[1]), cvtpk(v[2], v[3])};
          if (hm) *(u32x2*)(dst + ((size_t)(c >> 7) * S + row) * 128 + (c & 127)) = o;
          else *(u32x2*)(dst + (size_t)row * HW + c) = o;
          if (nt == 3) __builtin_amdgcn_sched_barrier(0);
        }
    } else {
      const int gc0 = (pn - 40) * 256 + wc * 32 + 4 * fq;
#pragma unroll
      for (int nt = 0; nt < 4; ++nt) {
        const int c = gc0 + ncol<4>(nt);
        const f32x4 bg = *(const f32x4*)(p.b_gate + (size_t)l * 6144 + c);
#pragma unroll
        for (int m = 0; m < 8; ++m) {
          const int row = row0 + (m >> 2) * 128 + (m & 3) * 16;
          f32x4 v = acc[m][nt];
#pragma unroll
          for (int e = 0; e < 4; ++e) v[e] = sigmoidf_(v[e] + bg[e]);
          u32x2 o = {cvtpk(v[0], v[1]), cvtpk(v[2], v[3])};
          *(u32x2*)(p.gates + (size_t)row * 6144 + c) = o;
          if ((m & 3) == 3) __builtin_amdgcn_sched_barrier(0);
        }
      }
    }
  }
}

__device__ __forceinline__ int swz128(int row, int col_elem) {
  return row * 128 + ((((col_elem >> 3) ^ (row & 7))) << 4) + (col_elem & 7) * 2;
}
__device__ __forceinline__ int swz256(int row, int col_elem) {
  return row * 256 + ((((col_elem >> 3) ^ (row & 7))) << 4) + (col_elem & 7) * 2;
}

__device__ __forceinline__ void hg_local(const P& p, int unit, char* lds) {
  const int hh = unit >> 7, n = unit & 127, tok0 = n * 64, colh = hh * 128;
  const int tid = otid(), lane = tid & 63, wid = tid >> 6, fr = lane & 15, fq = lane >> 4;
  float* cum = (float*)lds;
  char* qe = lds + 32768; char* ke = lds + 49152; char* kdT = lds + 65536; char* iT = lds + 81920; char* sc = lds + 98304;
  const bf16_t* hq = p.zb; const bf16_t* hk = p.zb + (size_t)1 * S * HW; const bf16_t* hi = p.zb + (size_t)2 * S * HW;
#pragma unroll
  for (int i = 0; i < 4; ++i) { const int id = tid + NTHREADS * i, t = id >> 5, c4 = (id & 31) * 4;
    *(f32x4*)(cum + t * 128 + c4) = *(const f32x4*)(p.logf + (size_t)(tok0 + t) * HW + colh + c4); }
  u32x4 q8a[2], k8a[2], i8a[2];
#pragma unroll
  for (int i = 0; i < 2; ++i) {
    const int id = tid + NTHREADS * i, t = id >> 4, k0 = (id & 15) * 8;
    const size_t gofs = (size_t)(tok0 + t) * HW + colh + k0;
    q8a[i] = *(const u32x4*)(hq + gofs); k8a[i] = *(const u32x4*)(hk + gofs); i8a[i] = *(const u32x4*)(hi + gofs);
  }
  __syncthreads();
  {
    const int k = tid & 127, part = tid >> 7;
    float run = 0.f;
    for (int t = 16 * part; t < 16 * part + 16; ++t) { run += cum[t * 128 + k]; cum[t * 128 + k] = run; }
    __syncthreads();
    float off = 0.f;
    for (int pp = 0; pp < part; ++pp) off += cum[(16 * pp + 15) * 128 + k];
    __syncthreads();
    if (part) for (int t = 16 * part; t < 16 * part + 16; ++t) cum[t * 128 + k] += off;
  }
  __syncthreads();
#pragma unroll
  for (int i = 0; i < 2; ++i) {
    const int id = tid + NTHREADS * i, t = id >> 4, k0 = (id & 15) * 8;
    const size_t gofs = (size_t)(tok0 + t) * HW + colh + k0;
    const u32x4 q8 = q8a[i], k8 = k8a[i], i8 = i8a[i];
    float qv[8], kv[8], iv[8], c8[8], r8[8], l8[8];
#pragma unroll
    for (int j = 0; j < 4; ++j) { qv[2 * j] = bflo(q8[j]); qv[2 * j + 1] = bfhi(q8[j]); kv[2 * j] = bflo(k8[j]); kv[2 * j + 1] = bfhi(k8[j]); iv[2 * j] = bflo(i8[j]); iv[2 * j + 1] = bfhi(i8[j]); }
#pragma unroll
    for (int j = 0; j < 8; ++j) { c8[j] = cum[t * 128 + k0 + j]; r8[j] = cum[31 * 128 + k0 + j]; l8[j] = cum[63 * 128 + k0 + j]; }
    float qe8[8], ke8[8], qd8[8];
#pragma unroll
    for (int j = 0; j < 8; ++j) {
      qe8[j] = qv[j] * __expf(c8[j] - r8[j]);
      ke8[j] = kv[j] * __expf(r8[j] - c8[j]);
      qd8[j] = qv[j] * __expf(c8[j]);
      const float kd = kv[j] * __expf(l8[j] - c8[j]);
      *(bf16_t*)(kdT + swz128(k0 + j, t)) = f2bf(kd);
      *(bf16_t*)(iT + swz128(k0 + j, t)) = (bf16_t)((j & 1) ? (i8[j >> 1] >> 16) : (i8[j >> 1] & 0xffffu));
    }
    *(bf16x8*)(qe + swz256(t, k0)) = pack8f(qe8);
    *(bf16x8*)(ke + swz256(t, k0)) = pack8f(ke8);
    *(bf16x8*)(p.qd + gofs) = pack8f(qd8);
  }
  if (tid < 128) p.elast[(size_t)(hh * 128 + n) * 128 + tid] = __expf(cum[63 * 128 + tid]);
  __syncthreads();
  {
    const int tt = wid >> 1;
#pragma unroll
    for (int e = 0; e < 2; ++e) {
      const int st = (wid & 1) * 2 + e;
      f32x4 a = {0.f, 0.f, 0.f, 0.f};
      if (st <= tt) {
#pragma unroll
        for (int kk = 0; kk < 4; ++kk) {
          const bf16x8 X = *(const bf16x8*)(ke + swz256(st * 16 + fr, kk * 32 + fq * 8));
          const bf16x8 Y = *(const bf16x8*)(qe + swz256(tt * 16 + fr, kk * 32 + fq * 8));
          a = mfma16(X, Y, a);
        }
      }
      const int t = tt * 16 + fr, s0 = st * 16 + 4 * fq;
#pragma unroll
      for (int r = 0; r < 4; ++r) if (s0 + r > t) a[r] = 0.f;
      u32x2 o = {cvtpk(a[0], a[1]), cvtpk(a[2], a[3])};
      *(u32x2*)(sc + swz128(t, s0)) = o;
    }
  }
  __syncthreads();
  {
    const int tt = wid & 3;
#pragma unroll
    for (int e = 0; e < 4; ++e) {
      const int vt = (wid >> 2) * 4 + e;
      f32x4 a = {0.f, 0.f, 0.f, 0.f};
#pragma unroll
      for (int kk = 0; kk < 2; ++kk) {
        const bf16x8 X = *(const bf16x8*)(iT + swz128(vt * 16 + fr, kk * 32 + fq * 8));
        const bf16x8 Y = *(const bf16x8*)(sc + swz128(tt * 16 + fr, kk * 32 + fq * 8));
        a = mfma16(X, Y, a);
      }
      *(f32x4*)(p.oin + (size_t)(tok0 + tt * 16 + fr) * HW + colh + vt * 16 + 4 * fq) = a;
    }
  }
  {
    const int vt = wid;
#pragma unroll
    for (int kt = 0; kt < 8; ++kt) {
      f32x4 a = {0.f, 0.f, 0.f, 0.f};
#pragma unroll
      for (int kk = 0; kk < 2; ++kk) {
        const bf16x8 X = *(const bf16x8*)(kdT + swz128(kt * 16 + fr, kk * 32 + fq * 8));
        const bf16x8 Y = *(const bf16x8*)(iT + swz128(vt * 16 + fr, kk * 32 + fq * 8));
        a = mfma16(X, Y, a);
      }
      { u32x2 o = {cvtpk(a[0], a[1]), cvtpk(a[2], a[3])}; *(u32x2*)((bf16_t*)p.SlocT + ((size_t)(hh * 128 + n) * 128 + vt * 16 + fr) * 128 + kt * 16 + 4 * fq) = o; }
    }
  }
  __syncthreads();
}

__device__ __forceinline__ void s5_local(const P& p, int l, int unit, char* lds) {
  const int g = unit >> 1, half = unit & 1;
  const int tid = otid(), lane = tid & 63, wid = tid >> 6, fr = lane & 15, fq = lane >> 4;
  const int cb = half * 8 + wid, n = 16 * cb + fr;
  const bf16_t* su = p.zb + (size_t)4 * S * HW;
  const bf16_t* M1 = p.M1 + (size_t)(l * 64 + g) * 128 * 512;
#pragma unroll 4
  for (int i = 0; i < 16; ++i) {
    const int idx = tid + NTHREADS * i, row = idx >> 6, ch = idx & 63;
    *(u32x4*)(lds + row * 1024 + ((ch ^ (row & 15)) << 4)) = *(const u32x4*)(M1 + row * 512 + ch * 8);
  }
  bf16x8 Y[16];
#pragma unroll
  for (int kk = 0; kk < 16; ++kk) Y[kk] = *(const bf16x8*)(su + (size_t)(n * SL + 2 * kk + (fq >> 1)) * HW + g * 16 + (fq & 1) * 8);
  __syncthreads();
  f32x4 acc[8];
#pragma unroll
  for (int i = 0; i < 8; ++i) acc[i] = (f32x4){0.f, 0.f, 0.f, 0.f};
#pragma unroll
  for (int kk = 0; kk < 16; ++kk) {
#pragma unroll
    for (int pt = 0; pt < 8; ++pt) {
      const bf16x8 X = *(const bf16x8*)(lds + (pt * 16 + fr) * 1024 + (((kk * 4 + fq) ^ fr) << 4));
      acc[pt] = mfma16(X, Y[kk], acc[pt]);
    }
    if ((kk & 1) == 1) __builtin_amdgcn_sched_barrier(0);
  }
#pragma unroll
  for (int pt = 0; pt < 8; ++pt) *(f32x4*)(p.Xloc + ((size_t)g * NCH + n) * 128 + pt * 16 + 4 * fq) = acc[pt];
  __syncthreads();
}

__device__ __forceinline__ void fox_cumsum(const P& p, int hh, char* lds) {
  float* wt = (float*)lds;
  const int tid = otid(), lane = tid & 63, wid = tid >> 6;
  float v[16];
  float run = 0.f;
#pragma unroll
  for (int j = 0; j < 16; ++j) { run += p.lsf[(tid * 16 + j) * 8 + hh]; v[j] = run; }
  float inc = run;
#pragma unroll
  for (int o = 1; o < 64; o <<= 1) { const float t = __shfl_up(inc, o); if (lane >= o) inc += t; }
  if (lane == 63) wt[wid] = inc;
  __syncthreads();
  float base = inc - run;
  for (int w = 0; w < wid; ++w) base += wt[w];
#pragma unroll
  for (int j = 0; j < 16; ++j) p.cc[hh * S + tid * 16 + j] = base + v[j];
  __syncthreads();
}

__device__ __forceinline__ void phase_local(const P& p, int l, char* lds) {
  constexpr int NU = 1024 + 128 + 8;
  for (int u = obid(); u < NU; u += ogdim()) {
    if (u < 1024) hg_local(p, u, lds);
    else if (u < 1152) { const int j = u - 1024; s5_local(p, l, ((j & 7) << 4) | (j >> 3), lds); }
    else fox_cumsum(p, u - 1152, lds);
  }
}

__device__ __forceinline__ void phase_scan(const P& p, int l) {
  constexpr int NU = 128 + 8;
  const int tid = otid();
  for (int u = obid(); u < NU; u += ogdim()) {
    if (u < 128) {
      const int e2 = u * NTHREADS + tid, hh = e2 >> 13, rem = e2 & 8191, v = rem >> 6, k = (rem & 63) * 2;
      float s0 = 0.f, s1 = 0.f;
#pragma unroll 16
      for (int n = 0; n < 128; ++n) {
        const size_t idx = ((size_t)(hh * 128 + n) * 128 + v) * 128 + k;
        const unsigned lu = *(const unsigned*)((const bf16_t*)p.SlocT + idx); const f32x2 loc = {bflo(lu), bfhi(lu)};
        const f32x2 el = *(const f32x2*)(p.elast + (size_t)(hh * 128 + n) * 128 + k);
        *(unsigned*)(p.SprevT + idx) = cvtpk(s0, s1);
        s0 = el[0] * s0 + loc[0]; s1 = el[1] * s1 + loc[1];
      }
    } else {
      const int gid = (u - 128) * NTHREADS + tid, g = gid >> 6, pp = gid & 63;
      const float ar = p.AL[((l * 64 + g) * 64 + pp) * 2], ai = p.AL[((l * 64 + g) * 64 + pp) * 2 + 1];
      float sr = 0.f, si = 0.f;
#pragma unroll 16
      for (int n = 0; n < NCH; ++n) {
        const size_t idx = ((size_t)g * NCH + n) * 128 + pp;
        const float xr = p.Xloc[idx], xi = p.Xloc[idx + 64];
        p.Xprev[idx] = f2bf(sr); p.Xprev[idx + 64] = f2bf(si);
        const float nr = ar * sr - ai * si + xr, ni = ar * si + ai * sr + xi;
        sr = nr; si = ni;
      }
    }
  }
}

__device__ __forceinline__ void hg_out(const P& p, int l, int bu) {
  const int hh = bu >> 6, np = bu & 63;
  const int tid = otid(), lane = tid & 63, wid = tid >> 6, fr = lane & 15, fq = lane >> 4;
  const int n = np * 2 + (wid >> 2), tt = wid & 3, colh = hh * 128;
  const int token = n * 64 + tt * 16 + fr;
  const bf16_t* sp = p.SprevT + (size_t)(hh * 128 + n) * 128 * 128;
  f32x4 acc[8];
#pragma unroll
  for (int i = 0; i < 8; ++i) acc[i] = (f32x4){0.f, 0.f, 0.f, 0.f};
#pragma unroll
  for (int kk = 0; kk < 4; ++kk) {
    const bf16x8 Y = *(const bf16x8*)(p.qd + (size_t)token * HW + colh + kk * 32 + fq * 8);
#pragma unroll
    for (int vt = 0; vt < 8; ++vt) {
      const bf16x8 X = *(const bf16x8*)(sp + (size_t)(vt * 16 + fr) * 128 + kk * 32 + fq * 8);
      acc[vt] = mfma16(X, Y, acc[vt]);
    }
  }
  float ss = 0.f;
#pragma unroll
  for (int vt = 0; vt < 8; ++vt) {
    const f32x4 o = *(const f32x4*)(p.oin + (size_t)token * HW + colh + vt * 16 + 4 * fq);
    acc[vt] += o;
    ss += acc[vt][0] * acc[vt][0] + acc[vt][1] * acc[vt][1] + acc[vt][2] * acc[vt][2] + acc[vt][3] * acc[vt][3];
  }
  ss += __shfl_xor(ss, 16);
  ss += __shfl_xor(ss, 32);
  const float rstd = rsqrtf(ss * (1.f / 128.f) + EPS);
  const bf16_t* sg = p.zb + (size_t)3 * S * HW;
#pragma unroll
  for (int vt = 0; vt < 8; ++vt) {
    const int c = colh + vt * 16 + 4 * fq;
    const f32x4 gn = *(const f32x4*)(p.hg_norm_g + l * HW + c);
    const u32x2 gt = *(const u32x2*)(sg + (size_t)token * HW + c);
    const float o0 = acc[vt][0] * rstd * gn[0] * bflo(gt[0]), o1 = acc[vt][1] * rstd * gn[1] * bfhi(gt[0]);
    const float o2 = acc[vt][2] * rstd * gn[2] * bflo(gt[1]), o3 = acc[vt][3] * rstd * gn[3] * bfhi(gt[1]);
    u32x2 o = {cvtpk(o0, o1), cvtpk(o2, o3)};
    *(u32x2*)(p.oa + (size_t)token * HW + c) = o;
  }
}

__device__ __forceinline__ void s5_out(const P& p, int l, int unit, char* lds) {
  const int g = unit >> 1, half = unit & 1;
  const int tid = otid(), lane = tid & 63, wid = tid >> 6, fr = lane & 15, fq = lane >> 4;
  const int cb = half * 8 + wid, n = 16 * cb + fr;
  const bf16_t* su = p.zb + (size_t)4 * S * HW;
  const bf16_t* M2 = p.M2 + (size_t)(l * 64 + g) * 512 * 128;
  {
    const u32x4* src = (const u32x4*)(p.Ktab + (size_t)(l * 64 + g) * 32 * 256);
    u32x4* dst = (u32x4*)(lds + 512);
    dst[tid] = src[tid]; dst[tid + 512] = src[tid + 512];
    if (tid < 32) { unsigned z = 0u; asm volatile("" : "+v"(z)); ((u32x4*)lds)[tid] = (u32x4){z, z, z, z}; }
#pragma unroll 4
    for (int i = 0; i < 16; ++i) {
      const int idx = tid + NTHREADS * i, row = idx >> 4, ch = idx & 15;
      *(u32x4*)(lds + 17408 + row * 256 + ((ch ^ (row & 15)) << 4)) = *(const u32x4*)(M2 + row * 128 + ch * 8);
    }
  }
  __syncthreads();
  const char* tb = lds + ((1 - (fq >> 1)) * 256 + fr * 16 + (fq & 1) * 8) * 2;
  bf16x8 U[16], Xp[4];
#pragma unroll
  for (int kk = 0; kk < 16; ++kk) U[kk] = *(const bf16x8*)(su + (n * SL + 2 * kk + (fq >> 1)) * HW + g * 16 + (fq & 1) * 8);
#pragma unroll
  for (int kk = 0; kk < 4; ++kk) Xp[kk] = *(const bf16x8*)(p.Xprev + (g * NCH + n) * 128 + kk * 32 + fq * 8);
  const f32x4 dsk = *(const f32x4*)(p.s5_d + l * HW + g * 16 + 4 * fq);
#pragma unroll
  for (int th = 0; th < 2; ++th) {
    f32x4 acc[16];
#pragma unroll
    for (int ti = 0; ti < 16; ++ti) acc[ti] = (f32x4){0.f, 0.f, 0.f, 0.f};
#pragma unroll
    for (int kk = 0; kk < 4; ++kk) {
#pragma unroll
      for (int ti = 0; ti < 16; ++ti) {
        const int t = 16 * th + ti;
        const bf16x8 X = *(const bf16x8*)(lds + 17408 + (t * 16 + fr) * 256 + (((kk * 4 + fq) ^ fr) << 4));
        acc[ti] = mfma16(X, Xp[kk], acc[ti]);
        if ((ti & 7) == 7) __builtin_amdgcn_sched_barrier(0);
      }
    }
#pragma unroll
    for (int kk = 0; kk < 8 * th + 8; ++kk) {
#pragma unroll
      for (int ti = 0; ti < 16; ++ti) {
        const int t = 16 * th + ti;
        if (t >= 2 * kk) {
          const bf16x8 X = *(const bf16x8*)(tb + (t - 2 * kk) * 512);
          acc[ti] = mfma16(X, U[kk], acc[ti]);
        }
        if ((ti & 7) == 7) __builtin_amdgcn_sched_barrier(0);
      }
    }
#pragma unroll
    for (int ti = 0; ti < 16; ++ti) {
      const int t = 16 * th + ti;
      const int o = (n * SL + t) * HW + g * 16 + 4 * fq;
      const u32x2 uu = *(const u32x2*)(su + o);
      const float y0 = gelu_tanh(acc[ti][0] + dsk[0] * bflo(uu[0])), y1 = gelu_tanh(acc[ti][1] + dsk[1] * bfhi(uu[0]));
      const float y2 = gelu_tanh(acc[ti][2] + dsk[2] * bflo(uu[1])), y3 = gelu_tanh(acc[ti][3] + dsk[3] * bfhi(uu[1]));
      u32x2 ov = {cvtpk(y0, y1), cvtpk(y2, y3)};
      *(u32x2*)(p.yg + o) = ov;
      if ((ti & 3) == 3) __builtin_amdgcn_sched_barrier(0);
    }
  }
  __syncthreads();
}

__device__ __forceinline__ void phase_out(const P& p, int l, char* lds) {
  const int G = ogdim(), b = obid();
  if (G == 256) {
    if (b < 128) s5_out(p, l, ((b & 7) << 4) | (b >> 3), lds);
    const int u0 = b < 128 ? 384 + b : (b - 128) * 3, n = b < 128 ? 1 : 3;
#pragma unroll 1
    for (int i = 0; i < n; ++i) hg_out(p, l, u0 + i);
  } else {
#pragma unroll 1
    for (int u = b; u < 512; u += G) hg_out(p, l, u);
#pragma unroll 1
    for (int u = b; u < 128; u += G) s5_out(p, l, u, lds);
  }
}

namespace fa {
constexpr int D = 128, QBLK = 32, KVBLK = 64, QB = 256, LD = 1024, LDQ = 128;
constexpr int SHM_V = 16384, SHM_K = 16384;
constexpr int OFF_WS = 2 * SHM_V + 2 * SHM_K, OFF_BIAS = 69632;
constexpr float SCALE = 0.08838834764831845f, SQRTD = 11.313708498984761f, THR = 8.f;
constexpr unsigned WBIG = 0x40000000u;
#define KSWZ(row, colB) ((row) * 256 + ((colB) ^ (((row) & 7) << 4)))
#define SBAR() __builtin_amdgcn_sched_barrier(0)
__device__ __forceinline__ int v_st(int k, int c) { const int kk = (k & ~0xC) | ((k & 4) << 1) | ((k & 8) >> 1); return ((kk >> 3) * 4 + (c >> 5)) * 512 + ((kk & 7) * 32 + (c & 31)) * 2; }
__device__ __forceinline__ int v_rd_base(int lane) { return ((lane & 3) << 3) | (((lane >> 2) & 3) << 6) | (((lane >> 4) & 1) << 5) | (((lane >> 5) & 1) << 8); }
constexpr int v_rd_off(int d0, int ks, int half) { return d0 * 512 + ks * 4096 + half * 2048; }
__device__ __forceinline__ int crow(int r, int hi) { return (r & 3) + 8 * (r >> 2) + 4 * hi; }
__device__ __forceinline__ unsigned cvtpkv(float lo, float hi) { unsigned r; asm volatile("v_cvt_pk_bf16_f32 %0, %1, %2" : "=v"(r) : "v"(lo), "v"(hi)); return r; }

__device__ __forceinline__ void mask_tile(f32x16& p0, f32x16& p1, int dq, unsigned W) {
  const float NEG = -__builtin_inff();
#pragma unroll
  for (int r = 0; r < 16; ++r) {
    const int c = (r & 3) + 8 * (r >> 2);
    if ((unsigned)(dq - c) >= W) p0[r] = NEG;
    if ((unsigned)(dq - c - 32) >= W) p1[r] = NEG;
  }
}
__device__ __forceinline__ void partialSM(f32x16& p0, f32x16& p1, float& m_reg, float& mn, float& alpha) {
  float pmax = p0[0];
#pragma unroll
  for (int r = 1; r < 16; ++r) pmax = fmaxf(pmax, p0[r]);
#pragma unroll
  for (int r = 0; r < 16; ++r) pmax = fmaxf(pmax, p1[r]);
  { auto rr = __builtin_amdgcn_permlane32_swap(__float_as_uint(pmax), __float_as_uint(pmax), false, false);
    pmax = fmaxf(__uint_as_float(rr[0]), __uint_as_float(rr[1])); }
  constexpr float C2 = 1.4426950408889634f * SCALE;
  if (__builtin_expect(__all((pmax - m_reg) * SCALE <= THR), 1)) { mn = m_reg; alpha = 1.f; }
  else { mn = fmaxf(m_reg, pmax); alpha = __builtin_amdgcn_exp2f((m_reg - mn) * C2); m_reg = mn; }
  const float mnL = -mn * C2;
#pragma unroll
  for (int r = 0; r < 16; ++r) p0[r] = fmaf(p0[r], C2, mnL);
#pragma unroll
  for (int r = 0; r < 16; ++r) p1[r] = fmaf(p1[r], C2, mnL);
#pragma unroll
  for (int r = 0; r < 16; ++r) p0[r] = __builtin_amdgcn_exp2f(p0[r]);
}
__device__ __forceinline__ void finishSM(f32x16& p0, f32x16& p1, float alpha, float& l_reg, bf16x8& pa0, bf16x8& pa1, bf16x8& pa2, bf16x8& pa3) {
#pragma unroll
  for (int r = 0; r < 16; ++r) p1[r] = __builtin_amdgcn_exp2f(p1[r]);
  float ps = 0;
#pragma unroll
  for (int r = 0; r < 16; ++r) ps += p0[r];
#pragma unroll
  for (int r = 0; r < 16; ++r) ps += p1[r];
  { auto rr = __builtin_amdgcn_permlane32_swap(__float_as_uint(ps), __float_as_uint(ps), false, false);
    ps = __uint_as_float(rr[0]) + __uint_as_float(rr[1]); }
  l_reg = l_reg * alpha + ps;
#define PK4(Pv, B_, OUT) do { unsigned a0 = cvtpkv(Pv[B_+0], Pv[B_+1]), a1 = cvtpkv(Pv[B_+2], Pv[B_+3]); \
    unsigned b0 = cvtpkv(Pv[B_+4], Pv[B_+5]), b1 = cvtpkv(Pv[B_+6], Pv[B_+7]); \
    auto r0 = __builtin_amdgcn_permlane32_swap(a0, b0, false, false); auto r1 = __builtin_amdgcn_permlane32_swap(a1, b1, false, false); \
    u32x4 w = {r0[0], r1[0], r0[1], r1[1]}; OUT = *reinterpret_cast<bf16x8*>(&w); } while (0)
  PK4(p0, 0, pa0); PK4(p0, 8, pa1); PK4(p1, 0, pa2); PK4(p1, 8, pa3);
#undef PK4
}
template <int KB>
__device__ __forceinline__ void qkt(f32x16& p0, f32x16& p1, const char* lds, int r32, int hi, const bf16x8* qr) {
  const char* K_lds = lds + 2 * SHM_V;
  p0 = f32x16{}; p1 = f32x16{};
  const char* kb[4];
#pragma unroll
  for (int dd = 0; dd < 4; ++dd) kb[dd] = K_lds + KB * SHM_K + KSWZ(r32, (dd * 16 + hi * 8) * 2);
#pragma unroll
  for (int d0 = 0; d0 < 8; ++d0) { const char* a = kb[d0 & 3] + (d0 >> 2) * 128;
    bf16x8 b0 = *reinterpret_cast<const bf16x8*>(a);
    bf16x8 b1 = *reinterpret_cast<const bf16x8*>(a + 32 * 256);
    p0 = __builtin_amdgcn_mfma_f32_32x32x16_bf16(b0, qr[d0], p0, 0, 0, 0);
    p1 = __builtin_amdgcn_mfma_f32_32x32x16_bf16(b1, qr[d0], p1, 0, 0, 0); }
}
__device__ __forceinline__ void add_bias(f32x16& p0, f32x16& p1, const char* lds, int hi, int kbase) {
  const float* bb = (const float*)(lds + OFF_BIAS) + kbase + 4 * hi;
#pragma unroll
  for (int j = 0; j < 4; ++j) {
    const f32x4 t0 = *(const f32x4*)(bb + 8 * j), t1 = *(const f32x4*)(bb + 32 + 8 * j);
    p0[4 * j] += t0[0]; p0[4 * j + 1] += t0[1]; p0[4 * j + 2] += t0[2]; p0[4 * j + 3] += t0[3];
    p1[4 * j] += t1[0]; p1[4 * j + 1] += t1[1]; p1[4 * j + 2] += t1[2]; p1[4 * j + 3] += t1[3];
  }
}
template <int VB>
__device__ __forceinline__ void pv_tile(f32x16* o, int vb0, bf16x8 pa0, bf16x8 pa1, bf16x8 pa2, bf16x8 pa3) {
#define TRRD(dst, off) asm volatile("ds_read_b64_tr_b16 %0, %1 offset:%2" : "=&v"(dst) : "v"(vb0), "i"(off) : "memory")
#define PV_D0(d0) do { s16x4 l0, l1, l2, l3, h0, h1, h2, h3; constexpr int b_ = VB * SHM_V + v_rd_off(d0, 0, 0); \
    TRRD(l0, b_); TRRD(h0, b_ + 2048); TRRD(l1, b_ + 4096); TRRD(h1, b_ + 6144); TRRD(l2, b_ + 8192); TRRD(h2, b_ + 10240); TRRD(l3, b_ + 12288); TRRD(h3, b_ + 14336); \
    asm volatile("s_waitcnt lgkmcnt(0)" ::: "memory"); SBAR(); \
    o[d0] = __builtin_amdgcn_mfma_f32_32x32x16_bf16(pa0, (bf16x8){l0[0], l0[1], l0[2], l0[3], h0[0], h0[1], h0[2], h0[3]}, o[d0], 0, 0, 0); \
    o[d0] = __builtin_amdgcn_mfma_f32_32x32x16_bf16(pa1, (bf16x8){l1[0], l1[1], l1[2], l1[3], h1[0], h1[1], h1[2], h1[3]}, o[d0], 0, 0, 0); \
    o[d0] = __builtin_amdgcn_mfma_f32_32x32x16_bf16(pa2, (bf16x8){l2[0], l2[1], l2[2], l2[3], h2[0], h2[1], h2[2], h2[3]}, o[d0], 0, 0, 0); \
    o[d0] = __builtin_amdgcn_mfma_f32_32x32x16_bf16(pa3, (bf16x8){l3[0], l3[1], l3[2], l3[3], h3[0], h3[1], h3[2], h3[3]}, o[d0], 0, 0, 0); } while (0)
  PV_D0(0); PV_D0(1); PV_D0(2); PV_D0(3);
#undef PV_D0
#undef TRRD
}

struct BlockRef { const bf16_t* Q; const bf16_t* K; const bf16_t* V; const bf16_t* G; bf16_t* O; const float* C; int P0; };
struct Seam { bf16x8 qr[8]; bf16x8 st_v0, st_v1, st_k0, st_k1; };

#define ROWP(pp, k0, rr) ((pp) + (size_t)((k0) + (rr)) * LDQ + sc)
#define VMW() asm volatile("s_waitcnt vmcnt(0)" ::: "memory")
#define VMWN(n) asm volatile("s_waitcnt vmcnt(%0)" :: "i"(n) : "memory")
#define LD8(ptr) (*reinterpret_cast<const bf16x8*>(ptr))
#define SLOAD_H(ref, k0) do { S.st_v0 = LD8(ROWP((ref).V, k0, sr)); S.st_v1 = LD8(ROWP((ref).V, k0, 32 + sr)); \
    S.st_k0 = LD8(ROWP((ref).K, k0, sr)); S.st_k1 = LD8(ROWP((ref).K, k0, 32 + sr)); } while (0)
#define SWRITE_HK(bf) do { *(bf16x8*)(K_lds + (bf) * SHM_K + kws) = S.st_k0; *(bf16x8*)(K_lds + (bf) * SHM_K + kws + 32 * 256) = S.st_k1; } while (0)
#define SWRITE_HV(bf) do { *(bf16x8*)(V_lds + (bf) * SHM_V + vst0) = S.st_v0; *(bf16x8*)(V_lds + (bf) * SHM_V + vst1) = S.st_v1; } while (0)
#define SWRITE_H(bf) do { SWRITE_HV(bf); SWRITE_HK(bf); } while (0)

__device__ __forceinline__ void prime(const BlockRef& cur, int j_lo, int j_hi, char* lds, Seam& S) {
  const int tid = otid(), wid = __builtin_amdgcn_readfirstlane(tid >> 6), lane = tid & 63, r32 = lane & 31, hi = lane >> 5;
  const int sr = tid >> 4, sc = (tid & 15) * 8, kws = KSWZ(sr, sc * 2); char* K_lds = lds + 2 * SHM_V;
  const float cref = cur.C[cur.P0 + QB - 1];
#pragma unroll
  for (int d0 = 0; d0 < 8; ++d0) S.qr[d0] = LD8(cur.Q + (size_t)(wid * QBLK + r32) * LDQ + d0 * 16 + hi * 8);
  SLOAD_H(cur, j_lo * KVBLK);
  { float* ct = (float*)(lds + OFF_BIAS); const int k1 = j_hi * KVBLK;
#pragma unroll 4
    for (int i = j_lo * KVBLK + tid; i < k1; i += NTHREADS) ct[i] = (cref - cur.C[i]) * SQRTD; }
  VMW(); SWRITE_HK(0);
  __syncthreads();
}

__device__ __forceinline__ void block(const BlockRef& cur, int j_lo, int j_hi, float* opart, float* mlpart, char* lds, Seam& S) {
  const int tid = otid(), wid = __builtin_amdgcn_readfirstlane(tid >> 6), lane = tid & 63, r32 = lane & 31, hi = lane >> 5;
  const int NT = j_hi - j_lo;
  const int qlo = cur.P0 + wid * QBLK, qm = qlo + r32 - 4 * hi;
  char* V_lds = lds; char* K_lds = lds + 2 * SHM_V;
  float* ws = (float*)(lds + OFF_WS) + wid * 64; float* li_l = ws, * al_l = ws + 32;
  float m_reg = -1e30f, l_reg = 0; f32x16 o[4] = {};
  const int sr = tid >> 4, sc = (tid & 15) * 8, vst0 = v_st(sr, sc), vst1 = v_st(32 + sr, sc), kws = KSWZ(sr, sc * 2);
  const int vb0 = (int)(uintptr_t)V_lds + v_rd_base(lane);
#define RESC(a) do { if (__any((a) < 1.f)) { if (hi == 0) al_l[r32] = (a); asm volatile("s_waitcnt lgkmcnt(0)" ::: "memory"); \
    for (int d_ = 0; d_ < 4; ++d_) for (int r = 0; r < 16; ++r) o[d_][r] *= al_l[crow(r, hi)]; } } while (0)
#define KBASE(t) ((j_lo + (t)) * KVBLK)
#define MASKT(P0_, P1_, t) do { const int kb_ = KBASE(t); if (kb_ + KVBLK - 1 > qlo) mask_tile(P0_, P1_, qm - kb_, WBIG); } while (0)
  constexpr int NQL = 8;
#define SEAM_K0() do { VMWN(NQL); SWRITE_HK(0); SBAR(); } while (0)
  f32x16 pA0, pA1, pB0, pB1; float mnA, mnB, alA, alB; bf16x8 pa0, pa1, pa2, pa3;
  SWRITE_HV(0); SBAR();
  if (NT > 1) { SLOAD_H(cur, KBASE(1)); }
  SBAR(); qkt<0>(pA0, pA1, lds, r32, hi, S.qr);
  add_bias(pA0, pA1, lds, hi, KBASE(0)); MASKT(pA0, pA1, 0); partialSM(pA0, pA1, m_reg, mnA, alA);
  if (NT > 1) { VMW(); SWRITE_H(1); }
  __syncthreads();
#define HALF_STEP(PX0, PX1, mnX, alX, PY0, PY1, alY, t, KB, VB, SB) do { \
    SBAR(); qkt<KB>(PX0, PX1, lds, r32, hi, S.qr); \
    finishSM(PY0, PY1, alY, l_reg, pa0, pa1, pa2, pa3); SBAR(); \
    if ((t) + 1 < NT) { SLOAD_H(cur, KBASE((t) + 1)); SBAR(); } \
    pv_tile<VB>(o, vb0, pa0, pa1, pa2, pa3); add_bias(PX0, PX1, lds, hi, KBASE(t)); MASKT(PX0, PX1, (t)); partialSM(PX0, PX1, m_reg, mnX, alX); \
    __syncthreads(); \
    if ((t) + 1 < NT) { VMW(); SWRITE_H(SB); } \
    RESC(alX); __syncthreads(); } while (0)
  for (int t = 1; t + 1 < NT; t += 2) {
    HALF_STEP(pB0, pB1, mnB, alB, pA0, pA1, alA, t, 1, 0, 0);
    HALF_STEP(pA0, pA1, mnA, alA, pB0, pB1, alB, t + 1, 0, 1, 1);
  }
  const bool even = (NT & 1) == 0;
  if (even) { SBAR(); qkt<1>(pB0, pB1, lds, r32, hi, S.qr); SBAR(); }
  finishSM(pA0, pA1, alA, l_reg, pa0, pa1, pa2, pa3); SBAR();
  pv_tile<0>(o, vb0, pa0, pa1, pa2, pa3);
  if (even) { add_bias(pB0, pB1, lds, hi, KBASE(NT - 1)); MASKT(pB0, pB1, NT - 1); partialSM(pB0, pB1, m_reg, mnB, alB); __syncthreads(); RESC(alB);
    finishSM(pB0, pB1, alB, l_reg, pa0, pa1, pa2, pa3); SBAR(); pv_tile<1>(o, vb0, pa0, pa1, pa2, pa3); }
  SBAR();
  if (opart) {
    if (hi == 0) { mlpart[wid * QBLK + r32] = m_reg; mlpart[256 + wid * QBLK + r32] = l_reg; }
    float* Ow = opart + wid * QBLK * 128;
#pragma unroll
    for (int r = 0; r < 16; ++r) { const int orow = crow(r, hi);
#pragma unroll
      for (int d0 = 0; d0 < 4; ++d0) Ow[orow * 128 + d0 * 32 + r32] = o[d0][r]; }
  } else {
    if (hi == 0) li_l[r32] = l_reg; asm volatile("s_waitcnt lgkmcnt(0)" ::: "memory");
    float rli[16];
#pragma unroll
    for (int r = 0; r < 16; ++r) rli[r] = __builtin_amdgcn_rcpf(li_l[crow(r, hi)]);
    bf16_t* Ow = cur.O + wid * QBLK * LD;
#pragma unroll
    for (int r = 0; r < 16; ++r) { const int orow = crow(r, hi);
#pragma unroll
      for (int d0 = 0; d0 < 4; ++d0) { const float v = o[d0][r] * rli[r];
        const float vn = __shfl_xor(v, 1);
        if ((r32 & 1) == 0) *(unsigned*)(Ow + orow * LD + d0 * 32 + r32) = cvtpkv(v, vn); }
    }
  }
  __syncthreads();
#undef RESC
#undef KBASE
#undef MASKT
#undef SEAM_K0
#undef HALF_STEP
}
#undef ROWP
#undef VMW
#undef VMWN
#undef SLOAD_H
#undef SWRITE_HK
#undef SWRITE_HV
#undef SWRITE_H

__device__ __forceinline__ BlockRef mkref(const P& p, int hh, int qb) {
  BlockRef r; const size_t ho = (size_t)hh * 128, ro = (size_t)qb * QB * LD, hm = (size_t)hh * S * 128;
  r.Q = p.zb + (size_t)6 * S * HW + hm + (size_t)qb * QB * 128; r.K = p.zb + (size_t)7 * S * HW + hm; r.V = p.zb + (size_t)8 * S * HW + hm;
  r.G = p.zb + (size_t)9 * S * HW + ro + ho; r.O = p.oc + ro + ho; r.C = p.cc + (size_t)hh * S; r.P0 = qb * QB;
  return r;
}
__device__ __forceinline__ void pair_work(const P& p, int l, int w, char* lds) {
  const int tid = otid();
  const int hh = w & 7, role = (w >> 3) & 1, x = w >> 4, pi = x * 8 + hh;
  float* opart = p.opart + (size_t)(pi * 2 + role) * 32768; float* mlpart = p.mlpart + (size_t)(pi * 2 + role) * 512;
#pragma unroll 1
  for (int k = 0; k <= role; ++k) {
    const BlockRef b0 = mkref(p, hh, k ? x : 31 - x);
    const int split = x <= 13 ? 68 : 66;
    const int j_lo = (k == 0 && role) ? split : 0;
    const int j_hi = k ? 4 * (x + 1) : (role ? 4 * (32 - x) : split);
    Seam S;
    prime(b0, j_lo, j_hi, lds, S);
    block(b0, j_lo, j_hi, k ? nullptr : opart, mlpart, lds, S);
    if (k) {
      asm volatile("s_waitcnt vmcnt(0)" ::: "memory"); __syncthreads();
      if (tid == 0) { __builtin_amdgcn_fence(__ATOMIC_ACQUIRE, "agent"); asm volatile("s_waitcnt vmcnt(0)" ::: "memory"); }
      __syncthreads();
#pragma unroll 2
      for (int i = 0; i < 8; ++i) {
        const int id = tid + NTHREADS * i, row = id >> 4, ch = id & 15;
        bf16_t* op = b0.O + row * LD + ch * 8;
        const u32x4 ov = *(const u32x4*)op, gv = *(const u32x4*)(b0.G + row * LD + ch * 8);
        u32x4 r;
#pragma unroll
        for (int j = 0; j < 4; ++j) r[j] = cvtpk(bflo(ov[j]) * bflo(gv[j]), bfhi(ov[j]) * bfhi(gv[j]));
        *(u32x4*)op = r;
      }
      __syncthreads();
    }
  }
  asm volatile("s_waitcnt vmcnt(0)" ::: "memory"); __syncthreads();
  unsigned* flag = (unsigned*)(lds + OFF_WS);
  if (tid == 0) {
    __builtin_amdgcn_fence(__ATOMIC_RELEASE, "agent"); asm volatile("s_waitcnt vmcnt(0)" ::: "memory");
    const unsigned o_ = __hip_atomic_fetch_add(p.bar + XCD_BAR_WORDS + l * 128 + pi, 1u, __ATOMIC_RELAXED, __HIP_MEMORY_SCOPE_AGENT);
    if (o_ == 1u) { __builtin_amdgcn_fence(__ATOMIC_ACQUIRE, "agent"); asm volatile("s_waitcnt vmcnt(0)" ::: "memory"); }
    *flag = o_;
  }
  __syncthreads();
  const unsigned old = *flag;
  __syncthreads();
  if (old == 1u) {
    const BlockRef hv = mkref(p, hh, 31 - x);
    const float* oA = p.opart + (size_t)(pi * 2) * 32768; const float* oB = oA + 32768;
    const float* mA = p.mlpart + (size_t)(pi * 2) * 512; const float* mB = mA + 512;
    const int row = tid >> 1, c0 = (tid & 1) * 64;
    constexpr float C2 = 1.4426950408889634f * SCALE;
    const float ma = mA[row], la = mA[256 + row], mb = mB[row], lb = mB[256 + row];
    const float M = fmaxf(ma, mb), wa = __builtin_amdgcn_exp2f((ma - M) * C2), wb = __builtin_amdgcn_exp2f((mb - M) * C2);
    const float inv = 1.f / (la * wa + lb * wb);
#pragma unroll 4
    for (int j = 0; j < 16; ++j) {
      const f32x4 a = *(const f32x4*)(oA + row * 128 + c0 + 4 * j), b = *(const f32x4*)(oB + row * 128 + c0 + 4 * j);
      const u32x2 g = *(const u32x2*)(hv.G + row * LD + c0 + 4 * j);
      const float v0 = (a[0] * wa + b[0] * wb) * inv * bflo(g[0]), v1 = (a[1] * wa + b[1] * wb) * inv * bfhi(g[0]);
      const float v2 = (a[2] * wa + b[2] * wb) * inv * bflo(g[1]), v3 = (a[3] * wa + b[3] * wb) * inv * bfhi(g[1]);
      u32x2 ov = {cvtpk(v0, v1), cvtpk(v2, v3)};
      *(u32x2*)(hv.O + row * LD + c0 + 4 * j) = ov;
    }
  }
  __syncthreads();
}
}

__device__ __forceinline__ void glu_tile(const P& p, int l, int t, char* lds) {
  const int tid = otid(), lane = tid & 63, wid = tid >> 6, wr = wid >> 2, wc = wid & 3, fr = lane & 15, fq = lane >> 4;
  const int pm = t & 31, pn = t >> 5;
  f32x4 acc[8][4];
  zero_acc<4>(acc);
  gemm8_main(acc, p.yg + (size_t)pm * 256 * HW, p.WgluT + ((size_t)l * 2048 + (size_t)pn * 256) * HW, HW, lds);
  const bf16_t* sg = p.zb + (size_t)5 * S * HW;
#pragma unroll
  for (int m = 0; m < 8; ++m)
#pragma unroll
    for (int nt = 0; nt < 2; ++nt) {
      const int row = pm * 256 + (m >> 2) * 128 + wr * 64 + (m & 3) * 16 + fr, c = pn * 128 + wc * 32 + nt * 16 + 4 * fq;
      const u32x2 gt = *(const u32x2*)(sg + (size_t)row * HW + c);
      const f32x4 v = acc[m][nt], gg = acc[m][nt + 2];
      const float o0 = v[0] * sigmoidf_(gg[0]) * bflo(gt[0]), o1 = v[1] * sigmoidf_(gg[1]) * bfhi(gt[0]);
      const float o2 = v[2] * sigmoidf_(gg[2]) * bflo(gt[1]), o3 = v[3] * sigmoidf_(gg[3]) * bfhi(gt[1]);
      u32x2 o = {cvtpk(o0, o1), cvtpk(o2, o3)};
      *(u32x2*)(p.ob + (size_t)row * HW + c) = o;
      if (nt == 1) __builtin_amdgcn_sched_barrier(0);
    }
}
__device__ __forceinline__ void phase_attn_glu(const P& p, int l, char* lds) {
  const int G = ogdim(), b = obid();
#pragma unroll 1
  for (int w = b; w < 256; w += G) fa::pair_work(p, l, w, lds);
#pragma unroll 1
  for (int t = b; t < 256; t += G) glu_tile(p, l, t, lds);
}

__device__ __forceinline__ void phase_merge(const P& p, int l, char* lds) {
  const int tid = otid(), lane = tid & 63, wid = tid >> 6, wr = wid >> 2, wc = wid & 3, fr = lane & 15, fq = lane >> 4;
  for (int t = obid(); t < 32 * 16; t += ogdim()) {
    const int pm = t & 31, pn = t >> 5;
    f32x4 macc[8][2];
    zero_acc<2>(macc);
#pragma unroll 1
    for (int br = 0; br < 3; ++br) {
      const bf16_t* A = (br == 0 ? p.oa : br == 1 ? p.ob : p.oc) + (size_t)pm * 256 * HW;
      f32x4 acc[8][2];
      zero_acc<2>(acc);
      u32x2 gtv[8][2];
#pragma unroll
      for (int m = 0; m < 8; ++m)
#pragma unroll
        for (int nt = 0; nt < 2; ++nt) {
          const int row = pm * 256 + wr * 128 + m * 16 + fr, c = pn * 128 + wc * 32 + nt * 16 + 4 * fq;
          gtv[m][nt] = *(const u32x2*)(p.gates + (size_t)row * 6144 + br * DM + c);
        }
      gemm_main<2>(acc, A, HW, p.WbrT + ((size_t)(l * 3 + br) * DM + (size_t)pn * 128) * HW, HW, HW, lds);
#pragma unroll
      for (int m = 0; m < 8; ++m)
#pragma unroll
        for (int nt = 0; nt < 2; ++nt) {
          const u32x2 gt = gtv[m][nt];
          macc[m][nt][0] += bflo(gt[0]) * acc[m][nt][0]; macc[m][nt][1] += bfhi(gt[0]) * acc[m][nt][1];
          macc[m][nt][2] += bflo(gt[1]) * acc[m][nt][2]; macc[m][nt][3] += bfhi(gt[1]) * acc[m][nt][3];
        }
    }
#pragma unroll
    for (int m = 0; m < 8; ++m)
#pragma unroll
      for (int nt = 0; nt < 2; ++nt) {
        const int row = pm * 256 + wr * 128 + m * 16 + fr, c = pn * 128 + wc * 32 + nt * 16 + 4 * fq;
        u32x2 o = {cvtpk(macc[m][nt][0], macc[m][nt][1]), cvtpk(macc[m][nt][2], macc[m][nt][3])};
        *(u32x2*)(p.m + (size_t)row * DM + c) = o;
      }
  }
}

__device__ __forceinline__ void phase_wout(const P& p, int l, char* lds) {
  const int tid = otid(), lane = tid & 63, wid = tid >> 6, wr = wid >> 2, wc = wid & 3, fr = lane & 15, fq = lane >> 4;
  const float* xin = l == 0 ? p.x : p.xbuf;
  for (int t = obid(); t < 32 * 8; t += ogdim()) {
    const int pm = t & 31, pn = t >> 5;
    f32x4 acc[8][4];
    zero_acc<4>(acc);
    gemm8_main(acc, p.m + (size_t)pm * 256 * DM, p.WoutT + ((size_t)l * DM + (size_t)pn * 256) * DM, DM, lds);
#pragma unroll
    for (int m = 0; m < 8; ++m)
#pragma unroll
      for (int nt = 0; nt < 4; ++nt) {
        const int row = pm * 256 + (m >> 2) * 128 + wr * 64 + (m & 3) * 16 + fr, c = pn * 256 + wc * 32 + ncol<4>(nt) + 4 * fq;
        const f32x4 xv = *(const f32x4*)(xin + (size_t)row * DM + c);
        *(f32x4*)(p.xbuf + (size_t)row * DM + c) = xv + acc[m][nt];
        if (nt == 3) __builtin_amdgcn_sched_barrier(0);
      }
  }
}

#if SINGLE_LAUNCH
typedef const __attribute__((address_space(4))) P KP;
#if defined(__HIP_DEVICE_COMPILE__)
#define LOADP() KP* q_ = (KP*)__builtin_amdgcn_kernarg_segment_ptr(); asm volatile("" : "+s"(q_)); const P p = *(const P*)q_
#else
#define LOADP() const P p{}
#endif
constexpr int XB_ST_OFF = LDS_BYTES - 16;
__device__ __forceinline__ void gsync(char* lds) {
#if defined(__HIP_DEVICE_COMPILE__)
  KP* q_ = (KP*)__builtin_amdgcn_kernarg_segment_ptr(); asm volatile("" : "+s"(q_));
  XcdBarrier b; b.bar = ((const P*)q_)->bar; b.x = xb_xcc_id(); b.st = (volatile LAS unsigned*)(lds + XB_ST_OFF);
  xcd_barrier(b);
#endif
}
template <int L> __device__ __forceinline__ void run_layer(char* lds) {
#ifndef ONLY_S
#define PH_ON(s) 1
#else
#define PH_ON(s) ((s) == ONLY_S)
#endif
  if (L != 0) { if (PH_ON(0)) { LOADP(); phase_norm(p, L, lds); } gsync(lds); }
#if defined(DOUBLE_S) && DOUBLE_S == 0
  { LOADP(); phase_norm(p, L, lds); } gsync(lds);
#endif
  if (PH_ON(1)) { LOADP(); phase_gemm_in(p, L, lds); } gsync(lds);
#if defined(DOUBLE_S) && DOUBLE_S == 1
  { LOADP(); phase_gemm_in(p, L, lds); } gsync(lds);
#endif
  if (PH_ON(2)) { LOADP(); phase_local(p, L, lds); } gsync(lds);
#if defined(DOUBLE_S) && DOUBLE_S == 2
  { LOADP(); phase_local(p, L, lds); } gsync(lds);
#endif
  if (PH_ON(3)) { LOADP(); phase_scan(p, L); } gsync(lds);
#if defined(DOUBLE_S) && DOUBLE_S == 3
  { LOADP(); phase_scan(p, L); } gsync(lds);
#endif
  if (PH_ON(4)) { LOADP(); phase_out(p, L, lds); } gsync(lds);
#if defined(DOUBLE_S) && DOUBLE_S == 4
  { LOADP(); phase_out(p, L, lds); } gsync(lds);
#endif
  if (PH_ON(5)) { LOADP(); phase_attn_glu(p, L, lds); } gsync(lds);
#if defined(DOUBLE_S) && DOUBLE_S == 5
  { LOADP(); phase_attn_glu(p, L, lds); } gsync(lds);
#endif
  if (PH_ON(6)) { LOADP(); phase_merge(p, L, lds); } gsync(lds);
#if defined(DOUBLE_S) && DOUBLE_S == 6
  { LOADP(); phase_merge(p, L, lds); } gsync(lds);
#endif
  if (PH_ON(7)) { LOADP(); phase_wout(p, L, lds); } gsync(lds);
}

__global__ void __launch_bounds__(NTHREADS) fwd_kernel(P pdummy) {
  extern __shared__ __attribute__((aligned(16))) char lds[];
  cg::grid_group grid = cg::this_grid();
  (void)pdummy;
  if (threadIdx.x < 4) ((volatile LAS unsigned*)(lds + XB_ST_OFF))[threadIdx.x] = 0u;
  __syncthreads();
  { LOADP(); (void)xcd_barrier_post(p.bar, (volatile LAS unsigned*)(lds + XB_ST_OFF)); }
  { LOADP(); phase_prep(p, lds); if (p.out == nullptr) grid.sync(); }
  { LOADP(); phase_norm(p, 0, lds); }
  gsync(lds);
#if defined(DOUBLE_S) && DOUBLE_S == 9
  for (int i = 0; i < 16; ++i) gsync(lds);
#endif
  run_layer<0>(lds);
  run_layer<1>(lds);
  { LOADP(); phase_final_norm(p); }
}

#else
constexpr int NPHASE = 18;
#ifdef PROBE_A
__global__ void stamp_k(unsigned long long* ts, int i) { if (threadIdx.x == 0 && blockIdx.x == 0) ts[i] = wall_clock64(); }
__global__ void fill_k(float* out, const unsigned long long* ts) {
  const float c = (float)(ts[PROBE_A + 1] - ts[PROBE_A]) * 1e-4f, a = (float)(ts[PROBE_B + 1] - ts[PROBE_B]) * 1e-2f;
  for (unsigned i = blockIdx.x * blockDim.x + threadIdx.x; i < (unsigned)(S * DM); i += gridDim.x * blockDim.x) out[i] = i == 0 ? a : c;
}
#endif
template <int SS> __global__ void __launch_bounds__(NTHREADS) phase_k(P p, int l) {
  extern __shared__ __attribute__((aligned(16))) char lds[];
  if (SS == 8) phase_prep(p, lds);
  else if (SS == 9) phase_final_norm(p);
  else if (SS == 0) phase_norm(p, l, lds);
  else if (SS == 1) phase_gemm_in(p, l, lds);
  else if (SS == 2) phase_local(p, l, lds);
  else if (SS == 3) phase_scan(p, l);
  else if (SS == 4) phase_out(p, l, lds);
  else if (SS == 5) phase_attn_glu(p, l, lds);
  else if (SS == 6) phase_merge(p, l, lds);
  else phase_wout(p, l, lds);
}
#endif

extern "C" void kernel_launch(void* const* d_in, const int* in_sizes, int n_in, void* d_out, int out_size, void* d_ws, size_t ws_size,
                              hipStream_t stream) {
  (void)in_sizes; (void)n_in; (void)out_size;
  static int grid_blocks = 0;
  if (!grid_blocks) {
    int dev = 0, cus = 0;
    (void)hipGetDevice(&dev);
    (void)hipDeviceGetAttribute(&cus, hipDeviceAttributeMultiprocessorCount, dev);
    if (cus <= 0) cus = 256;
#if SINGLE_LAUNCH
    int per_cu = 0;
    hipError_t e = hipFuncSetAttribute((const void*)fwd_kernel, hipFuncAttributeMaxDynamicSharedMemorySize, LDS_BYTES);
    if (e != hipSuccess) fprintf(stderr, "hipFuncSetAttribute failed: %s\n", hipGetErrorString(e));
    (void)hipOccupancyMaxActiveBlocksPerMultiprocessor(&per_cu, fwd_kernel, NTHREADS, LDS_BYTES);
    if (per_cu < 1) fprintf(stderr, "occupancy query returned %d\n", per_cu);
#else
#define SETA(SS) (void)hipFuncSetAttribute((const void*)phase_k<SS>, hipFuncAttributeMaxDynamicSharedMemorySize, LDS_BYTES)
    SETA(0); SETA(1); SETA(2); SETA(3); SETA(4); SETA(5); SETA(6); SETA(7); SETA(8); SETA(9);
#undef SETA
#endif
    grid_blocks = cus;
  }
  P p{};
  const float* const* in = (const float* const*)d_in;
  p.x = in[0]; p.norm_g = in[1]; p.w_in = in[2]; p.b_gate = in[3]; p.fox_bf = in[4]; p.hg_lb = in[5]; p.hg_norm_g = in[6];
  p.a_re = in[7]; p.a_im = in[8]; p.log_dt = in[9]; p.b_re = in[10]; p.b_im = in[11]; p.c_re = in[12]; p.c_im = in[13];
  p.s5_d = in[14]; p.w_glu = in[15]; p.w_a = in[16]; p.w_b = in[17]; p.w_c = in[18]; p.w_out = in[19]; p.final_g = in[20];
  p.out = (float*)d_out;
  char* w = (char*)d_ws; size_t off = 0;
  auto take = [&](size_t bytes) { char* r = w + off; off += (bytes + 255) & ~(size_t)255; return r; };
  p.WinT = (bf16_t*)take((size_t)2 * NZ * DM * 2);
  p.WgluT = (bf16_t*)take((size_t)2 * 2048 * HW * 2);
  p.WbrT = (bf16_t*)take((size_t)6 * DM * HW * 2);
  p.WoutT = (bf16_t*)take((size_t)2 * DM * DM * 2);
  p.Ktab = (bf16_t*)take((size_t)2 * 64 * 32 * 256 * 2);
  p.M1 = (bf16_t*)take((size_t)2 * 64 * 128 * 512 * 2);
  p.M2 = (bf16_t*)take((size_t)2 * 64 * 512 * 128 * 2);
  p.AL = (float*)take((size_t)2 * 64 * 64 * 2 * 4);
  p.xbuf = (float*)take((size_t)S * DM * 4);
  p.h = (bf16_t*)take((size_t)S * DM * 2);
  p.lsf = (float*)take((size_t)S * 8 * 4);
  p.cc = (float*)take((size_t)S * 8 * 4);
  p.zb = (bf16_t*)take((size_t)10 * S * HW * 2);
  p.logf = (float*)take((size_t)S * HW * 4);
  p.gates = (bf16_t*)take((size_t)S * 6144 * 2);
  p.oin = (float*)take((size_t)S * HW * 4);
  p.qd = (bf16_t*)take((size_t)S * HW * 2);
  p.SlocT = (float*)take((size_t)8 * 128 * 128 * 128 * 4);
  p.elast = (float*)take((size_t)8 * 128 * 128 * 4);
  p.SprevT = (bf16_t*)take((size_t)8 * 128 * 128 * 128 * 2);
  p.Xloc = (float*)take((size_t)64 * NCH * 128 * 4);
  p.Xprev = (bf16_t*)take((size_t)64 * NCH * 128 * 2);
  p.yg = (bf16_t*)take((size_t)S * HW * 2);
  p.oa = (bf16_t*)take((size_t)S * HW * 2);
  p.ob = (bf16_t*)take((size_t)S * HW * 2);
  p.oc = (bf16_t*)take((size_t)S * HW * 2);
  p.m = (bf16_t*)take((size_t)S * DM * 2);
  p.ts = (unsigned long long*)take(4096);
  p.bar = (unsigned*)take((size_t)(XCD_BAR_WORDS + 256) * 4);
  p.opart = (float*)take((size_t)256 * 32768 * 4);
  p.mlpart = (float*)take((size_t)256 * 512 * 4);
  p.mtmp = (float*)take((size_t)256 * 65536 * 4);
  if (off > ws_size) { fprintf(stderr, "workspace too small: need %zu have %zu\n", off, ws_size); return; }
#if SINGLE_LAUNCH
  (void)hipMemsetAsync(p.bar, 0, (size_t)(XCD_BAR_WORDS + 256) * 4, stream);
  void* args[] = {&p};
  hipError_t e = hipLaunchCooperativeKernel((const void*)fwd_kernel, dim3(grid_blocks), dim3(NTHREADS), args, LDS_BYTES, stream);
  if (e != hipSuccess) fprintf(stderr, "cooperative launch failed: %s (grid %d)\n", hipGetErrorString(e), grid_blocks);
#else
#ifdef PROBE_A
  int sidx = 0;
#define LAUNCH(SS, L) do { stamp_k<<<1, 64, 0, stream>>>(p.ts, sidx++); phase_k<SS><<<dim3(grid_blocks), dim3(NTHREADS), LDS_BYTES, stream>>>(p, L); } while (0)
#else
#define LAUNCH(SS, L) phase_k<SS><<<dim3(grid_blocks), dim3(NTHREADS), LDS_BYTES, stream>>>(p, L)
#endif
  LAUNCH(8, 0);
  for (int l = 0; l < 2; ++l) { LAUNCH(0, l); LAUNCH(1, l); LAUNCH(2, l); LAUNCH(3, l); LAUNCH(4, l); LAUNCH(5, l); LAUNCH(6, l); LAUNCH(7, l); }
  LAUNCH(9, 0);
#ifdef PROBE_A
  stamp_k<<<1, 64, 0, stream>>>(p.ts, sidx++);
  fill_k<<<1024, 256, 0, stream>>>(p.out, p.ts);
#endif
#undef LAUNCH
#endif
}
```

```cpp
#include <hip/hip_runtime.h>
#include <hip/hip_cooperative_groups.h>
#include <cstdint>
#include <cstdio>
namespace cg = cooperative_groups;

typedef unsigned short bf16_t;
typedef short bf16x8 __attribute__((ext_vector_type(8)));
typedef short s16x4 __attribute__((ext_vector_type(4)));
typedef float f32x4 __attribute__((ext_vector_type(4)));
typedef float f32x2 __attribute__((ext_vector_type(2)));
typedef float f32x16 __attribute__((ext_vector_type(16)));
typedef unsigned u32x4 __attribute__((ext_vector_type(4)));
typedef unsigned u32x2 __attribute__((ext_vector_type(2)));

#ifndef SINGLE_LAUNCH
#define SINGLE_LAUNCH 1
#endif

constexpr int S = 8192, DM = 2048, INW = 16392, NZ = 16384, HW = 1024;
constexpr int NTHREADS = 512;
constexpr int LDS_BYTES = 151552;
constexpr float EPS = 1e-6f;
constexpr int SL = 32, NCH = S / SL;

struct P {
  const float *x, *norm_g, *w_in, *b_gate, *fox_bf, *hg_lb, *hg_norm_g, *a_re, *a_im, *log_dt, *b_re, *b_im, *c_re, *c_im,
      *s5_d, *w_glu, *w_a, *w_b, *w_c, *w_out, *final_g;
  float* out;
  bf16_t *WinT, *WgluT, *WbrT, *WoutT, *Ktab, *M1, *M2;
  float* AL;
  float* xbuf; bf16_t* h; float* lsf; float* cc;
  bf16_t* zb; float* logf; bf16_t* gates;
  float* oin; bf16_t* qd; float* SlocT; float* elast; bf16_t* SprevT;
  float* Xloc; bf16_t* Xprev; bf16_t* yg;
  bf16_t *oa, *ob, *oc, *m;
  unsigned long long* ts;
  unsigned* bar;
  float* opart; float* mlpart; float* mtmp;
};

typedef __bf16 bf16x2_t __attribute__((ext_vector_type(2)));
__device__ __forceinline__ unsigned cvtpk(float lo, float hi) { f32x2 v = {lo, hi}; bf16x2_t b = __builtin_convertvector(v, bf16x2_t); return *reinterpret_cast<unsigned*>(&b); }
__device__ __forceinline__ bf16_t f2bf(float v) { return (bf16_t)(cvtpk(v, 0.f) & 0xffffu); }
__device__ __forceinline__ float bf2f(bf16_t h) { return __uint_as_float(((unsigned)h) << 16); }
__device__ __forceinline__ float bflo(unsigned u) { return __uint_as_float(u << 16); }
__device__ __forceinline__ float bfhi(unsigned u) { return __uint_as_float(u & 0xffff0000u); }
__device__ __forceinline__ float sigmoidf_(float x) { return __builtin_amdgcn_rcpf(1.f + __expf(-x)); }
__device__ __forceinline__ float siluf_(float x) { return x * sigmoidf_(x); }
__device__ __forceinline__ float logsigf_(float x) { return fminf(x, 0.f) - log1pf(__expf(-fabsf(x))); }
__device__ __forceinline__ float gelu_tanh(float y) {
  const float u2 = 1.5957691216057308f * (y + 0.044715f * y * y * y); return y * __builtin_amdgcn_rcpf(1.f + __expf(-u2)); }
__device__ __forceinline__ int otid() { int t = threadIdx.x; asm volatile("" : "+v"(t)); return t; }
__device__ __forceinline__ int obid() { int b = blockIdx.x; asm volatile("" : "+s"(b)); return b; }
__device__ __forceinline__ int ogdim() { int g = gridDim.x; asm volatile("" : "+s"(g)); return g; }
__device__ __forceinline__ f32x4 mfma16(bf16x8 a, bf16x8 b, f32x4 c) { return __builtin_amdgcn_mfma_f32_16x16x32_bf16(a, b, c, 0, 0, 0); }
__device__ __forceinline__ float wave_sum(float v) {
#pragma unroll
  for (int o = 32; o >= 1; o >>= 1) v += __shfl_xor(v, o);
  return v;
}
__device__ __forceinline__ bf16x8 pack8f(const float* v) {
  u32x4 w = {cvtpk(v[0], v[1]), cvtpk(v[2], v[3]), cvtpk(v[4], v[5]), cvtpk(v[6], v[7])};
  return *reinterpret_cast<bf16x8*>(&w);
}

#define XB_TMO      128
#define XB_XCNT(j)  (256  + 64 * (j))
#define XB_XSUB(j)  (1280 + 64 * (j))
#define XB_XGEN(j)  (2304 + 64 * (j))
#define XB_TOP      3328
#define XB_TOPGEN   3392
#define XCD_BAR_WORDS 3456
#define XB_SPIN_CAP (1u << 18)
#define LAS __attribute__((address_space(3)))

__device__ __forceinline__ unsigned xb_ld(unsigned* p)              { return __hip_atomic_load(p, __ATOMIC_RELAXED, __HIP_MEMORY_SCOPE_AGENT); }
__device__ __forceinline__ unsigned xb_add(unsigned* p, unsigned v) { return __hip_atomic_fetch_add(p, v, __ATOMIC_RELAXED, __HIP_MEMORY_SCOPE_AGENT); }
__device__ __forceinline__ unsigned xb_xcc_id() { return (unsigned)__builtin_amdgcn_s_getreg((3 << 11) | 20) & 0xFu; }
#define XB_SPIN(cond, bar) do { unsigned _sp = 0; while (cond) { __builtin_amdgcn_s_sleep(1); \
    if ((++_sp & 255u) == 0u) { if (xb_ld(&(bar)[XB_TMO])) break; if (_sp > XB_SPIN_CAP) { atomicAdd(&(bar)[XB_TMO], 1u); break; } } } } while (0)

struct XcdBarrier {
    unsigned* bar; unsigned x;
    volatile LAS unsigned* st;
};

__device__ __forceinline__ XcdBarrier xcd_barrier_post(unsigned* bar, volatile LAS unsigned* st) {
    XcdBarrier b; b.bar = bar; b.x = xb_xcc_id(); b.st = st;
    if (threadIdx.x == 0) (void)xb_add(&bar[XB_XCNT(b.x)], 1u);
    return b;
}
__device__ __forceinline__ void xcd_barrier_complete(unsigned* bar, unsigned x, unsigned& nloc, unsigned& nx) {
    const unsigned G = gridDim.x * gridDim.y * gridDim.z;
    unsigned sum, cnt, mine, sp = 0u;
    for (;;) {
        sum = 0u; cnt = 0u; mine = 0u;
#pragma unroll
        for (unsigned j = 0; j < 16; ++j) { const unsigned c = xb_ld(&bar[XB_XCNT(j)]); sum += c; cnt += (c > 0u) ? 1u : 0u; mine = (j == x) ? c : mine; }
        if (sum == G) break;
        __builtin_amdgcn_s_sleep(1);
        if ((++sp & 255u) == 0u) { if (xb_ld(&bar[XB_TMO])) break; if (sp > XB_SPIN_CAP) { atomicAdd(&bar[XB_TMO], 1u); break; } }
    }
    nloc = mine > 0u ? mine : 1u; nx = cnt > 0u ? cnt : 1u;
}

__device__ __forceinline__ void xcd_barrier(const XcdBarrier& b) {
    asm volatile("s_waitcnt vmcnt(0)" ::: "memory");
    __syncthreads();
    if (threadIdx.x == 0) {
        unsigned* bar = b.bar;
        __builtin_amdgcn_s_waitcnt(0);
        unsigned nloc = b.st[0], nx = b.st[1];
        if (nloc == 0u) { xcd_barrier_complete(bar, b.x, nloc, nx); b.st[0] = nloc; b.st[1] = nx; }
        const unsigned old = xb_add(&bar[XB_XSUB(b.x)], 1u);
        const unsigned gen = old / nloc;
        if (old + 1u == (gen + 1u) * nloc) {
            __builtin_amdgcn_fence(__ATOMIC_RELEASE, "agent");
            asm volatile("s_waitcnt vmcnt(0)" ::: "memory");
            const unsigned og = xb_add(&bar[XB_TOP], 1u);
            const unsigned tg = og / nx;
            if (og + 1u == (tg + 1u) * nx) xb_add(&bar[XB_TOPGEN], 1u);
            else XB_SPIN(xb_ld(&bar[XB_TOPGEN]) == tg, bar);
            __builtin_amdgcn_fence(__ATOMIC_ACQUIRE, "agent");
            xb_add(&bar[XB_XGEN(b.x)], 1u);
            asm volatile("s_waitcnt vmcnt(0)" ::: "memory");
        } else {
            XB_SPIN(xb_ld(&bar[XB_XGEN(b.x)]) == gen, bar);
            __builtin_amdgcn_fence(__ATOMIC_ACQUIRE, "agent");
            asm volatile("s_waitcnt vmcnt(0)" ::: "memory");
        }
    }
    __syncthreads();
}


template <int NT> __device__ __forceinline__ int ncol(int nt) { return NT == 4 ? ((nt >> 1) * 128 + (nt & 1) * 16) : nt * 16; }

template <int NT>
__device__ __forceinline__ void gemm_main(f32x4 (&acc)[8][NT], const bf16_t* __restrict__ A, int lda, const bf16_t* __restrict__ Bt, int ldb, int K, char* lds) {
  constexpr int BN = NT * 64;
  constexpr int BUF = 32768 + BN * 128;
  const int tid = otid(), lane = tid & 63, wid = tid >> 6, wr = wid >> 2, wc = wid & 3, fr = lane & 15, fq = lane >> 4;
  const int lrow = tid >> 3, sch = (tid & 7) ^ (lrow & 7);
  const char* ga = (const char*)(A + (size_t)lrow * lda + sch * 8);
  const char* gb = (const char*)(Bt + (size_t)lrow * ldb + sch * 8);
#define GDMA(bufp, kt) do { _Pragma("unroll") for (int i = 0; i < 4; ++i) \
      __builtin_amdgcn_global_load_lds((const unsigned*)(ga + ((size_t)i * 64 * lda + (kt) * 64) * 2), (__attribute__((address_space(3))) unsigned*)((bufp) + i * 8192 + tid * 16), 16, 0, 0); \
    _Pragma("unroll") for (int i = 0; i < NT; ++i) \
      __builtin_amdgcn_global_load_lds((const unsigned*)(gb + ((size_t)i * 64 * ldb + (kt) * 64) * 2), (__attribute__((address_space(3))) unsigned*)((bufp) + 32768 + i * 8192 + tid * 16), 16, 0, 0); } while (0)
  const int a0 = (wr * 128 + fr) * 128 + ((fq ^ (fr & 7)) << 4);
  const int a1 = (wr * 128 + fr) * 128 + (((4 + fq) ^ (fr & 7)) << 4);
  const int b0 = 32768 + (wc * 32 + fr) * 128 + ((fq ^ (fr & 7)) << 4);
  const int b1 = 32768 + (wc * 32 + fr) * 128 + (((4 + fq) ^ (fr & 7)) << 4);
  const int nk = K >> 6;
  GDMA(lds, 0); GDMA(lds + BUF, 1);
  asm volatile("s_waitcnt vmcnt(%0)" :: "i"(4 + NT) : "memory");
  __builtin_amdgcn_s_barrier();
  int cur = 0;
#pragma unroll 1
  for (int kt = 0; kt < nk; ++kt) {
    const char* buf = lds + cur * BUF;
    const int nxt2 = cur == 0 ? 2 : cur - 1;
    if (kt + 2 < nk) GDMA(lds + nxt2 * BUF, kt + 2);
    {
      bf16x8 af[8], bfr[NT];
#pragma unroll
      for (int m = 0; m < 8; ++m) af[m] = *(const bf16x8*)(buf + a0 + m * 2048);
#pragma unroll
      for (int nt = 0; nt < NT; ++nt) bfr[nt] = *(const bf16x8*)(buf + b0 + ncol<NT>(nt) * 128);
#pragma unroll
      for (int m = 0; m < 8; ++m)
#pragma unroll
        for (int nt = 0; nt < NT; ++nt) acc[m][nt] = mfma16(bfr[nt], af[m], acc[m][nt]);
    }
    {
      bf16x8 af[8], bfr[NT];
#pragma unroll
      for (int m = 0; m < 8; ++m) af[m] = *(const bf16x8*)(buf + a1 + m * 2048);
#pragma unroll
      for (int nt = 0; nt < NT; ++nt) bfr[nt] = *(const bf16x8*)(buf + b1 + ncol<NT>(nt) * 128);
#pragma unroll
      for (int m = 0; m < 8; ++m)
#pragma unroll
        for (int nt = 0; nt < NT; ++nt) acc[m][nt] = mfma16(bfr[nt], af[m], acc[m][nt]);
    }
    if (kt + 2 < nk) asm volatile("s_waitcnt vmcnt(%0)" :: "i"(4 + NT) : "memory");
    else asm volatile("s_waitcnt vmcnt(0)" ::: "memory");
    asm volatile("s_waitcnt lgkmcnt(0)" ::: "memory");
    __builtin_amdgcn_s_barrier();
    cur = cur == 2 ? 0 : cur + 1;
  }
#undef GDMA
}

template <int NT> __device__ __forceinline__ void zero_acc(f32x4 (&acc)[8][NT]) {
#pragma unroll
  for (int m = 0; m < 8; ++m)
#pragma unroll
    for (int nt = 0; nt < NT; ++nt) acc[m][nt] = (f32x4){0.f, 0.f, 0.f, 0.f};
}

namespace g8 {
constexpr int BK = 64, HALF = 128, HT = HALF * BK;
__device__ __forceinline__ int lds_byte(int r, int c) { const int st = (r >> 4) * 2 + (c >> 5), rr = r & 15, cc = c & 31, ob = rr * 64 + cc * 2; return st * 1024 + (ob ^ (((ob >> 9) & 1) << 5)); }
__device__ __forceinline__ void stage_rc(int b, int& R, int& C) { const int st = b / 1024, sb = b % 1024, swz = sb ^ (((sb >> 9) & 1) << 5); R = (st >> 1) * 16 + swz / 64; C = (st & 1) * 32 + (swz % 64) / 2; }
}
__device__ __forceinline__ void gemm8_main(f32x4 (&acc)[8][4], const bf16_t* __restrict__ A, const bf16_t* __restrict__ Bt, int K, char* lds) {
  using namespace g8;
  bf16_t* shm = (bf16_t*)lds;
  const int tid = otid();
#define SA(b, h) (shm + ((b) * 2 + (h)) * HT)
#define SB(b, h) (shm + (4 + (b) * 2 + (h)) * HT)
#define STAGE(Pp, BASE, br, kt) do { const char* _g = (const char*)((BASE) + (long)(br) * K + (long)(kt) * BK); \
    __builtin_amdgcn_global_load_lds((const unsigned*)(_g + goff0), (__attribute__((address_space(3))) unsigned*)((char*)(Pp) + tid * 16), 16, 0, 0); \
    __builtin_amdgcn_global_load_lds((const unsigned*)(_g + goff1), (__attribute__((address_space(3))) unsigned*)((char*)(Pp) + tid * 16 + 8192), 16, 0, 0); } while (0)
#define LDA(dst, b, h) _Pragma("unroll") for (int m = 0; m < 4; ++m) _Pragma("unroll") for (int k = 0; k < 2; ++k) \
    dst[m][k] = *reinterpret_cast<const bf16x8*>(lds + ((b) * 2 + (h)) * 16384 + aoff + m * 2048 + k * 1024)
#define LDB(dst, b, h) _Pragma("unroll") for (int n = 0; n < 2; ++n) _Pragma("unroll") for (int k = 0; k < 2; ++k) \
    dst[n][k] = *reinterpret_cast<const bf16x8*>(lds + (4 + (b) * 2 + (h)) * 16384 + boff + n * 2048 + k * 1024)
#define MMA(ai, bj, At_, Bt_) do { __builtin_amdgcn_s_setprio(1); \
    _Pragma("unroll") for (int m = 0; m < 4; ++m) _Pragma("unroll") for (int n = 0; n < 2; ++n) _Pragma("unroll") for (int k = 0; k < 2; ++k) \
      acc[(ai) * 4 + m][(bj) * 2 + n] = __builtin_amdgcn_mfma_f32_16x16x32_bf16(Bt_[n][k], At_[m][k], acc[(ai) * 4 + m][(bj) * 2 + n], 0, 0, 0); \
    __builtin_amdgcn_s_setprio(0); } while (0)
#define WAIT_V(n) asm volatile("s_waitcnt vmcnt(" #n ")" ::: "memory")
#define WAIT_L(n) asm volatile("s_waitcnt lgkmcnt(" #n ")" ::: "memory")
#define BAR __builtin_amdgcn_s_barrier()
#define SCHED __builtin_amdgcn_sched_barrier(0)
  const int wid = tid >> 6, lane = tid & 63, wr = wid >> 2, wc = wid & 3, fr = lane & 15, fq = lane >> 4;
  bf16x8 At[4][2], B0[2][2], B1[2][2];
  const int nt = K / BK;
  const int swz_ = (fr * 64 + fq * 16) ^ ((((fr * 64 + fq * 16) >> 9) & 1) << 5);
  const int aoff = wr * 8192 + swz_, boff = wc * 4096 + swz_;
  unsigned goff0, goff1;
  { int r_, c_; stage_rc(tid * 16, r_, c_); goff0 = (unsigned)(r_ * K + c_) * 2u; stage_rc(tid * 16 + 8192, r_, c_); goff1 = (unsigned)(r_ * K + c_) * 2u; }
  STAGE(SB(0, 0), Bt, 0, 0); STAGE(SA(0, 0), A, 0, 0);
  STAGE(SB(0, 1), Bt, HALF, 0); STAGE(SA(0, 1), A, HALF, 0);
  if (wr == 1) BAR;
  WAIT_V(4); BAR;
  STAGE(SB(1, 0), Bt, 0, 1); STAGE(SA(1, 0), A, 0, 1); STAGE(SB(1, 1), Bt, HALF, 1);
  WAIT_V(6); BAR;
  for (int t = 0; t < nt - 2; t += 2) {
    LDB(B0, 0, 0); SCHED; LDA(At, 0, 0); STAGE(SA(1, 1), A, HALF, t + 1);
    WAIT_L(8); BAR; WAIT_L(0); MMA(0, 0, At, B0); BAR; SCHED;
    LDB(B1, 0, 1); STAGE(SB(0, 0), Bt, 0, t + 2);
    BAR; WAIT_L(0); MMA(0, 1, At, B1); BAR;
    LDA(At, 0, 1); STAGE(SA(0, 0), A, 0, t + 2);
    BAR; WAIT_L(0); MMA(1, 0, At, B0); BAR; SCHED;
    STAGE(SB(0, 1), Bt, HALF, t + 2);
    WAIT_V(6); BAR; MMA(1, 1, At, B1); BAR;
    LDB(B0, 1, 0); SCHED; LDA(At, 1, 0); STAGE(SA(0, 1), A, HALF, t + 2);
    WAIT_L(8); BAR; WAIT_L(0); MMA(0, 0, At, B0); BAR; SCHED;
    LDB(B1, 1, 1); STAGE(SB(1, 0), Bt, 0, t + 3);
    BAR; WAIT_L(0); MMA(0, 1, At, B1); BAR;
    LDA(At, 1, 1); STAGE(SA(1, 0), A, 0, t + 3);
    BAR; WAIT_L(0); MMA(1, 0, At, B0); BAR; SCHED;
    STAGE(SB(1, 1), Bt, HALF, t + 3);
    WAIT_V(6); BAR; MMA(1, 1, At, B1); BAR;
  }
  { LDB(B0, 0, 0); LDA(At, 0, 0); STAGE(SA(1, 1), A, HALF, nt - 1);
    BAR; WAIT_L(0); MMA(0, 0, At, B0); BAR;
    LDB(B1, 0, 1); BAR; WAIT_L(0); MMA(0, 1, At, B1); BAR;
    LDA(At, 0, 1); WAIT_V(4); BAR; WAIT_L(0); MMA(1, 0, At, B0); MMA(1, 1, At, B1); BAR; }
  { LDB(B0, 1, 0); LDA(At, 1, 0); WAIT_V(2); BAR; WAIT_L(0); MMA(0, 0, At, B0); BAR;
    LDB(B1, 1, 1); WAIT_V(0); BAR; WAIT_L(0); MMA(0, 1, At, B1); BAR;
    LDA(At, 1, 1); BAR; WAIT_L(0); MMA(1, 0, At, B0); MMA(1, 1, At, B1); BAR; }
  if (wr == 0) BAR;
  __syncthreads();
#undef SA
#undef SB
#undef STAGE
#undef LDA
#undef LDB
#undef MMA
#undef WAIT_V
#undef WAIT_L
#undef BAR
#undef SCHED
}

__device__ __forceinline__ void tr_tile(const float* __restrict__ src, int ld_src, int k0, int scol0, int scol1, bf16_t* __restrict__ dst, int ld_dst, int n_dst0, char* lds) {
  float* t = (float*)lds;
  const int tid = otid();
  {
    const int c4 = (tid & 63) * 4, kq = tid >> 6;
    const int sc = c4 < 128 ? scol0 + c4 : scol1 + (c4 - 128);
    f32x4 v[8];
#pragma unroll
    for (int i = 0; i < 8; ++i) v[i] = *(const f32x4*)(src + (size_t)(k0 + kq + 8 * i) * ld_src + sc);
#pragma unroll
    for (int i = 0; i < 8; ++i) { float* tp = t + (kq + 8 * i) * 257 + c4; tp[0] = v[i][0]; tp[1] = v[i][1]; tp[2] = v[i][2]; tp[3] = v[i][3]; }
  }
  __syncthreads();
  {
    const int n = tid >> 1, kh = (tid & 1) * 32;
    bf16_t* d = dst + (size_t)(n_dst0 + n) * ld_dst + k0 + kh;
#pragma unroll
    for (int q = 0; q < 4; ++q) {
      float v[8];
#pragma unroll
      for (int j = 0; j < 8; ++j) v[j] = t[(kh + q * 8 + j) * 257 + n];
      *(bf16x8*)(d + q * 8) = pack8f(v);
    }
  }
  __syncthreads();
}

__device__ __forceinline__ void s5_tables(const P& p, int unit, char* lds) {
  const int l = unit >> 6, g = unit & 63, lg = l * 64 + g, tid = threadIdx.x;
  f32x2* pw = (f32x2*)lds;
  f32x2* bb = (f32x2*)(lds + 17408);
  f32x2* cw = (f32x2*)(lds + 25600);
  const float dtf = expf(p.log_dt[lg]);
#pragma unroll 1
  for (int idx = tid; idx < 64 * 33; idx += NTHREADS) {
    const int pp = idx / 33, j = idx - pp * 33;
    const float ar = p.a_re[lg * 64 + pp], ai = p.a_im[lg * 64 + pp];
    double rev = (double)ai * (double)dtf * (double)j * 0.15915494309189535;
    rev -= rint(rev);
    const float mag = expf(ar * dtf * (float)j);
    const float rf = (float)rev;
    pw[pp * 34 + j] = (f32x2){mag * __builtin_amdgcn_cosf(rf), mag * __builtin_amdgcn_sinf(rf)};
  }
#pragma unroll 1
  for (int idx = tid; idx < 1024; idx += NTHREADS) {
    const int pp = idx >> 4, c = idx & 15;
    const float ar = p.a_re[lg * 64 + pp], ai = p.a_im[lg * 64 + pp];
    double rev = (double)ai * (double)dtf * 0.15915494309189535;
    rev -= rint(rev);
    const float mag = expf(ar * dtf), rf = (float)rev;
    const float abr = mag * __builtin_amdgcn_cosf(rf), abi = mag * __builtin_amdgcn_sinf(rf);
    const float nr = abr - 1.f, den = ar * ar + ai * ai;
    const float zr = (nr * ar + abi * ai) / den, zi = (abi * ar - nr * ai) / den;
    const float br = p.b_re[(size_t)(lg * 64 + pp) * 16 + c], bi = p.b_im[(size_t)(lg * 64 + pp) * 16 + c];
    bb[idx] = (f32x2){zr * br - zi * bi, zr * bi + zi * br};
    const int c2 = idx >> 6, p2 = idx & 63;
    cw[idx] = (f32x2){p.c_re[(size_t)(lg * 16 + c2) * 64 + p2], p.c_im[(size_t)(lg * 16 + c2) * 64 + p2]};
  }
  __syncthreads();
#pragma unroll 1
  for (int idx = tid; idx < 32 * 256; idx += NTHREADS) {
    const int d = idx >> 8, c = (idx >> 4) & 15, c1 = idx & 15;
    float sum = 0.f;
#pragma unroll 4
    for (int pp = 0; pp < 64; ++pp) {
      const f32x2 w = pw[pp * 34 + d], b = bb[pp * 16 + c1], cv = cw[c * 64 + pp];
      const float tr = w[0] * b[0] - w[1] * b[1], ti = w[0] * b[1] + w[1] * b[0];
      sum += cv[0] * tr - cv[1] * ti;
    }
    p.Ktab[(size_t)(lg * 32 + d) * 256 + c * 16 + c1] = f2bf(sum);
  }
#pragma unroll 2
  for (int idx = tid; idx < 128 * 512; idx += NTHREADS) {
    const int pr = idx >> 9, col = idx & 511, s = col >> 4, c1 = col & 15, pp = pr & 63, im = pr >> 6;
    const f32x2 w = pw[pp * 34 + (SL - 1 - s)], b = bb[pp * 16 + c1];
    const float tr = w[0] * b[0] - w[1] * b[1], ti = w[0] * b[1] + w[1] * b[0];
    p.M1[(size_t)(lg * 128 + pr) * 512 + col] = f2bf(im ? ti : tr);
  }
#pragma unroll 2
  for (int idx = tid; idx < 512 * 128; idx += NTHREADS) {
    const int row = idx >> 7, pr = idx & 127, t = row >> 4, c = row & 15, pp = pr & 63, im = pr >> 6;
    const f32x2 w = pw[pp * 34 + t + 1], cv = cw[c * 64 + pp];
    const float tr = cv[0] * w[0] - cv[1] * w[1], ti = cv[0] * w[1] + cv[1] * w[0];
    p.M2[(size_t)(lg * 512 + row) * 128 + pr] = f2bf(im ? -ti : tr);
  }
  if (tid < 64) { const f32x2 w = pw[tid * 34 + SL]; p.AL[(lg * 64 + tid) * 2] = w[0]; p.AL[(lg * 64 + tid) * 2 + 1] = w[1]; }
  __syncthreads();
}

__device__ __forceinline__ void phase_prep(const P& p, char* lds) {
  constexpr int NT_ALL = 4096 + 256 + 768 + 512;
  const int G = ogdim(), b = obid();
  const bool bal = (G == 256);
  if (bal ? (b < 128) : true) { for (int u = b; u < 128; u += (bal ? 128 : G)) s5_tables(p, u, lds); }
  const int first = bal ? (b < 128 ? b : 2176 + (b - 128)) : b, step = bal ? 128 : G, count = bal ? (b < 128 ? 17 : 27) : (NT_ALL + G - 1) / G;
#pragma unroll 1
  for (int i = 0; i < count; ++i) {
    int u = first + i * step;
    if (u >= NT_ALL) break;
    if (u < 4096) {
      const int l = u >> 11, rem = u & 2047, kt = rem >> 6, ntile = rem & 63, n0 = ntile * 256, s0 = n0 + (n0 >= 9216 ? 8 : 0);
      tr_tile(p.w_in + (size_t)l * DM * INW, INW, kt * 64, s0, s0 + 128, p.WinT + (size_t)l * NZ * DM, DM, n0, lds);
      continue;
    }
    u -= 4096;
    if (u < 256) {
      const int l = u >> 7, rem = u & 127, kt = rem >> 3, j = rem & 7;
      tr_tile(p.w_glu + (size_t)l * HW * 2048, 2048, kt * 64, j * 128, 1024 + j * 128, p.WgluT + (size_t)l * 2048 * HW, HW, j * 256, lds);
      continue;
    }
    u -= 256;
    if (u < 768) {
      const int mat = u >> 7, rem = u & 127, kt = rem >> 3, ntile = rem & 7, l = mat / 3, br = mat - l * 3;
      const float* s = (br == 0 ? p.w_a : br == 1 ? p.w_b : p.w_c) + (size_t)l * HW * DM;
      tr_tile(s, DM, kt * 64, ntile * 256, ntile * 256 + 128, p.WbrT + (size_t)mat * DM * HW, HW, ntile * 256, lds);
      continue;
    }
    u -= 768;
    {
      const int l = u >> 8, rem = u & 255, kt = rem >> 3, ntile = rem & 7;
      tr_tile(p.w_out + (size_t)l * DM * DM, DM, kt * 64, ntile * 256, ntile * 256 + 128, p.WoutT + (size_t)l * DM * DM, DM, ntile * 256, lds);
    }
  }
}

__device__ __forceinline__ void phase_norm(const P& p, int l, char* lds) {
  const float* xin = l == 0 ? p.x : p.xbuf;
  const int tid = otid(), lane = tid & 63, wid = __builtin_amdgcn_readfirstlane(tid >> 6);
  const float* wl = p.w_in + (size_t)l * DM * INW;
#pragma unroll
  for (int i = 0; i < 8; ++i) { const int idx = tid + NTHREADS * i, k = idx >> 1, hf = idx & 1; *(f32x4*)(lds + k * 32 + hf * 16 + (k >> 2) * 16) = *(const f32x4*)(wl + (size_t)k * INW + 9216 + hf * 4); }
  __syncthreads();
  const float* g = p.norm_g + l * DM;
#pragma unroll 1
  for (int row = obid() * 8 + wid; row < S; row += ogdim() * 8) {
    const float* xr = xin + (size_t)row * DM; bf16_t* hrow = p.h + (size_t)row * DM;
    f32x4 xv[8];
    float ss = 0.f;
#pragma unroll
    for (int j = 0; j < 8; ++j) { xv[j] = *(const f32x4*)(xr + (unsigned)(lane + 64 * j) * 4u); ss += xv[j][0] * xv[j][0] + xv[j][1] * xv[j][1] + xv[j][2] * xv[j][2] + xv[j][3] * xv[j][3]; }
    ss = wave_sum(ss);
    const float rstd = rsqrtf(ss * (1.f / DM) + EPS);
    float fa[8] = {0.f, 0.f, 0.f, 0.f, 0.f, 0.f, 0.f, 0.f};
#pragma unroll
    for (int j = 0; j < 8; ++j) {
      const unsigned c = (unsigned)(lane + 64 * j) * 4u;
      const f32x4 gv = *(const f32x4*)(g + c);
      float hv[4];
#pragma unroll
      for (int e = 0; e < 4; ++e) hv[e] = xv[j][e] * rstd * gv[e];
      u32x2 o = {cvtpk(hv[0], hv[1]), cvtpk(hv[2], hv[3])};
      *(u32x2*)(hrow + c) = o;
#pragma unroll
      for (int e = 0; e < 4; ++e) {
        const f32x4 w0 = *(const f32x4*)(lds + (c + e) * 32 + (c >> 2) * 16), w1 = *(const f32x4*)(lds + (c + e) * 32 + 16 + (c >> 2) * 16);
        fa[0] += hv[e] * w0[0]; fa[1] += hv[e] * w0[1]; fa[2] += hv[e] * w0[2]; fa[3] += hv[e] * w0[3];
        fa[4] += hv[e] * w1[0]; fa[5] += hv[e] * w1[1]; fa[6] += hv[e] * w1[2]; fa[7] += hv[e] * w1[3];
      }
      __builtin_amdgcn_sched_barrier(0);
    }
#pragma unroll
    for (int j = 0; j < 8; ++j) fa[j] = wave_sum(fa[j]);
    {
      float v = fa[0];
#pragma unroll
      for (int j = 1; j < 8; ++j) v = (lane == j) ? fa[j] : v;
      if (lane < 8) p.lsf[row * 8 + lane] = logsigf_(v + p.fox_bf[l * 8 + lane]);
    }
  }
  __syncthreads();
}

__device__ __forceinline__ void phase_final_norm(const P& p) {
  const int tid = otid(), lane = tid & 63, wid = __builtin_amdgcn_readfirstlane(tid >> 6);
#pragma unroll 1
  for (int row = obid() * 8 + wid; row < S; row += ogdim() * 8) {
    const float* xr = p.xbuf + (size_t)row * DM;
    f32x4 xv[8];
    float ss = 0.f;
#pragma unroll
    for (int j = 0; j < 8; ++j) { xv[j] = *(const f32x4*)(xr + (lane + 64 * j) * 4); ss += xv[j][0] * xv[j][0] + xv[j][1] * xv[j][1] + xv[j][2] * xv[j][2] + xv[j][3] * xv[j][3]; }
    ss = wave_sum(ss);
    const float rstd = rsqrtf(ss * (1.f / DM) + EPS);
#pragma unroll
    for (int j = 0; j < 8; ++j) {
      const int c = (lane + 64 * j) * 4;
      const f32x4 gv = *(const f32x4*)(p.final_g + c);
      f32x4 o;
#pragma unroll
      for (int e = 0; e < 4; ++e) o[e] = xv[j][e] * rstd * gv[e];
      *(f32x4*)(p.out + (size_t)row * DM + c) = o;
    }
  }
}

__device__ __forceinline__ void phase_gemm_in(const P& p, int l, char* lds) {
  const int tid = otid(), lane = tid & 63, wid = tid >> 6, wr = wid >> 2, wc = wid & 3, fr = lane & 15, fq = lane >> 4;
  for (int t = obid(); t < 32 * 64; t += ogdim()) {
    const int pm = t & 31, pn = t >> 5;
    f32x4 acc[8][4];
    zero_acc<4>(acc);
    gemm8_main(acc, p.h + (size_t)pm * 256 * DM, p.WinT + ((size_t)l * NZ + (size_t)pn * 256) * DM, DM, lds);
    const int region = pn >> 2;
    const int row0 = pm * 256 + wr * 64 + fr;
    const int cbase = (pn & 3) * 256 + wc * 32 + 4 * fq;
    if (region == 1) {
#pragma unroll
      for (int nt = 0; nt < 4; ++nt) {
        const int c = cbase + ncol<4>(nt);
        float lb[4], la[4], l1m[4];
#pragma unroll
        for (int e = 0; e < 4; ++e) {
          lb[e] = l == 0 ? 0.f : sigmoidf_(p.hg_lb[HW + c + e] - p.hg_lb[c + e]);
          la[e] = l == 0 ? -1e30f : __logf(lb[e]);
          l1m[e] = l == 0 ? 0.f : __logf(1.f - lb[e]);
        }
#pragma unroll
        for (int m = 0; m < 8; ++m) {
          const int row = row0 + (m >> 2) * 128 + (m & 3) * 16;
          f32x4 lf; float kk[4];
#pragma unroll
          for (int e = 0; e < 4; ++e) {
            const float z = acc[m][nt][e];
            const float ez = __expf(-fabsf(z));
            const float ls = fminf(z, 0.f) - __logf(1.f + ez);
            const float b = l1m[e] + ls, a = la[e], mx = fmaxf(a, b);
            lf[e] = mx + __logf(1.f + __expf(-fabsf(a - b)));
            const float sneg = (z >= 0.f ? ez : 1.f) * __builtin_amdgcn_rcpf(1.f + ez);
            kk[e] = (1.f - lb[e]) * sneg;
          }
          *(f32x4*)(p.logf + (size_t)row * HW + c) = lf;
          u32x2 o = {cvtpk(kk[0], kk[1]), cvtpk(kk[2], kk[3])};
          *(u32x2*)(p.zb + (size_t)1 * S * HW + (size_t)row * HW + c) = o;
          __builtin_amdgcn_sched_barrier(0);
        }
      }
    } else if (region < 10) {
      const bool act = (region == 3 || region == 5 || region == 9), hm = (region >= 6 && region <= 8);
      bf16_t* dst = p.zb + (size_t)region * S * HW;
#pragma unroll
      for (int m = 0; m < 8; ++m)
#pragma unroll
        for (int nt = 0; nt < 4; ++nt) {
          const int row = row0 + (m >> 2) * 128 + (m & 3) * 16, c = cbase + ncol<4>(nt);
          f32x4 v = acc[m][nt];
          if (act) {
#pragma unroll
            for (int e = 0; e < 4; ++e) v[e] = siluf_(v[e]);
          }
          u32x2 o = {cvtpk(v[0], v[1]), cvtpk(v[2], v[3])};
          if (hm) *(u32x2*)(dst + ((size_t)(c >> 7) * S + row) * 128 + (c & 127)) = o;
          else *(u32x2*)(dst + (size_t)row * HW + c) = o;
          if (nt == 3) __builtin_amdgcn_sched_barrier(0);
        }
    } else {
      const int gc0 = (pn - 40) * 256 + wc * 32 + 4 * fq;
#pragma unroll
      for (int nt = 0; nt < 4; ++nt) {
        const int c = gc0 + ncol<4>(nt);
        const f32x4 bg = *(const f32x4*)(p.b_gate + (size_t)l * 6144 + c);
#pragma unroll
        for (int m = 0; m < 8; ++m) {
          const int row = row0 + (m >> 2) * 128 + (m & 3) * 16;
          f32x4 v = acc[m][nt];
#pragma unroll
          for (int e = 0; e < 4; ++e) v[e] = sigmoidf_(v[e] + bg[e]);
          u32x2 o = {cvtpk(v[0], v[1]), cvtpk(v[2], v[3])};
          *(u32x2*)(p.gates + (size_t)row * 6144 + c) = o;
          if ((m & 3) == 3) __builtin_amdgcn_sched_barrier(0);
        }
      }
    }
  }
}

__device__ __forceinline__ int swz128(int row, int col_elem) {
  return row * 128 + ((((col_elem >> 3) ^ (row & 7))) << 4) + (col_elem & 7) * 2;
}
__device__ __forceinline__ int swz256(int row, int col_elem) {
  return row * 256 + ((((col_elem >> 3) ^ (row & 7))) << 4) + (col_elem & 7) * 2;
}

__device__ __forceinline__ void hg_local(const P& p, int unit, char* lds) {
  const int hh = unit >> 7, n = unit & 127, tok0 = n * 64, colh = hh * 128;
  const int tid = otid(), lane = tid & 63, wid = tid >> 6, fr = lane & 15, fq = lane >> 4;
  float* cum = (float*)lds;
  char* qe = lds + 32768; char* ke = lds + 49152; char* kdT = lds + 65536; char* iT = lds + 81920; char* sc = lds + 98304;
  const bf16_t* hq = p.zb; const bf16_t* hk = p.zb + (size_t)1 * S * HW; const bf16_t* hi = p.zb + (size_t)2 * S * HW;
#pragma unroll
  for (int i = 0; i < 4; ++i) { const int id = tid + NTHREADS * i, t = id >> 5, c4 = (id & 31) * 4;
    *(f32x4*)(cum + t * 128 + c4) = *(const f32x4*)(p.logf + (size_t)(tok0 + t) * HW + colh + c4); }
  u32x4 q8a[2], k8a[2], i8a[2];
#pragma unroll
  for (int i = 0; i < 2; ++i) {
    const int id = tid + NTHREADS * i, t = id >> 4, k0 = (id & 15) * 8;
    const size_t gofs = (size_t)(tok0 + t) * HW + colh + k0;
    q8a[i] = *(const u32x4*)(hq + gofs); k8a[i] = *(const u32x4*)(hk + gofs); i8a[i] = *(const u32x4*)(hi + gofs);
  }
  __syncthreads();
  {
    const int k = tid & 127, part = tid >> 7;
    float run = 0.f;
    for (int t = 16 * part; t < 16 * part + 16; ++t) { run += cum[t * 128 + k]; cum[t * 128 + k] = run; }
    __syncthreads();
    float off = 0.f;
    for (int pp = 0; pp < part; ++pp) off += cum[(16 * pp + 15) * 128 + k];
    __syncthreads();
    if (part) for (int t = 16 * part; t < 16 * part + 16; ++t) cum[t * 128 + k] += off;
  }
  __syncthreads();
#pragma unroll
  for (int i = 0; i < 2; ++i) {
    const int id = tid + NTHREADS * i, t = id >> 4, k0 = (id & 15) * 8;
    const size_t gofs = (size_t)(tok0 + t) * HW + colh + k0;
    const u32x4 q8 = q8a[i], k8 = k8a[i], i8 = i8a[i];
    float qv[8], kv[8], iv[8], c8[8], r8[8], l8[8];
#pragma unroll
    for (int j = 0; j < 4; ++j) { qv[2 * j] = bflo(q8[j]); qv[2 * j + 1] = bfhi(q8[j]); kv[2 * j] = bflo(k8[j]); kv[2 * j + 1] = bfhi(k8[j]); iv[2 * j] = bflo(i8[j]); iv[2 * j + 1] = bfhi(i8[j]); }
#pragma unroll
    for (int j = 0; j < 8; ++j) { c8[j] = cum[t * 128 + k0 + j]; r8[j] = cum[31 * 128 + k0 + j]; l8[j] = cum[63 * 128 + k0 + j]; }
    float qe8[8], ke8[8], qd8[8];
#pragma unroll
    for (int j = 0; j < 8; ++j) {
      qe8[j] = qv[j] * __expf(c8[j] - r8[j]);
      ke8[j] = kv[j] * __expf(r8[j] - c8[j]);
      qd8[j] = qv[j] * __expf(c8[j]);
      const float kd = kv[j] * __expf(l8[j] - c8[j]);
      *(bf16_t*)(kdT + swz128(k0 + j, t)) = f2bf(kd);
      *(bf16_t*)(iT + swz128(k0 + j, t)) = (bf16_t)((j & 1) ? (i8[j >> 1] >> 16) : (i8[j >> 1] & 0xffffu));
    }
    *(bf16x8*)(qe + swz256(t, k0)) = pack8f(qe8);
    *(bf16x8*)(ke + swz256(t, k0)) = pack8f(ke8);
    *(bf16x8*)(p.qd + gofs) = pack8f(qd8);
  }
  if (tid < 128) p.elast[(size_t)(hh * 128 + n) * 128 + tid] = __expf(cum[63 * 128 + tid]);
  __syncthreads();
  {
    const int tt = wid >> 1;
#pragma unroll
    for (int e = 0; e < 2; ++e) {
      const int st = (wid & 1) * 2 + e;
      f32x4 a = {0.f, 0.f, 0.f, 0.f};
      if (st <= tt) {
#pragma unroll
        for (int kk = 0; kk < 4; ++kk) {
          const bf16x8 X = *(const bf16x8*)(ke + swz256(st * 16 + fr, kk * 32 + fq * 8));
          const bf16x8 Y = *(const bf16x8*)(qe + swz256(tt * 16 + fr, kk * 32 + fq * 8));
          a = mfma16(X, Y, a);
        }
      }
      const int t = tt * 16 + fr, s0 = st * 16 + 4 * fq;
#pragma unroll
      for (int r = 0; r < 4; ++r) if (s0 + r > t) a[r] = 0.f;
      u32x2 o = {cvtpk(a[0], a[1]), cvtpk(a[2], a[3])};
      *(u32x2*)(sc + swz128(t, s0)) = o;
    }
  }
  __syncthreads();
  {
    const int tt = wid & 3;
#pragma unroll
    for (int e = 0; e < 4; ++e) {
      const int vt = (wid >> 2) * 4 + e;
      f32x4 a = {0.f, 0.f, 0.f, 0.f};
#pragma unroll
      for (int kk = 0; kk < 2; ++kk) {
        const bf16x8 X = *(const bf16x8*)(iT + swz128(vt * 16 + fr, kk * 32 + fq * 8));
        const bf16x8 Y = *(const bf16x8*)(sc + swz128(tt * 16 + fr, kk * 32 + fq * 8));
        a = mfma16(X, Y, a);
      }
      *(f32x4*)(p.oin + (size_t)(tok0 + tt * 16 + fr) * HW + colh + vt * 16 + 4 * fq) = a;
    }
  }
  {
    const int vt = wid;
#pragma unroll
    for (int kt = 0; kt < 8; ++kt) {
      f32x4 a = {0.f, 0.f, 0.f, 0.f};
#pragma unroll
      for (int kk = 0; kk < 2; ++kk) {
        const bf16x8 X = *(const bf16x8*)(kdT + swz128(kt * 16 + fr, kk * 32 + fq * 8));
        const bf16x8 Y = *(const bf16x8*)(iT + swz128(vt * 16 + fr, kk * 32 + fq * 8));
        a = mfma16(X, Y, a);
      }
      { u32x2 o = {cvtpk(a[0], a[1]), cvtpk(a[2], a[3])}; *(u32x2*)((bf16_t*)p.SlocT + ((size_t)(hh * 128 + n) * 128 + vt * 16 + fr) * 128 + kt * 16 + 4 * fq) = o; }
    }
  }
  __syncthreads();
}

__device__ __forceinline__ void s5_local(const P& p, int l, int unit, char* lds) {
  const int g = unit >> 1, half = unit & 1;
  const int tid = otid(), lane = tid & 63, wid = tid >> 6, fr = lane & 15, fq = lane >> 4;
  const int cb = half * 8 + wid, n = 16 * cb + fr;
  const bf16_t* su = p.zb + (size_t)4 * S * HW;
  const bf16_t* M1 = p.M1 + (size_t)(l * 64 + g) * 128 * 512;
#pragma unroll 4
  for (int i = 0; i < 16; ++i) {
    const int idx = tid + NTHREADS * i, row = idx >> 6, ch = idx & 63;
    *(u32x4*)(lds + row * 1024 + ((ch ^ (row & 15)) << 4)) = *(const u32x4*)(M1 + row * 512 + ch * 8);
  }
  bf16x8 Y[16];
#pragma unroll
  for (int kk = 0; kk < 16; ++kk) Y[kk] = *(const bf16x8*)(su + (size_t)(n * SL + 2 * kk + (fq >> 1)) * HW + g * 16 + (fq & 1) * 8);
  __syncthreads();
  f32x4 acc[8];
#pragma unroll
  for (int i = 0; i < 8; ++i) acc[i] = (f32x4){0.f, 0.f, 0.f, 0.f};
#pragma unroll
  for (int kk = 0; kk < 16; ++kk) {
#pragma unroll
    for (int pt = 0; pt < 8; ++pt) {
      const bf16x8 X = *(const bf16x8*)(lds + (pt * 16 + fr) * 1024 + (((kk * 4 + fq) ^ fr) << 4));
      acc[pt] = mfma16(X, Y[kk], acc[pt]);
    }
    if ((kk & 1) == 1) __builtin_amdgcn_sched_barrier(0);
  }
#pragma unroll
  for (int pt = 0; pt < 8; ++pt) *(f32x4*)(p.Xloc + ((size_t)g * NCH + n) * 128 + pt * 16 + 4 * fq) = acc[pt];
  __syncthreads();
}

__device__ __forceinline__ void fox_cumsum(const P& p, int hh, char* lds) {
  float* wt = (float*)lds;
  const int tid = otid(), lane = tid & 63, wid = tid >> 6;
  float v[16];
  float run = 0.f;
#pragma unroll
  for (int j = 0; j < 16; ++j) { run += p.lsf[(tid * 16 + j) * 8 + hh]; v[j] = run; }
  float inc = run;
#pragma unroll
  for (int o = 1; o < 64; o <<= 1) { const float t = __shfl_up(inc, o); if (lane >= o) inc += t; }
  if (lane == 63) wt[wid] = inc;
  __syncthreads();
  float base = inc - run;
  for (int w = 0; w < wid; ++w) base += wt[w];
#pragma unroll
  for (int j = 0; j < 16; ++j) p.cc[hh * S + tid * 16 + j] = base + v[j];
  __syncthreads();
}

__device__ __forceinline__ void phase_local(const P& p, int l, char* lds) {
  constexpr int NU = 1024 + 128 + 8;
  for (int u = obid(); u < NU; u += ogdim()) {
    if (u < 1024) hg_local(p, u, lds);
    else if (u < 1152) { const int j = u - 1024; s5_local(p, l, ((j & 7) << 4) | (j >> 3), lds); }
    else fox_cumsum(p, u - 1152, lds);
  }
}

__device__ __forceinline__ void phase_scan(const P& p, int l) {
  constexpr int NU = 128 + 8;
  const int tid = otid();
  for (int u = obid(); u < NU; u += ogdim()) {
    if (u < 128) {
      const int e2 = u * NTHREADS + tid, hh = e2 >> 13, rem = e2 & 8191, v = rem >> 6, k = (rem & 63) * 2;
      float s0 = 0.f, s1 = 0.f;
#pragma unroll 16
      for (int n = 0; n < 128; ++n) {
        const size_t idx = ((size_t)(hh * 128 + n) * 128 + v) * 128 + k;
        const unsigned lu = *(const unsigned*)((const bf16_t*)p.SlocT + idx); const f32x2 loc = {bflo(lu), bfhi(lu)};
        const f32x2 el = *(const f32x2*)(p.elast + (size_t)(hh * 128 + n) * 128 + k);
        *(unsigned*)(p.SprevT + idx) = cvtpk(s0, s1);
        s0 = el[0] * s0 + loc[0]; s1 = el[1] * s1 + loc[1];
      }
    } else {
      const int gid = (u - 128) * NTHREADS + tid, g = gid >> 6, pp = gid & 63;
      const float ar = p.AL[((l * 64 + g) * 64 + pp) * 2], ai = p.AL[((l * 64 + g) * 64 + pp) * 2 + 1];
      float sr = 0.f, si = 0.f;
#pragma unroll 16
      for (int n = 0; n < NCH; ++n) {
        const size_t idx = ((size_t)g * NCH + n) * 128 + pp;
        const float xr = p.Xloc[idx], xi = p.Xloc[idx + 64];
        p.Xprev[idx] = f2bf(sr); p.Xprev[idx + 64] = f2bf(si);
        const float nr = ar * sr - ai * si + xr, ni = ar * si + ai * sr + xi;
        sr = nr; si = ni;
      }
    }
  }
}

__device__ __forceinline__ void hg_out(const P& p, int l, int bu) {
  const int hh = bu >> 6, np = bu & 63;
  const int tid = otid(), lane = tid & 63, wid = tid >> 6, fr = lane & 15, fq = lane >> 4;
  const int n = np * 2 + (wid >> 2), tt = wid & 3, colh = hh * 128;
  const int token = n * 64 + tt * 16 + fr;
  const bf16_t* sp = p.SprevT + (size_t)(hh * 128 + n) * 128 * 128;
  f32x4 acc[8];
  u32x2 gtv[8];
  const bf16_t* sg = p.zb + (size_t)3 * S * HW;
#pragma unroll
  for (int i = 0; i < 8; ++i) {
    acc[i] = *(const f32x4*)(p.oin + (size_t)token * HW + colh + i * 16 + 4 * fq);
    gtv[i] = *(const u32x2*)(sg + (size_t)token * HW + colh + i * 16 + 4 * fq);
  }
#pragma unroll
  for (int kk = 0; kk < 4; ++kk) {
    const bf16x8 Y = *(const bf16x8*)(p.qd + (size_t)token * HW + colh + kk * 32 + fq * 8);
#pragma unroll
    for (int vt = 0; vt < 8; ++vt) {
      const bf16x8 X = *(const bf16x8*)(sp + (size_t)(vt * 16 + fr) * 128 + kk * 32 + fq * 8);
      acc[vt] = mfma16(X, Y, acc[vt]);
    }
  }
  float ss = 0.f;
#pragma unroll
  for (int vt = 0; vt < 8; ++vt) {
    ss += acc[vt][0] * acc[vt][0] + acc[vt][1] * acc[vt][1] + acc[vt][2] * acc[vt][2] + acc[vt][3] * acc[vt][3];
  }
  ss += __shfl_xor(ss, 16);
  ss += __shfl_xor(ss, 32);
  const float rstd = rsqrtf(ss * (1.f / 128.f) + EPS);
#pragma unroll
  for (int vt = 0; vt < 8; ++vt) {
    const int c = colh + vt * 16 + 4 * fq;
    const f32x4 gn = *(const f32x4*)(p.hg_norm_g + l * HW + c);
    const u32x2 gt = gtv[vt];
    const float o0 = acc[vt][0] * rstd * gn[0] * bflo(gt[0]), o1 = acc[vt][1] * rstd * gn[1] * bfhi(gt[0]);
    const float o2 = acc[vt][2] * rstd * gn[2] * bflo(gt[1]), o3 = acc[vt][3] * rstd * gn[3] * bfhi(gt[1]);
    u32x2 o = {cvtpk(o0, o1), cvtpk(o2, o3)};
    *(u32x2*)(p.oa + (size_t)token * HW + c) = o;
  }
}

__device__ __forceinline__ void s5_out(const P& p, int l, int unit, char* lds) {
  const int g = unit >> 1, half = unit & 1;
  const int tid = otid(), lane = tid & 63, wid = tid >> 6, fr = lane & 15, fq = lane >> 4;
  const int cb = half * 8 + wid, n = 16 * cb + fr;
  const bf16_t* su = p.zb + (size_t)4 * S * HW;
  const bf16_t* M2 = p.M2 + (size_t)(l * 64 + g) * 512 * 128;
  {
    const u32x4* src = (const u32x4*)(p.Ktab + (size_t)(l * 64 + g) * 32 * 256);
    u32x4* dst = (u32x4*)(lds + 512);
    dst[tid] = src[tid]; dst[tid + 512] = src[tid + 512];
    if (tid < 32) { unsigned z = 0u; asm volatile("" : "+v"(z)); ((u32x4*)lds)[tid] = (u32x4){z, z, z, z}; }
#pragma unroll 4
    for (int i = 0; i < 16; ++i) {
      const int idx = tid + NTHREADS * i, row = idx >> 4, ch = idx & 15;
      *(u32x4*)(lds + 17408 + row * 256 + ((ch ^ (row & 15)) << 4)) = *(const u32x4*)(M2 + row * 128 + ch * 8);
    }
  }
  __syncthreads();
  const char* tb = lds + ((1 - (fq >> 1)) * 256 + fr * 16 + (fq & 1) * 8) * 2;
  bf16x8 U[16], Xp[4];
#pragma unroll
  for (int kk = 0; kk < 16; ++kk) U[kk] = *(const bf16x8*)(su + (n * SL + 2 * kk + (fq >> 1)) * HW + g * 16 + (fq & 1) * 8);
#pragma unroll
  for (int kk = 0; kk < 4; ++kk) Xp[kk] = *(const bf16x8*)(p.Xprev + (g * NCH + n) * 128 + kk * 32 + fq * 8);
  const f32x4 dsk = *(const f32x4*)(p.s5_d + l * HW + g * 16 + 4 * fq);
#pragma unroll
  for (int th = 0; th < 2; ++th) {
    f32x4 acc[16];
#pragma unroll
    for (int ti = 0; ti < 16; ++ti) acc[ti] = (f32x4){0.f, 0.f, 0.f, 0.f};
#pragma unroll
    for (int kk = 0; kk < 4; ++kk) {
#pragma unroll
      for (int ti = 0; ti < 16; ++ti) {
        const int t = 16 * th + ti;
        const bf16x8 X = *(const bf16x8*)(lds + 17408 + (t * 16 + fr) * 256 + (((kk * 4 + fq) ^ fr) << 4));
        acc[ti] = mfma16(X, Xp[kk], acc[ti]);
        if ((ti & 7) == 7) __builtin_amdgcn_sched_barrier(0);
      }
    }
#pragma unroll
    for (int kk = 0; kk < 8 * th + 8; ++kk) {
#pragma unroll
      for (int ti = 0; ti < 16; ++ti) {
        const int t = 16 * th + ti;
        if (t >= 2 * kk) {
          const bf16x8 X = *(const bf16x8*)(tb + (t - 2 * kk) * 512);
          acc[ti] = mfma16(X, U[kk], acc[ti]);
        }
        if ((ti & 7) == 7) __builtin_amdgcn_sched_barrier(0);
      }
    }
#pragma unroll
    for (int ti = 0; ti < 16; ++ti) {
      const int t = 16 * th + ti;
      const int o = (n * SL + t) * HW + g * 16 + 4 * fq;
      const u32x2 uu = *(const u32x2*)(su + o);
      const float y0 = gelu_tanh(acc[ti][0] + dsk[0] * bflo(uu[0])), y1 = gelu_tanh(acc[ti][1] + dsk[1] * bfhi(uu[0]));
      const float y2 = gelu_tanh(acc[ti][2] + dsk[2] * bflo(uu[1])), y3 = gelu_tanh(acc[ti][3] + dsk[3] * bfhi(uu[1]));
      u32x2 ov = {cvtpk(y0, y1), cvtpk(y2, y3)};
      *(u32x2*)(p.yg + o) = ov;
      if ((ti & 3) == 3) __builtin_amdgcn_sched_barrier(0);
    }
  }
  __syncthreads();
}

__device__ __forceinline__ void phase_out(const P& p, int l, char* lds) {
  const int G = ogdim(), b = obid();
  if (G == 256) {
    if (b < 128) s5_out(p, l, ((b & 7) << 4) | (b >> 3), lds);
    const int u0 = b < 128 ? 384 + b : (b - 128) * 3, n = b < 128 ? 1 : 3;
#pragma unroll 1
    for (int i = 0; i < n; ++i) hg_out(p, l, u0 + i);
  } else {
#pragma unroll 1
    for (int u = b; u < 512; u += G) hg_out(p, l, u);
#pragma unroll 1
    for (int u = b; u < 128; u += G) s5_out(p, l, u, lds);
  }
}

namespace fa {
constexpr int D = 128, QBLK = 32, KVBLK = 64, QB = 256, LD = 1024, LDQ = 128;
constexpr int SHM_V = 16384, SHM_K = 16384;
constexpr int OFF_WS = 2 * SHM_V + 2 * SHM_K, OFF_BIAS = 69632;
constexpr float SCALE = 0.08838834764831845f, SQRTD = 11.313708498984761f, THR = 8.f;
constexpr unsigned WBIG = 0x40000000u;
#define KSWZ(row, colB) ((row) * 256 + ((colB) ^ (((row) & 7) << 4)))
#define SBAR() __builtin_amdgcn_sched_barrier(0)
__device__ __forceinline__ int v_st(int k, int c) { const int kk = (k & ~0xC) | ((k & 4) << 1) | ((k & 8) >> 1); return ((kk >> 3) * 4 + (c >> 5)) * 512 + ((kk & 7) * 32 + (c & 31)) * 2; }
__device__ __forceinline__ int v_rd_base(int lane) { return ((lane & 3) << 3) | (((lane >> 2) & 3) << 6) | (((lane >> 4) & 1) << 5) | (((lane >> 5) & 1) << 8); }
constexpr int v_rd_off(int d0, int ks, int half) { return d0 * 512 + ks * 4096 + half * 2048; }
__device__ __forceinline__ int crow(int r, int hi) { return (r & 3) + 8 * (r >> 2) + 4 * hi; }
__device__ __forceinline__ unsigned cvtpkv(float lo, float hi) { unsigned r; asm volatile("v_cvt_pk_bf16_f32 %0, %1, %2" : "=v"(r) : "v"(lo), "v"(hi)); return r; }

__device__ __forceinline__ void mask_tile(f32x16& p0, f32x16& p1, int dq, unsigned W) {
  const float NEG = -__builtin_inff();
#pragma unroll
  for (int r = 0; r < 16; ++r) {
    const int c = (r & 3) + 8 * (r >> 2);
    if ((unsigned)(dq - c) >= W) p0[r] = NEG;
    if ((unsigned)(dq - c - 32) >= W) p1[r] = NEG;
  }
}
__device__ __forceinline__ void partialSM(f32x16& p0, f32x16& p1, float& m_reg, float& mn, float& alpha) {
  float pmax = p0[0];
#pragma unroll
  for (int r = 1; r < 16; ++r) pmax = fmaxf(pmax, p0[r]);
#pragma unroll
  for (int r = 0; r < 16; ++r) pmax = fmaxf(pmax, p1[r]);
  { auto rr = __builtin_amdgcn_permlane32_swap(__float_as_uint(pmax), __float_as_uint(pmax), false, false);
    pmax = fmaxf(__uint_as_float(rr[0]), __uint_as_float(rr[1])); }
  constexpr float C2 = 1.4426950408889634f * SCALE;
  if (__builtin_expect(__all((pmax - m_reg) * SCALE <= THR), 1)) { mn = m_reg; alpha = 1.f; }
  else { mn = fmaxf(m_reg, pmax); alpha = __builtin_amdgcn_exp2f((m_reg - mn) * C2); m_reg = mn; }
  const float mnL = -mn * C2;
#pragma unroll
  for (int r = 0; r < 16; ++r) p0[r] = fmaf(p0[r], C2, mnL);
#pragma unroll
  for (int r = 0; r < 16; ++r) p1[r] = fmaf(p1[r], C2, mnL);
#pragma unroll
  for (int r = 0; r < 16; ++r) p0[r] = __builtin_amdgcn_exp2f(p0[r]);
}
__device__ __forceinline__ void finishSM(f32x16& p0, f32x16& p1, float alpha, float& l_reg, bf16x8& pa0, bf16x8& pa1, bf16x8& pa2, bf16x8& pa3) {
#pragma unroll
  for (int r = 0; r < 16; ++r) p1[r] = __builtin_amdgcn_exp2f(p1[r]);
  float ps = 0;
#pragma unroll
  for (int r = 0; r < 16; ++r) ps += p0[r];
#pragma unroll
  for (int r = 0; r < 16; ++r) ps += p1[r];
  { auto rr = __builtin_amdgcn_permlane32_swap(__float_as_uint(ps), __float_as_uint(ps), false, false);
    ps = __uint_as_float(rr[0]) + __uint_as_float(rr[1]); }
  l_reg = l_reg * alpha + ps;
#define PK4(Pv, B_, OUT) do { unsigned a0 = cvtpkv(Pv[B_+0], Pv[B_+1]), a1 = cvtpkv(Pv[B_+2], Pv[B_+3]); \
    unsigned b0 = cvtpkv(Pv[B_+4], Pv[B_+5]), b1 = cvtpkv(Pv[B_+6], Pv[B_+7]); \
    auto r0 = __builtin_amdgcn_permlane32_swap(a0, b0, false, false); auto r1 = __builtin_amdgcn_permlane32_swap(a1, b1, false, false); \
    u32x4 w = {r0[0], r1[0], r0[1], r1[1]}; OUT = *reinterpret_cast<bf16x8*>(&w); } while (0)
  PK4(p0, 0, pa0); PK4(p0, 8, pa1); PK4(p1, 0, pa2); PK4(p1, 8, pa3);
#undef PK4
}
template <int KB>
__device__ __forceinline__ void qkt(f32x16& p0, f32x16& p1, const char* lds, int r32, int hi, const bf16x8* qr) {
  const char* K_lds = lds + 2 * SHM_V;
  p0 = f32x16{}; p1 = f32x16{};
  const char* kb[4];
#pragma unroll
  for (int dd = 0; dd < 4; ++dd) kb[dd] = K_lds + KB * SHM_K + KSWZ(r32, (dd * 16 + hi * 8) * 2);
#pragma unroll
  for (int d0 = 0; d0 < 8; ++d0) { const char* a = kb[d0 & 3] + (d0 >> 2) * 128;
    bf16x8 b0 = *reinterpret_cast<const bf16x8*>(a);
    bf16x8 b1 = *reinterpret_cast<const bf16x8*>(a + 32 * 256);
    p0 = __builtin_amdgcn_mfma_f32_32x32x16_bf16(b0, qr[d0], p0, 0, 0, 0);
    p1 = __builtin_amdgcn_mfma_f32_32x32x16_bf16(b1, qr[d0], p1, 0, 0, 0); }
}
__device__ __forceinline__ void add_bias(f32x16& p0, f32x16& p1, const char* lds, int hi, int kbase) {
  const float* bb = (const float*)(lds + OFF_BIAS) + kbase + 4 * hi;
#pragma unroll
  for (int j = 0; j < 4; ++j) {
    const f32x4 t0 = *(const f32x4*)(bb + 8 * j), t1 = *(const f32x4*)(bb + 32 + 8 * j);
    p0[4 * j] += t0[0]; p0[4 * j + 1] += t0[1]; p0[4 * j + 2] += t0[2]; p0[4 * j + 3] += t0[3];
    p1[4 * j] += t1[0]; p1[4 * j + 1] += t1[1]; p1[4 * j + 2] += t1[2]; p1[4 * j + 3] += t1[3];
  }
}
template <int VB>
__device__ __forceinline__ void pv_tile(f32x16* o, int vb0, bf16x8 pa0, bf16x8 pa1, bf16x8 pa2, bf16x8 pa3) {
#define TRRD(dst, off) asm volatile("ds_read_b64_tr_b16 %0, %1 offset:%2" : "=&v"(dst) : "v"(vb0), "i"(off) : "memory")
#define PV_D0(d0) do { s16x4 l0, l1, l2, l3, h0, h1, h2, h3; constexpr int b_ = VB * SHM_V + v_rd_off(d0, 0, 0); \
    TRRD(l0, b_); TRRD(h0, b_ + 2048); TRRD(l1, b_ + 4096); TRRD(h1, b_ + 6144); TRRD(l2, b_ + 8192); TRRD(h2, b_ + 10240); TRRD(l3, b_ + 12288); TRRD(h3, b_ + 14336); \
    asm volatile("s_waitcnt lgkmcnt(0)" ::: "memory"); SBAR(); \
    o[d0] = __builtin_amdgcn_mfma_f32_32x32x16_bf16(pa0, (bf16x8){l0[0], l0[1], l0[2], l0[3], h0[0], h0[1], h0[2], h0[3]}, o[d0], 0, 0, 0); \
    o[d0] = __builtin_amdgcn_mfma_f32_32x32x16_bf16(pa1, (bf16x8){l1[0], l1[1], l1[2], l1[3], h1[0], h1[1], h1[2], h1[3]}, o[d0], 0, 0, 0); \
    o[d0] = __builtin_amdgcn_mfma_f32_32x32x16_bf16(pa2, (bf16x8){l2[0], l2[1], l2[2], l2[3], h2[0], h2[1], h2[2], h2[3]}, o[d0], 0, 0, 0); \
    o[d0] = __builtin_amdgcn_mfma_f32_32x32x16_bf16(pa3, (bf16x8){l3[0], l3[1], l3[2], l3[3], h3[0], h3[1], h3[2], h3[3]}, o[d0], 0, 0, 0); } while (0)
  PV_D0(0); PV_D0(1); PV_D0(2); PV_D0(3);
#undef PV_D0
#undef TRRD
}

struct BlockRef { const bf16_t* Q; const bf16_t* K; const bf16_t* V; const bf16_t* G; bf16_t* O; const float* C; int P0; };
struct Seam { bf16x8 qr[8]; bf16x8 st_v0, st_v1, st_k0, st_k1; };

#define ROWP(pp, k0, rr) ((pp) + (size_t)((k0) + (rr)) * LDQ + sc)
#define VMW() asm volatile("s_waitcnt vmcnt(0)" ::: "memory")
#define VMWN(n) asm volatile("s_waitcnt vmcnt(%0)" :: "i"(n) : "memory")
#define LD8(ptr) (*reinterpret_cast<const bf16x8*>(ptr))
#define SLOAD_H(ref, k0) do { S.st_v0 = LD8(ROWP((ref).V, k0, sr)); S.st_v1 = LD8(ROWP((ref).V, k0, 32 + sr)); \
    S.st_k0 = LD8(ROWP((ref).K, k0, sr)); S.st_k1 = LD8(ROWP((ref).K, k0, 32 + sr)); } while (0)
#define SWRITE_HK(bf) do { *(bf16x8*)(K_lds + (bf) * SHM_K + kws) = S.st_k0; *(bf16x8*)(K_lds + (bf) * SHM_K + kws + 32 * 256) = S.st_k1; } while (0)
#define SWRITE_HV(bf) do { *(bf16x8*)(V_lds + (bf) * SHM_V + vst0) = S.st_v0; *(bf16x8*)(V_lds + (bf) * SHM_V + vst1) = S.st_v1; } while (0)
#define SWRITE_H(bf) do { SWRITE_HV(bf); SWRITE_HK(bf); } while (0)

__device__ __forceinline__ void prime(const BlockRef& cur, int j_lo, int j_hi, char* lds, Seam& S) {
  const int tid = otid(), wid = __builtin_amdgcn_readfirstlane(tid >> 6), lane = tid & 63, r32 = lane & 31, hi = lane >> 5;
  const int sr = tid >> 4, sc = (tid & 15) * 8, kws = KSWZ(sr, sc * 2); char* K_lds = lds + 2 * SHM_V;
  const float cref = cur.C[cur.P0 + QB - 1];
#pragma unroll
  for (int d0 = 0; d0 < 8; ++d0) S.qr[d0] = LD8(cur.Q + (size_t)(wid * QBLK + r32) * LDQ + d0 * 16 + hi * 8);
  SLOAD_H(cur, j_lo * KVBLK);
  { float* ct = (float*)(lds + OFF_BIAS); const int k1 = j_hi * KVBLK;
#pragma unroll 4
    for (int i = j_lo * KVBLK + tid; i < k1; i += NTHREADS) ct[i] = (cref - cur.C[i]) * SQRTD; }
  VMW(); SWRITE_HK(0);
  __syncthreads();
}

__device__ __forceinline__ void block(const BlockRef& cur, int j_lo, int j_hi, float* opart, float* mlpart, char* lds, Seam& S) {
  const int tid = otid(), wid = __builtin_amdgcn_readfirstlane(tid >> 6), lane = tid & 63, r32 = lane & 31, hi = lane >> 5;
  const int NT = j_hi - j_lo;
  const int qlo = cur.P0 + wid * QBLK, qm = qlo + r32 - 4 * hi;
  char* V_lds = lds; char* K_lds = lds + 2 * SHM_V;
  float* ws = (float*)(lds + OFF_WS) + wid * 64; float* li_l = ws, * al_l = ws + 32;
  float m_reg = -1e30f, l_reg = 0; f32x16 o[4] = {};
  const int sr = tid >> 4, sc = (tid & 15) * 8, vst0 = v_st(sr, sc), vst1 = v_st(32 + sr, sc), kws = KSWZ(sr, sc * 2);
  const int vb0 = (int)(uintptr_t)V_lds + v_rd_base(lane);
#define RESC(a) do { if (__any((a) < 1.f)) { if (hi == 0) al_l[r32] = (a); asm volatile("s_waitcnt lgkmcnt(0)" ::: "memory"); \
    for (int d_ = 0; d_ < 4; ++d_) for (int r = 0; r < 16; ++r) o[d_][r] *= al_l[crow(r, hi)]; } } while (0)
#define KBASE(t) ((j_lo + (t)) * KVBLK)
#define MASKT(P0_, P1_, t) do { const int kb_ = KBASE(t); if (kb_ + KVBLK - 1 > qlo) mask_tile(P0_, P1_, qm - kb_, WBIG); } while (0)
  constexpr int NQL = 8;
#define SEAM_K0() do { VMWN(NQL); SWRITE_HK(0); SBAR(); } while (0)
  f32x16 pA0, pA1, pB0, pB1; float mnA, mnB, alA, alB; bf16x8 pa0, pa1, pa2, pa3;
  SWRITE_HV(0); SBAR();
  if (NT > 1) { SLOAD_H(cur, KBASE(1)); }
  SBAR(); qkt<0>(pA0, pA1, lds, r32, hi, S.qr);
  add_bias(pA0, pA1, lds, hi, KBASE(0)); MASKT(pA0, pA1, 0); partialSM(pA0, pA1, m_reg, mnA, alA);
  if (NT > 1) { VMW(); SWRITE_H(1); }
  __syncthreads();
#define HALF_STEP(PX0, PX1, mnX, alX, PY0, PY1, alY, t, KB, VB, SB) do { \
    SBAR(); qkt<KB>(PX0, PX1, lds, r32, hi, S.qr); \
    finishSM(PY0, PY1, alY, l_reg, pa0, pa1, pa2, pa3); SBAR(); \
    if ((t) + 1 < NT) { SLOAD_H(cur, KBASE((t) + 1)); SBAR(); } \
    pv_tile<VB>(o, vb0, pa0, pa1, pa2, pa3); add_bias(PX0, PX1, lds, hi, KBASE(t)); MASKT(PX0, PX1, (t)); partialSM(PX0, PX1, m_reg, mnX, alX); \
    __syncthreads(); \
    if ((t) + 1 < NT) { VMW(); SWRITE_H(SB); } \
    RESC(alX); __syncthreads(); } while (0)
  for (int t = 1; t + 1 < NT; t += 2) {
    HALF_STEP(pB0, pB1, mnB, alB, pA0, pA1, alA, t, 1, 0, 0);
    HALF_STEP(pA0, pA1, mnA, alA, pB0, pB1, alB, t + 1, 0, 1, 1);
  }
  const bool even = (NT & 1) == 0;
  if (even) { SBAR(); qkt<1>(pB0, pB1, lds, r32, hi, S.qr); SBAR(); }
  finishSM(pA0, pA1, alA, l_reg, pa0, pa1, pa2, pa3); SBAR();
  pv_tile<0>(o, vb0, pa0, pa1, pa2, pa3);
  if (even) { add_bias(pB0, pB1, lds, hi, KBASE(NT - 1)); MASKT(pB0, pB1, NT - 1); partialSM(pB0, pB1, m_reg, mnB, alB); __syncthreads(); RESC(alB);
    finishSM(pB0, pB1, alB, l_reg, pa0, pa1, pa2, pa3); SBAR(); pv_tile<1>(o, vb0, pa0, pa1, pa2, pa3); }
  SBAR();
  if (opart) {
    if (hi == 0) { mlpart[wid * QBLK + r32] = m_reg; mlpart[256 + wid * QBLK + r32] = l_reg; }
    float* Ow = opart + wid * QBLK * 128;
#pragma unroll
    for (int r = 0; r < 16; ++r) { const int orow = crow(r, hi);
#pragma unroll
      for (int d0 = 0; d0 < 4; ++d0) Ow[orow * 128 + d0 * 32 + r32] = o[d0][r]; }
  } else {
    if (hi == 0) li_l[r32] = l_reg; asm volatile("s_waitcnt lgkmcnt(0)" ::: "memory");
    float rli[16];
#pragma unroll
    for (int r = 0; r < 16; ++r) rli[r] = __builtin_amdgcn_rcpf(li_l[crow(r, hi)]);
    bf16_t* Ow = cur.O + wid * QBLK * LD;
#pragma unroll
    for (int r = 0; r < 16; ++r) { const int orow = crow(r, hi);
#pragma unroll
      for (int d0 = 0; d0 < 4; ++d0) { const float v = o[d0][r] * rli[r];
        const float vn = __shfl_xor(v, 1);
        if ((r32 & 1) == 0) *(unsigned*)(Ow + orow * LD + d0 * 32 + r32) = cvtpkv(v, vn); }
    }
  }
  __syncthreads();
#undef RESC
#undef KBASE
#undef MASKT
#undef SEAM_K0
#undef HALF_STEP
}
#undef ROWP
#undef VMW
#undef VMWN
#undef SLOAD_H
#undef SWRITE_HK
#undef SWRITE_HV
#undef SWRITE_H

__device__ __forceinline__ BlockRef mkref(const P& p, int hh, int qb) {
  BlockRef r; const size_t ho = (size_t)hh * 128, ro = (size_t)qb * QB * LD, hm = (size_t)hh * S * 128;
  r.Q = p.zb + (size_t)6 * S * HW + hm + (size_t)qb * QB * 128; r.K = p.zb + (size_t)7 * S * HW + hm; r.V = p.zb + (size_t)8 * S * HW + hm;
  r.G = p.zb + (size_t)9 * S * HW + ro + ho; r.O = p.oc + ro + ho; r.C = p.cc + (size_t)hh * S; r.P0 = qb * QB;
  return r;
}
__device__ __forceinline__ void pair_work(const P& p, int l, int w, char* lds) {
  const int tid = otid();
  const int hh = w & 7, role = (w >> 3) & 1, x = w >> 4, pi = x * 8 + hh;
  float* opart = p.opart + (size_t)(pi * 2 + role) * 32768; float* mlpart = p.mlpart + (size_t)(pi * 2 + role) * 512;
#pragma unroll 1
  for (int k = 0; k <= role; ++k) {
    const BlockRef b0 = mkref(p, hh, k ? x : 31 - x);
    const int split = x <= 13 ? 68 : 66;
    const int j_lo = (k == 0 && role) ? split : 0;
    const int j_hi = k ? 4 * (x + 1) : (role ? 4 * (32 - x) : split);
    Seam S;
    prime(b0, j_lo, j_hi, lds, S);
    block(b0, j_lo, j_hi, k ? nullptr : opart, mlpart, lds, S);
    if (k) {
      asm volatile("s_waitcnt vmcnt(0)" ::: "memory"); __syncthreads();
      if (tid == 0) { __builtin_amdgcn_fence(__ATOMIC_ACQUIRE, "agent"); asm volatile("s_waitcnt vmcnt(0)" ::: "memory"); }
      __syncthreads();
#pragma unroll 2
      for (int i = 0; i < 8; ++i) {
        const int id = tid + NTHREADS * i, row = id >> 4, ch = id & 15;
        bf16_t* op = b0.O + row * LD + ch * 8;
        const u32x4 ov = *(const u32x4*)op, gv = *(const u32x4*)(b0.G + row * LD + ch * 8);
        u32x4 r;
#pragma unroll
        for (int j = 0; j < 4; ++j) r[j] = cvtpk(bflo(ov[j]) * bflo(gv[j]), bfhi(ov[j]) * bfhi(gv[j]));
        *(u32x4*)op = r;
      }
      __syncthreads();
    }
  }
  asm volatile("s_waitcnt vmcnt(0)" ::: "memory"); __syncthreads();
  unsigned* flag = (unsigned*)(lds + OFF_WS);
  if (tid == 0) {
    __builtin_amdgcn_fence(__ATOMIC_RELEASE, "agent"); asm volatile("s_waitcnt vmcnt(0)" ::: "memory");
    const unsigned o_ = __hip_atomic_fetch_add(p.bar + XCD_BAR_WORDS + l * 128 + pi, 1u, __ATOMIC_RELAXED, __HIP_MEMORY_SCOPE_AGENT);
    if (o_ == 1u) { __builtin_amdgcn_fence(__ATOMIC_ACQUIRE, "agent"); asm volatile("s_waitcnt vmcnt(0)" ::: "memory"); }
    *flag = o_;
  }
  __syncthreads();
  const unsigned old = *flag;
  __syncthreads();
  if (old == 1u) {
    const BlockRef hv = mkref(p, hh, 31 - x);
    const float* oA = p.opart + (size_t)(pi * 2) * 32768; const float* oB = oA + 32768;
    const float* mA = p.mlpart + (size_t)(pi * 2) * 512; const float* mB = mA + 512;
    const int row = tid >> 1, c0 = (tid & 1) * 64;
    constexpr float C2 = 1.4426950408889634f * SCALE;
    const float ma = mA[row], la = mA[256 + row], mb = mB[row], lb = mB[256 + row];
    const float M = fmaxf(ma, mb), wa = __builtin_amdgcn_exp2f((ma - M) * C2), wb = __builtin_amdgcn_exp2f((mb - M) * C2);
    const float inv = 1.f / (la * wa + lb * wb);
#pragma unroll 4
    for (int j = 0; j < 16; ++j) {
      const f32x4 a = *(const f32x4*)(oA + row * 128 + c0 + 4 * j), b = *(const f32x4*)(oB + row * 128 + c0 + 4 * j);
      const u32x2 g = *(const u32x2*)(hv.G + row * LD + c0 + 4 * j);
      const float v0 = (a[0] * wa + b[0] * wb) * inv * bflo(g[0]), v1 = (a[1] * wa + b[1] * wb) * inv * bfhi(g[0]);
      const float v2 = (a[2] * wa + b[2] * wb) * inv * bflo(g[1]), v3 = (a[3] * wa + b[3] * wb) * inv * bfhi(g[1]);
      u32x2 ov = {cvtpk(v0, v1), cvtpk(v2, v3)};
      *(u32x2*)(hv.O + row * LD + c0 + 4 * j) = ov;
    }
  }
  __syncthreads();
}
}

__device__ __forceinline__ void glu_tile(const P& p, int l, int t, char* lds) {
  const int tid = otid(), lane = tid & 63, wid = tid >> 6, wr = wid >> 2, wc = wid & 3, fr = lane & 15, fq = lane >> 4;
  const int pm = t & 31, pn = t >> 5;
  f32x4 acc[8][4];
  zero_acc<4>(acc);
  gemm8_main(acc, p.yg + (size_t)pm * 256 * HW, p.WgluT + ((size_t)l * 2048 + (size_t)pn * 256) * HW, HW, lds);
  const bf16_t* sg = p.zb + (size_t)5 * S * HW;
#pragma unroll
  for (int m = 0; m < 8; ++m)
#pragma unroll
    for (int nt = 0; nt < 2; ++nt) {
      const int row = pm * 256 + (m >> 2) * 128 + wr * 64 + (m & 3) * 16 + fr, c = pn * 128 + wc * 32 + nt * 16 + 4 * fq;
      const u32x2 gt = *(const u32x2*)(sg + (size_t)row * HW + c);
      const f32x4 v = acc[m][nt], gg = acc[m][nt + 2];
      const float o0 = v[0] * sigmoidf_(gg[0]) * bflo(gt[0]), o1 = v[1] * sigmoidf_(gg[1]) * bfhi(gt[0]);
      const float o2 = v[2] * sigmoidf_(gg[2]) * bflo(gt[1]), o3 = v[3] * sigmoidf_(gg[3]) * bfhi(gt[1]);
      u32x2 o = {cvtpk(o0, o1), cvtpk(o2, o3)};
      *(u32x2*)(p.ob + (size_t)row * HW + c) = o;
      if (nt == 1) __builtin_amdgcn_sched_barrier(0);
    }
}
__device__ __forceinline__ void phase_attn_glu(const P& p, int l, char* lds) {
  const int G = ogdim(), b = obid();
#pragma unroll 1
  for (int w = b; w < 256; w += G) fa::pair_work(p, l, w, lds);
#pragma unroll 1
  for (int t = b; t < 256; t += G) glu_tile(p, l, t, lds);
}

__device__ __forceinline__ void phase_merge(const P& p, int l, char* lds) {
  const int tid = otid(), lane = tid & 63, wid = tid >> 6, wr = wid >> 2, wc = wid & 3, fr = lane & 15, fq = lane >> 4;
  for (int t = obid(); t < 32 * 16; t += ogdim()) {
    const int pm = t & 31, pn = t >> 5;
    f32x4 macc[8][2];
    zero_acc<2>(macc);
#pragma unroll 1
    for (int br = 0; br < 3; ++br) {
      const bf16_t* A = (br == 0 ? p.oa : br == 1 ? p.ob : p.oc) + (size_t)pm * 256 * HW;
      f32x4 acc[8][2];
      zero_acc<2>(acc);
      u32x2 gtv[8][2];
#pragma unroll
      for (int m = 0; m < 8; ++m)
#pragma unroll
        for (int nt = 0; nt < 2; ++nt) {
          const int row = pm * 256 + wr * 128 + m * 16 + fr, c = pn * 128 + wc * 32 + nt * 16 + 4 * fq;
          gtv[m][nt] = *(const u32x2*)(p.gates + (size_t)row * 6144 + br * DM + c);
        }
      gemm_main<2>(acc, A, HW, p.WbrT + ((size_t)(l * 3 + br) * DM + (size_t)pn * 128) * HW, HW, HW, lds);
#pragma unroll
      for (int m = 0; m < 8; ++m)
#pragma unroll
        for (int nt = 0; nt < 2; ++nt) {
          const u32x2 gt = gtv[m][nt];
          macc[m][nt][0] += bflo(gt[0]) * acc[m][nt][0]; macc[m][nt][1] += bfhi(gt[0]) * acc[m][nt][1];
          macc[m][nt][2] += bflo(gt[1]) * acc[m][nt][2]; macc[m][nt][3] += bfhi(gt[1]) * acc[m][nt][3];
        }
    }
#pragma unroll
    for (int m = 0; m < 8; ++m)
#pragma unroll
      for (int nt = 0; nt < 2; ++nt) {
        const int row = pm * 256 + wr * 128 + m * 16 + fr, c = pn * 128 + wc * 32 + nt * 16 + 4 * fq;
        u32x2 o = {cvtpk(macc[m][nt][0], macc[m][nt][1]), cvtpk(macc[m][nt][2], macc[m][nt][3])};
        *(u32x2*)(p.m + (size_t)row * DM + c) = o;
      }
  }
}

__device__ __forceinline__ void phase_wout(const P& p, int l, char* lds) {
  const int tid = otid(), lane = tid & 63, wid = tid >> 6, wr = wid >> 2, wc = wid & 3, fr = lane & 15, fq = lane >> 4;
  const float* xin = l == 0 ? p.x : p.xbuf;
  for (int t = obid(); t < 32 * 8; t += ogdim()) {
    const int pm = t & 31, pn = t >> 5;
    f32x4 acc[8][4];
    zero_acc<4>(acc);
    gemm8_main(acc, p.m + (size_t)pm * 256 * DM, p.WoutT + ((size_t)l * DM + (size_t)pn * 256) * DM, DM, lds);
#pragma unroll
    for (int m = 0; m < 8; ++m)
#pragma unroll
      for (int nt = 0; nt < 4; ++nt) {
        const int row = pm * 256 + (m >> 2) * 128 + wr * 64 + (m & 3) * 16 + fr, c = pn * 256 + wc * 32 + ncol<4>(nt) + 4 * fq;
        const f32x4 xv = *(const f32x4*)(xin + (size_t)row * DM + c);
        *(f32x4*)(p.xbuf + (size_t)row * DM + c) = xv + acc[m][nt];
        if (nt == 3) __builtin_amdgcn_sched_barrier(0);
      }
  }
}

#if SINGLE_LAUNCH
typedef const __attribute__((address_space(4))) P KP;
#if defined(__HIP_DEVICE_COMPILE__)
#define LOADP() KP* q_ = (KP*)__builtin_amdgcn_kernarg_segment_ptr(); asm volatile("" : "+s"(q_)); const P p = *(const P*)q_
#else
#define LOADP() const P p{}
#endif
constexpr int XB_ST_OFF = LDS_BYTES - 16;
__device__ __forceinline__ void gsync(char* lds) {
#if defined(__HIP_DEVICE_COMPILE__)
  KP* q_ = (KP*)__builtin_amdgcn_kernarg_segment_ptr(); asm volatile("" : "+s"(q_));
  XcdBarrier b; b.bar = ((const P*)q_)->bar; b.x = xb_xcc_id(); b.st = (volatile LAS unsigned*)(lds + XB_ST_OFF);
  xcd_barrier(b);
#endif
}
template <int L> __device__ __forceinline__ void run_layer(char* lds) {
#ifndef ONLY_S
#define PH_ON(s) 1
#else
#define PH_ON(s) ((s) == ONLY_S)
#endif
  if (L != 0) { if (PH_ON(0)) { LOADP(); phase_norm(p, L, lds); } gsync(lds); }
#if defined(DOUBLE_S) && DOUBLE_S == 0
  { LOADP(); phase_norm(p, L, lds); } gsync(lds);
#endif
  if (PH_ON(1)) { LOADP(); phase_gemm_in(p, L, lds); } gsync(lds);
#if defined(DOUBLE_S) && DOUBLE_S == 1
  { LOADP(); phase_gemm_in(p, L, lds); } gsync(lds);
#endif
  if (PH_ON(2)) { LOADP(); phase_local(p, L, lds); } gsync(lds);
#if defined(DOUBLE_S) && DOUBLE_S == 2
  { LOADP(); phase_local(p, L, lds); } gsync(lds);
#endif
  if (PH_ON(3)) { LOADP(); phase_scan(p, L); } gsync(lds);
#if defined(DOUBLE_S) && DOUBLE_S == 3
  { LOADP(); phase_scan(p, L); } gsync(lds);
#endif
  if (PH_ON(4)) { LOADP(); phase_out(p, L, lds); } gsync(lds);
#if defined(DOUBLE_S) && DOUBLE_S == 4
  { LOADP(); phase_out(p, L, lds); } gsync(lds);
#endif
  if (PH_ON(5)) { LOADP(); phase_attn_glu(p, L, lds); } gsync(lds);
#if defined(DOUBLE_S) && DOUBLE_S == 5
  { LOADP(); phase_attn_glu(p, L, lds); } gsync(lds);
#endif
  if (PH_ON(6)) { LOADP(); phase_merge(p, L, lds); } gsync(lds);
#if defined(DOUBLE_S) && DOUBLE_S == 6
  { LOADP(); phase_merge(p, L, lds); } gsync(lds);
#endif
  if (PH_ON(7)) { LOADP(); phase_wout(p, L, lds); } gsync(lds);
}

__global__ void __launch_bounds__(NTHREADS) fwd_kernel(P pdummy) {
  extern __shared__ __attribute__((aligned(16))) char lds[];
  cg::grid_group grid = cg::this_grid();
  (void)pdummy;
  if (threadIdx.x < 4) ((volatile LAS unsigned*)(lds + XB_ST_OFF))[threadIdx.x] = 0u;
  __syncthreads();
  { LOADP(); (void)xcd_barrier_post(p.bar, (volatile LAS unsigned*)(lds + XB_ST_OFF)); }
  { LOADP(); phase_prep(p, lds); if (p.out == nullptr) grid.sync(); }
  { LOADP(); phase_norm(p, 0, lds); }
  gsync(lds);
#if defined(DOUBLE_S) && DOUBLE_S == 9
  for (int i = 0; i < 16; ++i) gsync(lds);
#endif
  run_layer<0>(lds);
  run_layer<1>(lds);
  { LOADP(); phase_final_norm(p); }
}

#else
constexpr int NPHASE = 18;
#ifdef PROBE_A
__global__ void stamp_k(unsigned long long* ts, int i) { if (threadIdx.x == 0 && blockIdx.x == 0) ts[i] = wall_clock64(); }
__global__ void fill_k(float* out, const unsigned long long* ts) {
  const float c = (float)(ts[PROBE_A + 1] - ts[PROBE_A]) * 1e-4f, a = (float)(ts[PROBE_B + 1] - ts[PROBE_B]) * 1e-2f;
  for (unsigned i = blockIdx.x * blockDim.x + threadIdx.x; i < (unsigned)(S * DM); i += gridDim.x * blockDim.x) out[i] = i == 0 ? a : c;
}
#endif
template <int SS> __global__ void __launch_bounds__(NTHREADS) phase_k(P p, int l) {
  extern __shared__ __attribute__((aligned(16))) char lds[];
  if (SS == 8) phase_prep(p, lds);
  else if (SS == 9) phase_final_norm(p);
  else if (SS == 0) phase_norm(p, l, lds);
  else if (SS == 1) phase_gemm_in(p, l, lds);
  else if (SS == 2) phase_local(p, l, lds);
  else if (SS == 3) phase_scan(p, l);
  else if (SS == 4) phase_out(p, l, lds);
  else if (SS == 5) phase_attn_glu(p, l, lds);
  else if (SS == 6) phase_merge(p, l, lds);
  else phase_wout(p, l, lds);
}
#endif

extern "C" void kernel_launch(void* const* d_in, const int* in_sizes, int n_in, void* d_out, int out_size, void* d_ws, size_t ws_size,
                              hipStream_t stream) {
  (void)in_sizes; (void)n_in; (void)out_size;
  static int grid_blocks = 0;
  if (!grid_blocks) {
    int dev = 0, cus = 0;
    (void)hipGetDevice(&dev);
    (void)hipDeviceGetAttribute(&cus, hipDeviceAttributeMultiprocessorCount, dev);
    if (cus <= 0) cus = 256;
#if SINGLE_LAUNCH
    int per_cu = 0;
    hipError_t e = hipFuncSetAttribute((const void*)fwd_kernel, hipFuncAttributeMaxDynamicSharedMemorySize, LDS_BYTES);
    if (e != hipSuccess) fprintf(stderr, "hipFuncSetAttribute failed: %s\n", hipGetErrorString(e));
    (void)hipOccupancyMaxActiveBlocksPerMultiprocessor(&per_cu, fwd_kernel, NTHREADS, LDS_BYTES);
    if (per_cu < 1) fprintf(stderr, "occupancy query returned %d\n", per_cu);
#else
#define SETA(SS) (void)hipFuncSetAttribute((const void*)phase_k<SS>, hipFuncAttributeMaxDynamicSharedMemorySize, LDS_BYTES)
    SETA(0); SETA(1); SETA(2); SETA(3); SETA(4); SETA(5); SETA(6); SETA(7); SETA(8); SETA(9);
#undef SETA
#endif
    grid_blocks = cus;
  }
  P p{};
  const float* const* in = (const float* const*)d_in;
  p.x = in[0]; p.norm_g = in[1]; p.w_in = in[2]; p.b_gate = in[3]; p.fox_bf = in[4]; p.hg_lb = in[5]; p.hg_norm_g = in[6];
  p.a_re = in[7]; p.a_im = in[8]; p.log_dt = in[9]; p.b_re = in[10]; p.b_im = in[11]; p.c_re = in[12]; p.c_im = in[13];
  p.s5_d = in[14]; p.w_glu = in[15]; p.w_a = in[16]; p.w_b = in[17]; p.w_c = in[18]; p.w_out = in[19]; p.final_g = in[20];
  p.out = (float*)d_out;
  char* w = (char*)d_ws; size_t off = 0;
  auto take = [&](size_t bytes) { char* r = w + off; off += (bytes + 255) & ~(size_t)255; return r; };
  p.WinT = (bf16_t*)take((size_t)2 * NZ * DM * 2);
  p.WgluT = (bf16_t*)take((size_t)2 * 2048 * HW * 2);
  p.WbrT = (bf16_t*)take((size_t)6 * DM * HW * 2);
  p.WoutT = (bf16_t*)take((size_t)2 * DM * DM * 2);
  p.Ktab = (bf16_t*)take((size_t)2 * 64 * 32 * 256 * 2);
  p.M1 = (bf16_t*)take((size_t)2 * 64 * 128 * 512 * 2);
  p.M2 = (bf16_t*)take((size_t)2 * 64 * 512 * 128 * 2);
  p.AL = (float*)take((size_t)2 * 64 * 64 * 2 * 4);
  p.xbuf = (float*)take((size_t)S * DM * 4);
  p.h = (bf16_t*)take((size_t)S * DM * 2);
  p.lsf = (float*)take((size_t)S * 8 * 4);
  p.cc = (float*)take((size_t)S * 8 * 4);
  p.zb = (bf16_t*)take((size_t)10 * S * HW * 2);
  p.logf = (float*)take((size_t)S * HW * 4);
  p.gates = (bf16_t*)take((size_t)S * 6144 * 2);
  p.oin = (float*)take((size_t)S * HW * 4);
  p.qd = (bf16_t*)take((size_t)S * HW * 2);
  p.SlocT = (float*)take((size_t)8 * 128 * 128 * 128 * 4);
  p.elast = (float*)take((size_t)8 * 128 * 128 * 4);
  p.SprevT = (bf16_t*)take((size_t)8 * 128 * 128 * 128 * 2);
  p.Xloc = (float*)take((size_t)64 * NCH * 128 * 4);
  p.Xprev = (bf16_t*)take((size_t)64 * NCH * 128 * 2);
  p.yg = (bf16_t*)take((size_t)S * HW * 2);
  p.oa = (bf16_t*)take((size_t)S * HW * 2);
  p.ob = (bf16_t*)take((size_t)S * HW * 2);
  p.oc = (bf16_t*)take((size_t)S * HW * 2);
  p.m = (bf16_t*)take((size_t)S * DM * 2);
  p.ts = (unsigned long long*)take(4096);
  p.bar = (unsigned*)take((size_t)(XCD_BAR_WORDS + 256) * 4);
  p.opart = (float*)take((size_t)256 * 32768 * 4);
  p.mlpart = (float*)take((size_t)256 * 512 * 4);
  p.mtmp = (float*)take((size_t)256 * 65536 * 4);
  if (off > ws_size) { fprintf(stderr, "workspace too small: need %zu have %zu\n", off, ws_size); return; }
#if SINGLE_LAUNCH
  (void)hipMemsetAsync(p.bar, 0, (size_t)(XCD_BAR_WORDS + 256) * 4, stream);
  void* args[] = {&p};
  hipError_t e = hipLaunchCooperativeKernel((const void*)fwd_kernel, dim3(grid_blocks), dim3(NTHREADS), args, LDS_BYTES, stream);
  if (e != hipSuccess) fprintf(stderr, "cooperative launch failed: %s (grid %d)\n", hipGetErrorString(e), grid_blocks);
#else
#ifdef PROBE_A
  int sidx = 0;
#define LAUNCH(SS, L) do { stamp_k<<<1, 64, 0, stream>>>(p.ts, sidx++); phase_k<SS><<<dim3(grid_blocks), dim3(NTHREADS), LDS_BYTES, stream>>>(p, L); } while (0)
#else
#define LAUNCH(SS, L) phase_k<SS><<<dim3(grid_blocks), dim3(NTHREADS), LDS_BYTES, stream>>>(p, L)
#endif
  LAUNCH(8, 0);
  for (int l = 0; l < 2; ++l) { LAUNCH(0, l); LAUNCH(1, l); LAUNCH(2, l); LAUNCH(3, l); LAUNCH(4, l); LAUNCH(5, l); LAUNCH(6, l); LAUNCH(7, l); }
  LAUNCH(9, 0);
#ifdef PROBE_A
  stamp_k<<<1, 64, 0, stream>>>(p.ts, sidx++);
  fill_k<<<1024, 256, 0, stream>>>(p.out, p.ts);
#endif
#undef LAUNCH
#endif
}
```

```cpp
#include <hip/hip_runtime.h>
#include <hip/hip_cooperative_groups.h>
#include <cstdint>
#include <cstdio>
namespace cg = cooperative_groups;

typedef unsigned short bf16_t;
typedef short bf16x8 __attribute__((ext_vector_type(8)));
typedef short s16x4 __attribute__((ext_vector_type(4)));
typedef float f32x4 __attribute__((ext_vector_type(4)));
typedef float f32x2 __attribute__((ext_vector_type(2)));
typedef float f32x16 __attribute__((ext_vector_type(16)));
typedef unsigned u32x4 __attribute__((ext_vector_type(4)));
typedef unsigned u32x2 __attribute__((ext_vector_type(2)));

#ifndef SINGLE_LAUNCH
#define SINGLE_LAUNCH 1
#endif

constexpr int S = 8192, DM = 2048, INW = 16392, NZ = 16384, HW = 1024;
constexpr int NTHREADS = 512;
constexpr int LDS_BYTES = 151552;
constexpr float EPS = 1e-6f;
constexpr int SL = 32, NCH = S / SL;

struct P {
  const float *x, *norm_g, *w_in, *b_gate, *fox_bf, *hg_lb, *hg_norm_g, *a_re, *a_im, *log_dt, *b_re, *b_im, *c_re, *c_im,
      *s5_d, *w_glu, *w_a, *w_b, *w_c, *w_out, *final_g;
  float* out;
  bf16_t *WinT, *WgluT, *WbrT, *WoutT, *Ktab, *M1, *M2;
  float* AL;
  float* xbuf; bf16_t* h; float* lsf; float* cc;
  bf16_t* zb; float* logf; bf16_t* gates;
  float* oin; bf16_t* qd; float* SlocT; float* elast; bf16_t* SprevT;
  float* Xloc; bf16_t* Xprev; bf16_t* yg;
  bf16_t *oa, *ob, *oc, *m;
  unsigned long long* ts;
  unsigned* bar;
  float* opart; float* mlpart; float* mtmp;
};

typedef __bf16 bf16x2_t __attribute__((ext_vector_type(2)));
__device__ __forceinline__ unsigned cvtpk(float lo, float hi) { f32x2 v = {lo, hi}; bf16x2_t b = __builtin_convertvector(v, bf16x2_t); return *reinterpret_cast<unsigned*>(&b); }
__device__ __forceinline__ bf16_t f2bf(float v) { return (bf16_t)(cvtpk(v, 0.f) & 0xffffu); }
__device__ __forceinline__ float bf2f(bf16_t h) { return __uint_as_float(((unsigned)h) << 16); }
__device__ __forceinline__ float bflo(unsigned u) { return __uint_as_float(u << 16); }
__device__ __forceinline__ float bfhi(unsigned u) { return __uint_as_float(u & 0xffff0000u); }
__device__ __forceinline__ float sigmoidf_(float x) { return __builtin_amdgcn_rcpf(1.f + __expf(-x)); }
__device__ __forceinline__ float siluf_(float x) { return x * sigmoidf_(x); }
__device__ __forceinline__ float logsigf_(float x) { return fminf(x, 0.f) - log1pf(__expf(-fabsf(x))); }
__device__ __forceinline__ float gelu_tanh(float y) {
  const float u2 = 1.5957691216057308f * (y + 0.044715f * y * y * y); return y * __builtin_amdgcn_rcpf(1.f + __expf(-u2)); }
__device__ __forceinline__ int otid() { int t = threadIdx.x; asm volatile("" : "+v"(t)); return t; }
__device__ __forceinline__ int obid() { int b = blockIdx.x; asm volatile("" : "+s"(b)); return b; }
__device__ __forceinline__ int ogdim() { int g = gridDim.x; asm volatile("" : "+s"(g)); return g; }
__device__ __forceinline__ f32x4 mfma16(bf16x8 a, bf16x8 b, f32x4 c) { return __builtin_amdgcn_mfma_f32_16x16x32_bf16(a, b, c, 0, 0, 0); }
__device__ __forceinline__ float wave_sum(float v) {
#pragma unroll
  for (int o = 32; o >= 1; o >>= 1) v += __shfl_xor(v, o);
  return v;
}
__device__ __forceinline__ bf16x8 pack8f(const float* v) {
  u32x4 w = {cvtpk(v[0], v[1]), cvtpk(v[2], v[3]), cvtpk(v[4], v[5]), cvtpk(v[6], v[7])};
  return *reinterpret_cast<bf16x8*>(&w);
}

#define XB_TMO      128
#define XB_XCNT(j)  (256  + 64 * (j))
#define XB_XSUB(j)  (1280 + 64 * (j))
#define XB_XGEN(j)  (2304 + 64 * (j))
#define XB_TOP      3328
#define XB_TOPGEN   3392
#define XCD_BAR_WORDS 3456
#define XB_SPIN_CAP (1u << 18)
#define LAS __attribute__((address_space(3)))

__device__ __forceinline__ unsigned xb_ld(unsigned* p)              { return __hip_atomic_load(p, __ATOMIC_RELAXED, __HIP_MEMORY_SCOPE_AGENT); }
__device__ __forceinline__ unsigned xb_add(unsigned* p, unsigned v) { return __hip_atomic_fetch_add(p, v, __ATOMIC_RELAXED, __HIP_MEMORY_SCOPE_AGENT); }
__device__ __forceinline__ unsigned xb_xcc_id() { return (unsigned)__builtin_amdgcn_s_getreg((3 << 11) | 20) & 0xFu; }
#define XB_SPIN(cond, bar) do { unsigned _sp = 0; while (cond) { __builtin_amdgcn_s_sleep(1); \
    if ((++_sp & 255u) == 0u) { if (xb_ld(&(bar)[XB_TMO])) break; if (_sp > XB_SPIN_CAP) { atomicAdd(&(bar)[XB_TMO], 1u); break; } } } } while (0)

struct XcdBarrier {
    unsigned* bar; unsigned x;
    volatile LAS unsigned* st;
};

__device__ __forceinline__ XcdBarrier xcd_barrier_post(unsigned* bar, volatile LAS unsigned* st) {
    XcdBarrier b; b.bar = bar; b.x = xb_xcc_id(); b.st = st;
    if (threadIdx.x == 0) (void)xb_add(&bar[XB_XCNT(b.x)], 1u);
    return b;
}
__device__ __forceinline__ void xcd_barrier_complete(unsigned* bar, unsigned x, unsigned& nloc, unsigned& nx) {
    const unsigned G = gridDim.x * gridDim.y * gridDim.z;
    unsigned sum, cnt, mine, sp = 0u;
    for (;;) {
        sum = 0u; cnt = 0u; mine = 0u;
#pragma unroll
        for (unsigned j = 0; j < 16; ++j) { const unsigned c = xb_ld(&bar[XB_XCNT(j)]); sum += c; cnt += (c > 0u) ? 1u : 0u; mine = (j == x) ? c : mine; }
        if (sum == G) break;
        __builtin_amdgcn_s_sleep(1);
        if ((++sp & 255u) == 0u) { if (xb_ld(&bar[XB_TMO])) break; if (sp > XB_SPIN_CAP) { atomicAdd(&bar[XB_TMO], 1u); break; } }
    }
    nloc = mine > 0u ? mine : 1u; nx = cnt > 0u ? cnt : 1u;
}

__device__ __forceinline__ void xcd_barrier(const XcdBarrier& b) {
    asm volatile("s_waitcnt vmcnt(0)" ::: "memory");
    __syncthreads();
    if (threadIdx.x == 0) {
        unsigned* bar = b.bar;
        __builtin_amdgcn_s_waitcnt(0);
        unsigned nloc = b.st[0], nx = b.st[1];
        if (nloc == 0u) { xcd_barrier_complete(bar, b.x, nloc, nx); b.st[0] = nloc; b.st[1] = nx; }
        const unsigned old = xb_add(&bar[XB_XSUB(b.x)], 1u);
        const unsigned gen = old / nloc;
        if (old + 1u == (gen + 1u) * nloc) {
            __builtin_amdgcn_fence(__ATOMIC_RELEASE, "agent");
            asm volatile("s_waitcnt vmcnt(0)" ::: "memory");
            const unsigned og = xb_add(&bar[XB_TOP], 1u);
            const unsigned tg = og / nx;
            if (og + 1u == (tg + 1u) * nx) xb_add(&bar[XB_TOPGEN], 1u);
            else XB_SPIN(xb_ld(&bar[XB_TOPGEN]) == tg, bar);
            __builtin_amdgcn_fence(__ATOMIC_ACQUIRE, "agent");
            xb_add(&bar[XB_XGEN(b.x)], 1u);
            asm volatile("s_waitcnt vmcnt(0)" ::: "memory");
        } else {
            XB_SPIN(xb_ld(&bar[XB_XGEN(b.x)]) == gen, bar);
            __builtin_amdgcn_fence(__ATOMIC_ACQUIRE, "agent");
            asm volatile("s_waitcnt vmcnt(0)" ::: "memory");
        }
    }
    __syncthreads();
}


template <int NT> __device__ __forceinline__ int ncol(int nt) { return NT == 4 ? ((nt >> 1) * 128 + (nt & 1) * 16) : nt * 16; }

template <int NT>
__device__ __forceinline__ void gemm_main(f32x4 (&acc)[8][NT], const bf16_t* __restrict__ A, int lda, const bf16_t* __restrict__ Bt, int ldb, int K, char* lds) {
  constexpr int BN = NT * 64;
  constexpr int BUF = 32768 + BN * 128;
  const int tid = otid(), lane = tid & 63, wid = tid >> 6, wr = wid >> 2, wc = wid & 3, fr = lane & 15, fq = lane >> 4;
  const int lrow = tid >> 3, sch = (tid & 7) ^ (lrow & 7);
  const char* ga = (const char*)(A + (size_t)lrow * lda + sch * 8);
  const char* gb = (const char*)(Bt + (size_t)lrow * ldb + sch * 8);
#define GDMA(bufp, kt) do { _Pragma("unroll") for (int i = 0; i < 4; ++i) \
      __builtin_amdgcn_global_load_lds((const unsigned*)(ga + ((size_t)i * 64 * lda + (kt) * 64) * 2), (__attribute__((address_space(3))) unsigned*)((bufp) + i * 8192 + tid * 16), 16, 0, 0); \
    _Pragma("unroll") for (int i = 0; i < NT; ++i) \
      __builtin_amdgcn_global_load_lds((const unsigned*)(gb + ((size_t)i * 64 * ldb + (kt) * 64) * 2), (__attribute__((address_space(3))) unsigned*)((bufp) + 32768 + i * 8192 + tid * 16), 16, 0, 0); } while (0)
  const int a0 = (wr * 128 + fr) * 128 + ((fq ^ (fr & 7)) << 4);
  const int a1 = (wr * 128 + fr) * 128 + (((4 + fq) ^ (fr & 7)) << 4);
  const int b0 = 32768 + (wc * 32 + fr) * 128 + ((fq ^ (fr & 7)) << 4);
  const int b1 = 32768 + (wc * 32 + fr) * 128 + (((4 + fq) ^ (fr & 7)) << 4);
  const int nk = K >> 6;
  GDMA(lds, 0); GDMA(lds + BUF, 1);
  asm volatile("s_waitcnt vmcnt(%0)" :: "i"(4 + NT) : "memory");
  __builtin_amdgcn_s_barrier();
  int cur = 0;
#pragma unroll 1
  for (int kt = 0; kt < nk; ++kt) {
    const char* buf = lds + cur * BUF;
    const int nxt2 = cur == 0 ? 2 : cur - 1;
    if (kt + 2 < nk) GDMA(lds + nxt2 * BUF, kt + 2);
    {
      bf16x8 af[8], bfr[NT];
#pragma unroll
      for (int m = 0; m < 8; ++m) af[m] = *(const bf16x8*)(buf + a0 + m * 2048);
#pragma unroll
      for (int nt = 0; nt < NT; ++nt) bfr[nt] = *(const bf16x8*)(buf + b0 + ncol<NT>(nt) * 128);
#pragma unroll
      for (int m = 0; m < 8; ++m)
#pragma unroll
        for (int nt = 0; nt < NT; ++nt) acc[m][nt] = mfma16(bfr[nt], af[m], acc[m][nt]);
    }
    {
      bf16x8 af[8], bfr[NT];
#pragma unroll
      for (int m = 0; m < 8; ++m) af[m] = *(const bf16x8*)(buf + a1 + m * 2048);
#pragma unroll
      for (int nt = 0; nt < NT; ++nt) bfr[nt] = *(const bf16x8*)(buf + b1 + ncol<NT>(nt) * 128);
#pragma unroll
      for (int m = 0; m < 8; ++m)
#pragma unroll
        for (int nt = 0; nt < NT; ++nt) acc[m][nt] = mfma16(bfr[nt], af[m], acc[m][nt]);
    }
    if (kt + 2 < nk) asm volatile("s_waitcnt vmcnt(%0)" :: "i"(4 + NT) : "memory");
    else asm volatile("s_waitcnt vmcnt(0)" ::: "memory");
    asm volatile("s_waitcnt lgkmcnt(0)" ::: "memory");
    __builtin_amdgcn_s_barrier();
    cur = cur == 2 ? 0 : cur + 1;
  }
#undef GDMA
}

template <int NT> __device__ __forceinline__ void zero_acc(f32x4 (&acc)[8][NT]) {
#pragma unroll
  for (int m = 0; m < 8; ++m)
#pragma unroll
    for (int nt = 0; nt < NT; ++nt) acc[m][nt] = (f32x4){0.f, 0.f, 0.f, 0.f};
}

namespace g8 {
constexpr int BK = 64, HALF = 128, HT = HALF * BK;
__device__ __forceinline__ int lds_byte(int r, int c) { const int st = (r >> 4) * 2 + (c >> 5), rr = r & 15, cc = c & 31, ob = rr * 64 + cc * 2; return st * 1024 + (ob ^ (((ob >> 9) & 1) << 5)); }
__device__ __forceinline__ void stage_rc(int b, int& R, int& C) { const int st = b / 1024, sb = b % 1024, swz = sb ^ (((sb >> 9) & 1) << 5); R = (st >> 1) * 16 + swz / 64; C = (st & 1) * 32 + (swz % 64) / 2; }
}
__device__ __forceinline__ void gemm8_main(f32x4 (&acc)[8][4], const bf16_t* __restrict__ A, const bf16_t* __restrict__ Bt, int K, char* lds) {
  using namespace g8;
  bf16_t* shm = (bf16_t*)lds;
  const int tid = otid();
#define SA(b, h) (shm + ((b) * 2 + (h)) * HT)
#define SB(b, h) (shm + (4 + (b) * 2 + (h)) * HT)
#define STAGE(Pp, BASE, br, kt) do { const char* _g = (const char*)((BASE) + (long)(br) * K + (long)(kt) * BK); \
    __builtin_amdgcn_global_load_lds((const unsigned*)(_g + goff0), (__attribute__((address_space(3))) unsigned*)((char*)(Pp) + tid * 16), 16, 0, 0); \
    __builtin_amdgcn_global_load_lds((const unsigned*)(_g + goff1), (__attribute__((address_space(3))) unsigned*)((char*)(Pp) + tid * 16 + 8192), 16, 0, 0); } while (0)
#define LDA(dst, b, h) _Pragma("unroll") for (int m = 0; m < 4; ++m) _Pragma("unroll") for (int k = 0; k < 2; ++k) \
    dst[m][k] = *reinterpret_cast<const bf16x8*>(lds + ((b) * 2 + (h)) * 16384 + aoff + m * 2048 + k * 1024)
#define LDB(dst, b, h) _Pragma("unroll") for (int n = 0; n < 2; ++n) _Pragma("unroll") for (int k = 0; k < 2; ++k) \
    dst[n][k] = *reinterpret_cast<const bf16x8*>(lds + (4 + (b) * 2 + (h)) * 16384 + boff + n * 2048 + k * 1024)
#define MMA(ai, bj, At_, Bt_) do { __builtin_amdgcn_s_setprio(1); \
    _Pragma("unroll") for (int m = 0; m < 4; ++m) _Pragma("unroll") for (int n = 0; n < 2; ++n) _Pragma("unroll") for (int k = 0; k < 2; ++k) \
      acc[(ai) * 4 + m][(bj) * 2 + n] = __builtin_amdgcn_mfma_f32_16x16x32_bf16(Bt_[n][k], At_[m][k], acc[(ai) * 4 + m][(bj) * 2 + n], 0, 0, 0); \
    __builtin_amdgcn_s_setprio(0); } while (0)
#define WAIT_V(n) asm volatile("s_waitcnt vmcnt(" #n ")" ::: "memory")
#define WAIT_L(n) asm volatile("s_waitcnt lgkmcnt(" #n ")" ::: "memory")
#define BAR __builtin_amdgcn_s_barrier()
#define SCHED __builtin_amdgcn_sched_barrier(0)
  const int wid = tid >> 6, lane = tid & 63, wr = wid >> 2, wc = wid & 3, fr = lane & 15, fq = lane >> 4;
  bf16x8 At[4][2], B0[2][2], B1[2][2];
  const int nt = K / BK;
  const int swz_ = (fr * 64 + fq * 16) ^ ((((fr * 64 + fq * 16) >> 9) & 1) << 5);
  const int aoff = wr * 8192 + swz_, boff = wc * 4096 + swz_;
  unsigned goff0, goff1;
  { int r_, c_; stage_rc(tid * 16, r_, c_); goff0 = (unsigned)(r_ * K + c_) * 2u; stage_rc(tid * 16 + 8192, r_, c_); goff1 = (unsigned)(r_ * K + c_) * 2u; }
  STAGE(SB(0, 0), Bt, 0, 0); STAGE(SA(0, 0), A, 0, 0);
  STAGE(SB(0, 1), Bt, HALF, 0); STAGE(SA(0, 1), A, HALF, 0);
  if (wr == 1) BAR;
  WAIT_V(4); BAR;
  STAGE(SB(1, 0), Bt, 0, 1); STAGE(SA(1, 0), A, 0, 1); STAGE(SB(1, 1), Bt, HALF, 1);
  WAIT_V(6); BAR;
  for (int t = 0; t < nt - 2; t += 2) {
    LDB(B0, 0, 0); SCHED; LDA(At, 0, 0); STAGE(SA(1, 1), A, HALF, t + 1);
    WAIT_L(8); BAR; WAIT_L(0); MMA(0, 0, At, B0); BAR; SCHED;
    LDB(B1, 0, 1); STAGE(SB(0, 0), Bt, 0, t + 2);
    BAR; WAIT_L(0); MMA(0, 1, At, B1); BAR;
    LDA(At, 0, 1); STAGE(SA(0, 0), A, 0, t + 2);
    BAR; WAIT_L(0); MMA(1, 0, At, B0); BAR; SCHED;
    STAGE(SB(0, 1), Bt, HALF, t + 2);
    WAIT_V(6); BAR; MMA(1, 1, At, B1); BAR;
    LDB(B0, 1, 0); SCHED; LDA(At, 1, 0); STAGE(SA(0, 1), A, HALF, t + 2);
    WAIT_L(8); BAR; WAIT_L(0); MMA(0, 0, At, B0); BAR; SCHED;
    LDB(B1, 1, 1); STAGE(SB(1, 0), Bt, 0, t + 3);
    BAR; WAIT_L(0); MMA(0, 1, At, B1); BAR;
    LDA(At, 1, 1); STAGE(SA(1, 0), A, 0, t + 3);
    BAR; WAIT_L(0); MMA(1, 0, At, B0); BAR; SCHED;
    STAGE(SB(1, 1), Bt, HALF, t + 3);
    WAIT_V(6); BAR; MMA(1, 1, At, B1); BAR;
  }
  { LDB(B0, 0, 0); LDA(At, 0, 0); STAGE(SA(1, 1), A, HALF, nt - 1);
    BAR; WAIT_L(0); MMA(0, 0, At, B0); BAR;
    LDB(B1, 0, 1); BAR; WAIT_L(0); MMA(0, 1, At, B1); BAR;
    LDA(At, 0, 1); WAIT_V(4); BAR; WAIT_L(0); MMA(1, 0, At, B0); MMA(1, 1, At, B1); BAR; }
  { LDB(B0, 1, 0); LDA(At, 1, 0); WAIT_V(2); BAR; WAIT_L(0); MMA(0, 0, At, B0); BAR;
    LDB(B1, 1, 1); WAIT_V(0); BAR; WAIT_L(0); MMA(0, 1, At, B1); BAR;
    LDA(At, 1, 1); BAR; WAIT_L(0); MMA(1, 0, At, B0); MMA(1, 1, At, B1); BAR; }
  if (wr == 0) BAR;
  __syncthreads();
#undef SA
#undef SB
#undef STAGE
#undef LDA
#undef LDB
#undef MMA
#undef WAIT_V
#undef WAIT_L
#undef BAR
#undef SCHED
}

__device__ __forceinline__ void tr_tile(const float* __restrict__ src, int ld_src, int k0, int scol0, int scol1, bf16_t* __restrict__ dst, int ld_dst, int n_dst0, char* lds) {
  float* t = (float*)lds;
  const int tid = otid();
  {
    const int c4 = (tid & 63) * 4, kq = tid >> 6;
    const int sc = c4 < 128 ? scol0 + c4 : scol1 + (c4 - 128);
    f32x4 v[8];
#pragma unroll
    for (int i = 0; i < 8; ++i) v[i] = *(const f32x4*)(src + (size_t)(k0 + kq + 8 * i) * ld_src + sc);
#pragma unroll
    for (int i = 0; i < 8; ++i) { float* tp = t + (kq + 8 * i) * 257 + c4; tp[0] = v[i][0]; tp[1] = v[i][1]; tp[2] = v[i][2]; tp[3] = v[i][3]; }
  }
  __syncthreads();
  {
    const int n = tid >> 1, kh = (tid & 1) * 32;
    bf16_t* d = dst + (size_t)(n_dst0 + n) * ld_dst + k0 + kh;
#pragma unroll
    for (int q = 0; q < 4; ++q) {
      float v[8];
#pragma unroll
      for (int j = 0; j < 8; ++j) v[j] = t[(kh + q * 8 + j) * 257 + n];
      *(bf16x8*)(d + q * 8) = pack8f(v);
    }
  }
  __syncthreads();
}

__device__ __forceinline__ void s5_tables(const P& p, int unit, char* lds) {
  const int l = unit >> 6, g = unit & 63, lg = l * 64 + g, tid = threadIdx.x;
  f32x2* pw = (f32x2*)lds;
  f32x2* bb = (f32x2*)(lds + 17408);
  f32x2* cw = (f32x2*)(lds + 25600);
  const float dtf = expf(p.log_dt[lg]);
#pragma unroll 1
  for (int idx = tid; idx < 64 * 33; idx += NTHREADS) {
    const int pp = idx / 33, j = idx - pp * 33;
    const float ar = p.a_re[lg * 64 + pp], ai = p.a_im[lg * 64 + pp];
    double rev = (double)ai * (double)dtf * (double)j * 0.15915494309189535;
    rev -= rint(rev);
    const float mag = expf(ar * dtf * (float)j);
    const float rf = (float)rev;
    pw[pp * 34 + j] = (f32x2){mag * __builtin_amdgcn_cosf(rf), mag * __builtin_amdgcn_sinf(rf)};
  }
#pragma unroll 1
  for (int idx = tid; idx < 1024; idx += NTHREADS) {
    const int pp = idx >> 4, c = idx & 15;
    const float ar = p.a_re[lg * 64 + pp], ai = p.a_im[lg * 64 + pp];
    double rev = (double)ai * (double)dtf * 0.15915494309189535;
    rev -= rint(rev);
    const float mag = expf(ar * dtf), rf = (float)rev;
    const float abr = mag * __builtin_amdgcn_cosf(rf), abi = mag * __builtin_amdgcn_sinf(rf);
    const float nr = abr - 1.f, den = ar * ar + ai * ai;
    const float zr = (nr * ar + abi * ai) / den, zi = (abi * ar - nr * ai) / den;
    const float br = p.b_re[(size_t)(lg * 64 + pp) * 16 + c], bi = p.b_im[(size_t)(lg * 64 + pp) * 16 + c];
    bb[idx] = (f32x2){zr * br - zi * bi, zr * bi + zi * br};
    const int c2 = idx >> 6, p2 = idx & 63;
    cw[idx] = (f32x2){p.c_re[(size_t)(lg * 16 + c2) * 64 + p2], p.c_im[(size_t)(lg * 16 + c2) * 64 + p2]};
  }
  __syncthreads();
#pragma unroll 1
  for (int idx = tid; idx < 32 * 256; idx += NTHREADS) {
    const int d = idx >> 8, c = (idx >> 4) & 15, c1 = idx & 15;
    float sum = 0.f;
#pragma unroll 4
    for (int pp = 0; pp < 64; ++pp) {
      const f32x2 w = pw[pp * 34 + d], b = bb[pp * 16 + c1], cv = cw[c * 64 + pp];
      const float tr = w[0] * b[0] - w[1] * b[1], ti = w[0] * b[1] + w[1] * b[0];
      sum += cv[0] * tr - cv[1] * ti;
    }
    p.Ktab[(size_t)(lg * 32 + d) * 256 + c * 16 + c1] = f2bf(sum);
  }
#pragma unroll 2
  for (int idx = tid; idx < 128 * 512; idx += NTHREADS) {
    const int pr = idx >> 9, col = idx & 511, s = col >> 4, c1 = col & 15, pp = pr & 63, im = pr >> 6;
    const f32x2 w = pw[pp * 34 + (SL - 1 - s)], b = bb[pp * 16 + c1];
    const float tr = w[0] * b[0] - w[1] * b[1], ti = w[0] * b[1] + w[1] * b[0];
    p.M1[(size_t)(lg * 128 + pr) * 512 + col] = f2bf(im ? ti : tr);
  }
#pragma unroll 2
  for (int idx = tid; idx < 512 * 128; idx += NTHREADS) {
    const int row = idx >> 7, pr = idx & 127, t = row >> 4, c = row & 15, pp = pr & 63, im = pr >> 6;
    const f32x2 w = pw[pp * 34 + t + 1], cv = cw[c * 64 + pp];
    const float tr = cv[0] * w[0] - cv[1] * w[1], ti = cv[0] * w[1] + cv[1] * w[0];
    p.M2[(size_t)(lg * 512 + row) * 128 + pr] = f2bf(im ? -ti : tr);
  }
  if (tid < 64) { const f32x2 w = pw[tid * 34 + SL]; p.AL[(lg * 64 + tid) * 2] = w[0]; p.AL[(lg * 64 + tid) * 2 + 1] = w[1]; }
  __syncthreads();
}

__device__ __forceinline__ void phase_prep(const P& p, char* lds) {
  constexpr int NT_ALL = 4096 + 256 + 768 + 512;
  const int G = ogdim(), b = obid();
  const bool bal = (G == 256);
  if (bal ? (b < 128) : true) { for (int u = b; u < 128; u += (bal ? 128 : G)) s5_tables(p, u, lds); }
  const int first = bal ? (b < 128 ? b : 2176 + (b - 128)) : b, step = bal ? 128 : G, count = bal ? (b < 128 ? 17 : 27) : (NT_ALL + G - 1) / G;
#pragma unroll 1
  for (int i = 0; i < count; ++i) {
    int u = first + i * step;
    if (u >= NT_ALL) break;
    if (u < 4096) {
      const int l = u >> 11, rem = u & 2047, kt = rem >> 6, ntile = rem & 63, n0 = ntile * 256, s0 = n0 + (n0 >= 9216 ? 8 : 0);
      tr_tile(p.w_in + (size_t)l * DM * INW, INW, kt * 64, s0, s0 + 128, p.WinT + (size_t)l * NZ * DM, DM, n0, lds);
      continue;
    }
    u -= 4096;
    if (u < 256) {
      const int l = u >> 7, rem = u & 127, kt = rem >> 3, j = rem & 7;
      tr_tile(p.w_glu + (size_t)l * HW * 2048, 2048, kt * 64, j * 128, 1024 + j * 128, p.WgluT + (size_t)l * 2048 * HW, HW, j * 256, lds);
      continue;
    }
    u -= 256;
    if (u < 768) {
      const int mat = u >> 7, rem = u & 127, kt = rem >> 3, ntile = rem & 7, l = mat / 3, br = mat - l * 3;
      const float* s = (br == 0 ? p.w_a : br == 1 ? p.w_b : p.w_c) + (size_t)l * HW * DM;
      tr_tile(s, DM, kt * 64, ntile * 256, ntile * 256 + 128, p.WbrT + (size_t)mat * DM * HW, HW, ntile * 256, lds);
      continue;
    }
    u -= 768;
    {
      const int l = u >> 8, rem = u & 255, kt = rem >> 3, ntile = rem & 7;
      tr_tile(p.w_out + (size_t)l * DM * DM, DM, kt * 64, ntile * 256, ntile * 256 + 128, p.WoutT + (size_t)l * DM * DM, DM, ntile * 256, lds);
    }
  }
}

__device__ __forceinline__ void phase_norm(const P& p, int l, char* lds) {
  const float* xin = l == 0 ? p.x : p.xbuf;
  const int tid = otid(), lane = tid & 63, wid = __builtin_amdgcn_readfirstlane(tid >> 6);
  const float* wl = p.w_in + (size_t)l * DM * INW;
#pragma unroll
  for (int i = 0; i < 8; ++i) { const int idx = tid + NTHREADS * i, k = idx >> 1, hf = idx & 1; *(f32x4*)(lds + k * 32 + hf * 16 + (k >> 2) * 16) = *(const f32x4*)(wl + (size_t)k * INW + 9216 + hf * 4); }
  __syncthreads();
  const float* g = p.norm_g + l * DM;
#pragma unroll 1
  for (int row = obid() * 8 + wid; row < S; row += ogdim() * 8) {
    const float* xr = xin + (size_t)row * DM; bf16_t* hrow = p.h + (size_t)row * DM;
    f32x4 xv[8];
    float ss = 0.f;
#pragma unroll
    for (int j = 0; j < 8; ++j) { xv[j] = *(const f32x4*)(xr + (unsigned)(lane + 64 * j) * 4u); ss += xv[j][0] * xv[j][0] + xv[j][1] * xv[j][1] + xv[j][2] * xv[j][2] + xv[j][3] * xv[j][3]; }
    ss = wave_sum(ss);
    const float rstd = rsqrtf(ss * (1.f / DM) + EPS);
    float fa[8] = {0.f, 0.f, 0.f, 0.f, 0.f, 0.f, 0.f, 0.f};
#pragma unroll
    for (int j = 0; j < 8; ++j) {
      const unsigned c = (unsigned)(lane + 64 * j) * 4u;
      const f32x4 gv = *(const f32x4*)(g + c);
      float hv[4];
#pragma unroll
      for (int e = 0; e < 4; ++e) hv[e] = xv[j][e] * rstd * gv[e];
      u32x2 o = {cvtpk(hv[0], hv[1]), cvtpk(hv[2], hv[3])};
      *(u32x2*)(hrow + c) = o;
#pragma unroll
      for (int e = 0; e < 4; ++e) {
        const f32x4 w0 = *(const f32x4*)(lds + (c + e) * 32 + (c >> 2) * 16), w1 = *(const f32x4*)(lds + (c + e) * 32 + 16 + (c >> 2) * 16);
        fa[0] += hv[e] * w0[0]; fa[1] += hv[e] * w0[1]; fa[2] += hv[e] * w0[2]; fa[3] += hv[e] * w0[3];
        fa[4] += hv[e] * w1[0]; fa[5] += hv[e] * w1[1]; fa[6] += hv[e] * w1[2]; fa[7] += hv[e] * w1[3];
      }
      __builtin_amdgcn_sched_barrier(0);
    }
#pragma unroll
    for (int j = 0; j < 8; ++j) fa[j] = wave_sum(fa[j]);
    {
      float v = fa[0];
#pragma unroll
      for (int j = 1; j < 8; ++j) v = (lane == j) ? fa[j] : v;
      if (lane < 8) p.lsf[row * 8 + lane] = logsigf_(v + p.fox_bf[l * 8 + lane]);
    }
  }
  __syncthreads();
}

__device__ __forceinline__ void phase_final_norm(const P& p) {
  const int tid = otid(), lane = tid & 63, wid = __builtin_amdgcn_readfirstlane(tid >> 6);
#pragma unroll 1
  for (int row = obid() * 8 + wid; row < S; row += ogdim() * 8) {
    const float* xr = p.xbuf + (size_t)row * DM;
    f32x4 xv[8];
    float ss = 0.f;
#pragma unroll
    for (int j = 0; j < 8; ++j) { xv[j] = *(const f32x4*)(xr + (lane + 64 * j) * 4); ss += xv[j][0] * xv[j][0] + xv[j][1] * xv[j][1] + xv[j][2] * xv[j][2] + xv[j][3] * xv[j][3]; }
    ss = wave_sum(ss);
    const float rstd = rsqrtf(ss * (1.f / DM) + EPS);
#pragma unroll
    for (int j = 0; j < 8; ++j) {
      const int c = (lane + 64 * j) * 4;
      const f32x4 gv = *(const f32x4*)(p.final_g + c);
      f32x4 o;
#pragma unroll
      for (int e = 0; e < 4; ++e) o[e] = xv[j][e] * rstd * gv[e];
      *(f32x4*)(p.out + (size_t)row * DM + c) = o;
    }
  }
}

__device__ __forceinline__ void phase_gemm_in(const P& p, int l, char* lds) {
  const int tid = otid(), lane = tid & 63, wid = tid >> 6, wr = wid >> 2, wc = wid & 3, fr = lane & 15, fq = lane >> 4;
  for (int t = obid(); t < 32 * 64; t += ogdim()) {
    const int pm = t & 31, pn = t >> 5;
    f32x4 acc[8][4];
    zero_acc<4>(acc);
    gemm8_main(acc, p.h + (size_t)pm * 256 * DM, p.WinT + ((size_t)l * NZ + (size_t)pn * 256) * DM, DM, lds);
    const int region = pn >> 2;
    const int row0 = pm * 256 + wr * 64 + fr;
    const int cbase = (pn & 3) * 256 + wc * 32 + 4 * fq;
    if (region == 1) {
#pragma unroll
      for (int nt = 0; nt < 4; ++nt) {
        const int c = cbase + ncol<4>(nt);
        float lb[4], la[4], l1m[4];
#pragma unroll
        for (int e = 0; e < 4; ++e) {
          lb[e] = l == 0 ? 0.f : sigmoidf_(p.hg_lb[HW + c + e] - p.hg_lb[c + e]);
          la[e] = l == 0 ? -1e30f : __logf(lb[e]);
          l1m[e] = l == 0 ? 0.f : __logf(1.f - lb[e]);
        }
#pragma unroll
        for (int m = 0; m < 8; ++m) {
          const int row = row0 + (m >> 2) * 128 + (m & 3) * 16;
          f32x4 lf; float kk[4];
#pragma unroll
          for (int e = 0; e < 4; ++e) {
            const float z = acc[m][nt][e];
            const float ez = __expf(-fabsf(z));
            const float ls = fminf(z, 0.f) - __logf(1.f + ez);
            const float b = l1m[e] + ls, a = la[e], mx = fmaxf(a, b);
            lf[e] = mx + __logf(1.f + __expf(-fabsf(a - b)));
            const float sneg = (z >= 0.f ? ez : 1.f) * __builtin_amdgcn_rcpf(1.f + ez);
            kk[e] = (1.f - lb[e]) * sneg;
          }
          *(f32x4*)(p.logf + (size_t)row * HW + c) = lf;
          u32x2 o = {cvtpk(kk[0], kk[1]), cvtpk(kk[2], kk[3])};
          *(u32x2*)(p.zb + (size_t)1 * S * HW + (size_t)row * HW + c) = o;
          __builtin_amdgcn_sched_barrier(0);
        }
      }
    } else if (region < 10) {
      const bool act = (region == 3 || region == 5 || region == 9), hm = (region >= 6 && region <= 8);
      bf16_t* dst = p.zb + (size_t)region * S * HW;
#pragma unroll
      for (int m = 0; m < 8; ++m)
#pragma unroll
        for (int nt = 0; nt < 4; ++nt) {
          const int row = row0 + (m >> 2) * 128 + (m & 3) * 16, c = cbase + ncol<4>(nt);
          f32x4 v = acc[m][nt];
          if (act) {
#pragma unroll
            for (int e = 0; e < 4; ++e) v[e] = siluf_(v[e]);
          }
          u32x2 o = {cvtpk(v[0], v[1]), cvtpk(v[2], v[3])};
          if (hm) *(u32x2*)(dst + ((size_t)(c >> 7) * S + row) * 128 + (c & 127)) = o;
          else *(u32x2*)(dst + (size_t)row * HW + c) = o;
          if (nt == 3) __builtin_amdgcn_sched_barrier(0);
        }
    } else {
      const int gc0 = (pn - 40) * 256 + wc * 32 + 4 * fq;
#pragma unroll
      for (int nt = 0; nt < 4; ++nt) {
        const int c = gc0 + ncol<4>(nt);
        const f32x4 bg = *(const f32x4*)(p.b_gate + (size_t)l * 6144 + c);
#pragma unroll
        for (int m = 0; m < 8; ++m) {
          const int row = row0 + (m >> 2) * 128 + (m & 3) * 16;
          f32x4 v = acc[m][nt];
#pragma unroll
          for (int e = 0; e < 4; ++e) v[e] = sigmoidf_(v[e] + bg[e]);
          u32x2 o = {cvtpk(v[0], v[1]), cvtpk(v[2], v[3])};
          *(u32x2*)(p.gates + (size_t)row * 6144 + c) = o;
          if ((m & 3) == 3) __builtin_amdgcn_sched_barrier(0);
        }
      }
    }
  }
}

__device__ __forceinline__ int swz128(int row, int col_elem) {
  return row * 128 + ((((col_elem >> 3) ^ (row & 7))) << 4) + (col_elem & 7) * 2;
}
__device__ __forceinline__ int swz256(int row, int col_elem) {
  return row * 256 + ((((col_elem >> 3) ^ (row & 7))) << 4) + (col_elem & 7) * 2;
}

__device__ __forceinline__ void hg_local(const P& p, int unit, char* lds) {
  const int hh = unit >> 7, n = unit & 127, tok0 = n * 64, colh = hh * 128;
  const int tid = otid(), lane = tid & 63, wid = tid >> 6, fr = lane & 15, fq = lane >> 4;
  float* cum = (float*)lds;
  char* qe = lds + 32768; char* ke = lds + 49152; char* kdT = lds + 65536; char* iT = lds + 81920; char* sc = lds + 98304;
  const bf16_t* hq = p.zb; const bf16_t* hk = p.zb + (size_t)1 * S * HW; const bf16_t* hi = p.zb + (size_t)2 * S * HW;
#pragma unroll
  for (int i = 0; i < 4; ++i) { const int id = tid + NTHREADS * i, t = id >> 5, c4 = (id & 31) * 4;
    *(f32x4*)(cum + t * 128 + c4) = *(const f32x4*)(p.logf + (size_t)(tok0 + t) * HW + colh + c4); }
  u32x4 q8a[2], k8a[2], i8a[2];
#pragma unroll
  for (int i = 0; i < 2; ++i) {
    const int id = tid + NTHREADS * i, t = id >> 4, k0 = (id & 15) * 8;
    const size_t gofs = (size_t)(tok0 + t) * HW + colh + k0;
    q8a[i] = *(const u32x4*)(hq + gofs); k8a[i] = *(const u32x4*)(hk + gofs); i8a[i] = *(const u32x4*)(hi + gofs);
  }
  __syncthreads();
  {
    const int k = tid & 127, part = tid >> 7;
    float run = 0.f;
    for (int t = 16 * part; t < 16 * part + 16; ++t) { run += cum[t * 128 + k]; cum[t * 128 + k] = run; }
    __syncthreads();
    float off = 0.f;
    for (int pp = 0; pp < part; ++pp) off += cum[(16 * pp + 15) * 128 + k];
    __syncthreads();
    if (part) for (int t = 16 * part; t < 16 * part + 16; ++t) cum[t * 128 + k] += off;
  }
  __syncthreads();
#pragma unroll
  for (int i = 0; i < 2; ++i) {
    const int id = tid + NTHREADS * i, t = id >> 4, k0 = (id & 15) * 8;
    const size_t gofs = (size_t)(tok0 + t) * HW + colh + k0;
    const u32x4 q8 = q8a[i], k8 = k8a[i], i8 = i8a[i];
    float qv[8], kv[8], iv[8], c8[8], r8[8], l8[8];
#pragma unroll
    for (int j = 0; j < 4; ++j) { qv[2 * j] = bflo(q8[j]); qv[2 * j + 1] = bfhi(q8[j]); kv[2 * j] = bflo(k8[j]); kv[2 * j + 1] = bfhi(k8[j]); iv[2 * j] = bflo(i8[j]); iv[2 * j + 1] = bfhi(i8[j]); }
#pragma unroll
    for (int j = 0; j < 8; ++j) { c8[j] = cum[t * 128 + k0 + j]; r8[j] = cum[31 * 128 + k0 + j]; l8[j] = cum[63 * 128 + k0 + j]; }
    float qe8[8], ke8[8], qd8[8];
#pragma unroll
    for (int j = 0; j < 8; ++j) {
      qe8[j] = qv[j] * __expf(c8[j] - r8[j]);
      ke8[j] = kv[j] * __expf(r8[j] - c8[j]);
      qd8[j] = qv[j] * __expf(c8[j]);
      const float kd = kv[j] * __expf(l8[j] - c8[j]);
      *(bf16_t*)(kdT + swz128(k0 + j, t)) = f2bf(kd);
      *(bf16_t*)(iT + swz128(k0 + j, t)) = (bf16_t)((j & 1) ? (i8[j >> 1] >> 16) : (i8[j >> 1] & 0xffffu));
    }
    *(bf16x8*)(qe + swz256(t, k0)) = pack8f(qe8);
    *(bf16x8*)(ke + swz256(t, k0)) = pack8f(ke8);
    *(bf16x8*)(p.qd + gofs) = pack8f(qd8);
  }
  if (tid < 128) p.elast[(size_t)(hh * 128 + n) * 128 + tid] = __expf(cum[63 * 128 + tid]);
  __syncthreads();
  {
    const int tt = wid >> 1;
#pragma unroll
    for (int e = 0; e < 2; ++e) {
      const int st = (wid & 1) * 2 + e;
      f32x4 a = {0.f, 0.f, 0.f, 0.f};
      if (st <= tt) {
#pragma unroll
        for (int kk = 0; kk < 4; ++kk) {
          const bf16x8 X = *(const bf16x8*)(ke + swz256(st * 16 + fr, kk * 32 + fq * 8));
          const bf16x8 Y = *(const bf16x8*)(qe + swz256(tt * 16 + fr, kk * 32 + fq * 8));
          a = mfma16(X, Y, a);
        }
      }
      const int t = tt * 16 + fr, s0 = st * 16 + 4 * fq;
#pragma unroll
      for (int r = 0; r < 4; ++r) if (s0 + r > t) a[r] = 0.f;
      u32x2 o = {cvtpk(a[0], a[1]), cvtpk(a[2], a[3])};
      *(u32x2*)(sc + swz128(t, s0)) = o;
    }
  }
  __syncthreads();
  {
    const int tt = wid & 3;
#pragma unroll
    for (int e = 0; e < 4; ++e) {
      const int vt = (wid >> 2) * 4 + e;
      f32x4 a = {0.f, 0.f, 0.f, 0.f};
#pragma unroll
      for (int kk = 0; kk < 2; ++kk) {
        const bf16x8 X = *(const bf16x8*)(iT + swz128(vt * 16 + fr, kk * 32 + fq * 8));
        const bf16x8 Y = *(const bf16x8*)(sc + swz128(tt * 16 + fr, kk * 32 + fq * 8));
        a = mfma16(X, Y, a);
      }
      *(f32x4*)(p.oin + (size_t)(tok0 + tt * 16 + fr) * HW + colh + vt * 16 + 4 * fq) = a;
    }
  }
  {
    const int vt = wid;
#pragma unroll
    for (int kt = 0; kt < 8; ++kt) {
      f32x4 a = {0.f, 0.f, 0.f, 0.f};
#pragma unroll
      for (int kk = 0; kk < 2; ++kk) {
        const bf16x8 X = *(const bf16x8*)(kdT + swz128(kt * 16 + fr, kk * 32 + fq * 8));
        const bf16x8 Y = *(const bf16x8*)(iT + swz128(vt * 16 + fr, kk * 32 + fq * 8));
        a = mfma16(X, Y, a);
      }
      { u32x2 o = {cvtpk(a[0], a[1]), cvtpk(a[2], a[3])}; *(u32x2*)((bf16_t*)p.SlocT + ((size_t)(hh * 128 + n) * 128 + vt * 16 + fr) * 128 + kt * 16 + 4 * fq) = o; }
    }
  }
  __syncthreads();
}

__device__ __forceinline__ void s5_local(const P& p, int l, int unit, char* lds) {
  const int g = unit >> 1, half = unit & 1;
  const int tid = otid(), lane = tid & 63, wid = tid >> 6, fr = lane & 15, fq = lane >> 4;
  const int cb = half * 8 + wid, n = 16 * cb + fr;
  const bf16_t* su = p.zb + (size_t)4 * S * HW;
  const bf16_t* M1 = p.M1 + (size_t)(l * 64 + g) * 128 * 512;
#pragma unroll 4
  for (int i = 0; i < 16; ++i) {
    const int idx = tid + NTHREADS * i, row = idx >> 6, ch = idx & 63;
    *(u32x4*)(lds + row * 1024 + ((ch ^ (row & 15)) << 4)) = *(const u32x4*)(M1 + row * 512 + ch * 8);
  }
  bf16x8 Y[16];
#pragma unroll
  for (int kk = 0; kk < 16; ++kk) Y[kk] = *(const bf16x8*)(su + (size_t)(n * SL + 2 * kk + (fq >> 1)) * HW + g * 16 + (fq & 1) * 8);
  __syncthreads();
  f32x4 acc[8];
#pragma unroll
  for (int i = 0; i < 8; ++i) acc[i] = (f32x4){0.f, 0.f, 0.f, 0.f};
#pragma unroll
  for (int kk = 0; kk < 16; ++kk) {
#pragma unroll
    for (int pt = 0; pt < 8; ++pt) {
      const bf16x8 X = *(const bf16x8*)(lds + (pt * 16 + fr) * 1024 + (((kk * 4 + fq) ^ fr) << 4));
      acc[pt] = mfma16(X, Y[kk], acc[pt]);
    }
    if ((kk & 1) == 1) __builtin_amdgcn_sched_barrier(0);
  }
#pragma unroll
  for (int pt = 0; pt < 8; ++pt) *(f32x4*)(p.Xloc + ((size_t)g * NCH + n) * 128 + pt * 16 + 4 * fq) = acc[pt];
  __syncthreads();
}

__device__ __forceinline__ void fox_cumsum(const P& p, int hh, char* lds) {
  float* wt = (float*)lds;
  const int tid = otid(), lane = tid & 63, wid = tid >> 6;
  float v[16];
  float run = 0.f;
#pragma unroll
  for (int j = 0; j < 16; ++j) { run += p.lsf[(tid * 16 + j) * 8 + hh]; v[j] = run; }
  float inc = run;
#pragma unroll
  for (int o = 1; o < 64; o <<= 1) { const float t = __shfl_up(inc, o); if (lane >= o) inc += t; }
  if (lane == 63) wt[wid] = inc;
  __syncthreads();
  float base = inc - run;
  for (int w = 0; w < wid; ++w) base += wt[w];
#pragma unroll
  for (int j = 0; j < 16; ++j) p.cc[hh * S + tid * 16 + j] = base + v[j];
  __syncthreads();
}

__device__ __forceinline__ void phase_local(const P& p, int l, char* lds) {
  constexpr int NU = 1024 + 128 + 8;
  for (int u = obid(); u < NU; u += ogdim()) {
    if (u < 1024) hg_local(p, u, lds);
    else if (u < 1152) { const int j = u - 1024; s5_local(p, l, ((j & 7) << 4) | (j >> 3), lds); }
    else fox_cumsum(p, u - 1152, lds);
  }
}

__device__ __forceinline__ void phase_scan(const P& p, int l) {
  constexpr int NU = 128 + 8;
  const int tid = otid();
  for (int u = obid(); u < NU; u += ogdim()) {
    if (u < 128) {
      const int e2 = u * NTHREADS + tid, hh = e2 >> 13, rem = e2 & 8191, v = rem >> 6, k = (rem & 63) * 2;
      float s0 = 0.f, s1 = 0.f;
#pragma unroll 16
      for (int n = 0; n < 128; ++n) {
        const size_t idx = ((size_t)(hh * 128 + n) * 128 + v) * 128 + k;
        const unsigned lu = *(const unsigned*)((const bf16_t*)p.SlocT + idx); const f32x2 loc = {bflo(lu), bfhi(lu)};
        const f32x2 el = *(const f32x2*)(p.elast + (size_t)(hh * 128 + n) * 128 + k);
        *(unsigned*)(p.SprevT + idx) = cvtpk(s0, s1);
        s0 = el[0] * s0 + loc[0]; s1 = el[1] * s1 + loc[1];
      }
    } else {
      const int gid = (u - 128) * NTHREADS + tid, g = gid >> 6, pp = gid & 63;
      const float ar = p.AL[((l * 64 + g) * 64 + pp) * 2], ai = p.AL[((l * 64 + g) * 64 + pp) * 2 + 1];
      float sr = 0.f, si = 0.f;
#pragma unroll 16
      for (int n = 0; n < NCH; ++n) {
        const size_t idx = ((size_t)g * NCH + n) * 128 + pp;
        const float xr = p.Xloc[idx], xi = p.Xloc[idx + 64];
        p.Xprev[idx] = f2bf(sr); p.Xprev[idx + 64] = f2bf(si);
        const float nr = ar * sr - ai * si + xr, ni = ar * si + ai * sr + xi;
        sr = nr; si = ni;
      }
    }
  }
}

__device__ __forceinline__ void hg_out(const P& p, int l, int bu) {
  const int hh = bu >> 6, np = bu & 63;
  const int tid = otid(), lane = tid & 63, wid = tid >> 6, fr = lane & 15, fq = lane >> 4;
  const int n = np * 2 + (wid >> 2), tt = wid & 3, colh = hh * 128;
  const int token = n * 64 + tt * 16 + fr;
  const bf16_t* sp = p.SprevT + (size_t)(hh * 128 + n) * 128 * 128;
  f32x4 acc[8];
  u32x2 gtv[8];
  const bf16_t* sg = p.zb + (size_t)3 * S * HW;
#pragma unroll
  for (int i = 0; i < 8; ++i) {
    acc[i] = *(const f32x4*)(p.oin + (size_t)token * HW + colh + i * 16 + 4 * fq);
    gtv[i] = *(const u32x2*)(sg + (size_t)token * HW + colh + i * 16 + 4 * fq);
  }
#pragma unroll
  for (int kk = 0; kk < 4; ++kk) {
    const bf16x8 Y = *(const bf16x8*)(p.qd + (size_t)token * HW + colh + kk * 32 + fq * 8);
#pragma unroll
    for (int vt = 0; vt < 8; ++vt) {
      const bf16x8 X = *(const bf16x8*)(sp + (size_t)(vt * 16 + fr) * 128 + kk * 32 + fq * 8);
      acc[vt] = mfma16(X, Y, acc[vt]);
    }
  }
  float ss = 0.f;
#pragma unroll
  for (int vt = 0; vt < 8; ++vt) {
    ss += acc[vt][0] * acc[vt][0] + acc[vt][1] * acc[vt][1] + acc[vt][2] * acc[vt][2] + acc[vt][3] * acc[vt][3];
  }
  ss += __shfl_xor(ss, 16);
  ss += __shfl_xor(ss, 32);
  const float rstd = rsqrtf(ss * (1.f / 128.f) + EPS);
#pragma unroll
  for (int vt = 0; vt < 8; ++vt) {
    const int c = colh + vt * 16 + 4 * fq;
    const f32x4 gn = *(const f32x4*)(p.hg_norm_g + l * HW + c);
    const u32x2 gt = gtv[vt];
    const float o0 = acc[vt][0] * rstd * gn[0] * bflo(gt[0]), o1 = acc[vt][1] * rstd * gn[1] * bfhi(gt[0]);
    const float o2 = acc[vt][2] * rstd * gn[2] * bflo(gt[1]), o3 = acc[vt][3] * rstd * gn[3] * bfhi(gt[1]);
    u32x2 o = {cvtpk(o0, o1), cvtpk(o2, o3)};
    *(u32x2*)(p.oa + (size_t)token * HW + c) = o;
  }
}

__device__ __forceinline__ void s5_out(const P& p, int l, int unit, char* lds) {
  const int g = unit >> 1, half = unit & 1;
  const int tid = otid(), lane = tid & 63, wid = tid >> 6, fr = lane & 15, fq = lane >> 4;
  const int cb = half * 8 + wid, n = 16 * cb + fr;
  const bf16_t* su = p.zb + (size_t)4 * S * HW;
  const bf16_t* M2 = p.M2 + (size_t)(l * 64 + g) * 512 * 128;
  {
    const u32x4* src = (const u32x4*)(p.Ktab + (size_t)(l * 64 + g) * 32 * 256);
    u32x4* dst = (u32x4*)(lds + 512);
    dst[tid] = src[tid]; dst[tid + 512] = src[tid + 512];
    if (tid < 32) { unsigned z = 0u; asm volatile("" : "+v"(z)); ((u32x4*)lds)[tid] = (u32x4){z, z, z, z}; }
#pragma unroll 4
    for (int i = 0; i < 16; ++i) {
      const int idx = tid + NTHREADS * i, row = idx >> 4, ch = idx & 15;
      *(u32x4*)(lds + 17408 + row * 256 + ((ch ^ (row & 15)) << 4)) = *(const u32x4*)(M2 + row * 128 + ch * 8);
    }
  }
  __syncthreads();
  const char* tb = lds + ((1 - (fq >> 1)) * 256 + fr * 16 + (fq & 1) * 8) * 2;
  bf16x8 U[16], Xp[4];
#pragma unroll
  for (int kk = 0; kk < 16; ++kk) U[kk] = *(const bf16x8*)(su + (n * SL + 2 * kk + (fq >> 1)) * HW + g * 16 + (fq & 1) * 8);
#pragma unroll
  for (int kk = 0; kk < 4; ++kk) Xp[kk] = *(const bf16x8*)(p.Xprev + (g * NCH + n) * 128 + kk * 32 + fq * 8);
  const f32x4 dsk = *(const f32x4*)(p.s5_d + l * HW + g * 16 + 4 * fq);
#pragma unroll
  for (int th = 0; th < 2; ++th) {
    f32x4 acc[16];
#pragma unroll
    for (int ti = 0; ti < 16; ++ti) {
      const u32x2 uu = *(const u32x2*)(su + (n * SL + 16 * th + ti) * HW + g * 16 + 4 * fq);
      acc[ti] = (f32x4){dsk[0] * bflo(uu[0]), dsk[1] * bfhi(uu[0]), dsk[2] * bflo(uu[1]), dsk[3] * bfhi(uu[1])};
    }
#pragma unroll
    for (int kk = 0; kk < 4; ++kk) {
#pragma unroll
      for (int ti = 0; ti < 16; ++ti) {
        const int t = 16 * th + ti;
        const bf16x8 X = *(const bf16x8*)(lds + 17408 + (t * 16 + fr) * 256 + (((kk * 4 + fq) ^ fr) << 4));
        acc[ti] = mfma16(X, Xp[kk], acc[ti]);
        if ((ti & 7) == 7) __builtin_amdgcn_sched_barrier(0);
      }
    }
#pragma unroll
    for (int kk = 0; kk < 8 * th + 8; ++kk) {
#pragma unroll
      for (int ti = 0; ti < 16; ++ti) {
        const int t = 16 * th + ti;
        if (t >= 2 * kk) {
          const bf16x8 X = *(const bf16x8*)(tb + (t - 2 * kk) * 512);
          acc[ti] = mfma16(X, U[kk], acc[ti]);
        }
        if ((ti & 7) == 7) __builtin_amdgcn_sched_barrier(0);
      }
    }
#pragma unroll
    for (int ti = 0; ti < 16; ++ti) {
      const int t = 16 * th + ti;
      const int o = (n * SL + t) * HW + g * 16 + 4 * fq;
      const float y0 = gelu_tanh(acc[ti][0]), y1 = gelu_tanh(acc[ti][1]);
      const float y2 = gelu_tanh(acc[ti][2]), y3 = gelu_tanh(acc[ti][3]);
      u32x2 ov = {cvtpk(y0, y1), cvtpk(y2, y3)};
      *(u32x2*)(p.yg + o) = ov;
      if ((ti & 3) == 3) __builtin_amdgcn_sched_barrier(0);
    }
  }
  __syncthreads();
}

__device__ __forceinline__ void phase_out(const P& p, int l, char* lds) {
  const int G = ogdim(), b = obid();
  if (G == 256) {
    if (b < 128) s5_out(p, l, ((b & 7) << 4) | (b >> 3), lds);
    const int u0 = b < 128 ? 384 + b : (b - 128) * 3, n = b < 128 ? 1 : 3;
#pragma unroll 1
    for (int i = 0; i < n; ++i) hg_out(p, l, u0 + i);
  } else {
#pragma unroll 1
    for (int u = b; u < 512; u += G) hg_out(p, l, u);
#pragma unroll 1
    for (int u = b; u < 128; u += G) s5_out(p, l, u, lds);
  }
}

namespace fa {
constexpr int D = 128, QBLK = 32, KVBLK = 64, QB = 256, LD = 1024, LDQ = 128;
constexpr int SHM_V = 16384, SHM_K = 16384;
constexpr int OFF_WS = 2 * SHM_V + 2 * SHM_K, OFF_BIAS = 69632;
constexpr float SCALE = 0.08838834764831845f, SQRTD = 11.313708498984761f, THR = 8.f;
constexpr unsigned WBIG = 0x40000000u;
#define KSWZ(row, colB) ((row) * 256 + ((colB) ^ (((row) & 7) << 4)))
#define SBAR() __builtin_amdgcn_sched_barrier(0)
__device__ __forceinline__ int v_st(int k, int c) { const int kk = (k & ~0xC) | ((k & 4) << 1) | ((k & 8) >> 1); return ((kk >> 3) * 4 + (c >> 5)) * 512 + ((kk & 7) * 32 + (c & 31)) * 2; }
__device__ __forceinline__ int v_rd_base(int lane) { return ((lane & 3) << 3) | (((lane >> 2) & 3) << 6) | (((lane >> 4) & 1) << 5) | (((lane >> 5) & 1) << 8); }
constexpr int v_rd_off(int d0, int ks, int half) { return d0 * 512 + ks * 4096 + half * 2048; }
__device__ __forceinline__ int crow(int r, int hi) { return (r & 3) + 8 * (r >> 2) + 4 * hi; }
__device__ __forceinline__ unsigned cvtpkv(float lo, float hi) { unsigned r; asm volatile("v_cvt_pk_bf16_f32 %0, %1, %2" : "=v"(r) : "v"(lo), "v"(hi)); return r; }

__device__ __forceinline__ void mask_tile(f32x16& p0, f32x16& p1, int dq, unsigned W) {
  const float NEG = -__builtin_inff();
#pragma unroll
  for (int r = 0; r < 16; ++r) {
    const int c = (r & 3) + 8 * (r >> 2);
    if ((unsigned)(dq - c) >= W) p0[r] = NEG;
    if ((unsigned)(dq - c - 32) >= W) p1[r] = NEG;
  }
}
__device__ __forceinline__ void partialSM(f32x16& p0, f32x16& p1, float& m_reg, float& mn, float& alpha) {
  float pmax = p0[0];
#pragma unroll
  for (int r = 1; r < 16; ++r) pmax = fmaxf(pmax, p0[r]);
#pragma unroll
  for (int r = 0; r < 16; ++r) pmax = fmaxf(pmax, p1[r]);
  { auto rr = __builtin_amdgcn_permlane32_swap(__float_as_uint(pmax), __float_as_uint(pmax), false, false);
    pmax = fmaxf(__uint_as_float(rr[0]), __uint_as_float(rr[1])); }
  constexpr float C2 = 1.4426950408889634f * SCALE;
  if (__builtin_expect(__all((pmax - m_reg) * SCALE <= THR), 1)) { mn = m_reg; alpha = 1.f; }
  else { mn = fmaxf(m_reg, pmax); alpha = __builtin_amdgcn_exp2f((m_reg - mn) * C2); m_reg = mn; }
  const float mnL = -mn * C2;
#pragma unroll
  for (int r = 0; r < 16; ++r) p0[r] = fmaf(p0[r], C2, mnL);
#pragma unroll
  for (int r = 0; r < 16; ++r) p1[r] = fmaf(p1[r], C2, mnL);
#pragma unroll
  for (int r = 0; r < 16; ++r) p0[r] = __builtin_amdgcn_exp2f(p0[r]);
}
__device__ __forceinline__ void finishSM(f32x16& p0, f32x16& p1, float alpha, float& l_reg, bf16x8& pa0, bf16x8& pa1, bf16x8& pa2, bf16x8& pa3) {
#pragma unroll
  for (int r = 0; r < 16; ++r) p1[r] = __builtin_amdgcn_exp2f(p1[r]);
  float ps = 0;
#pragma unroll
  for (int r = 0; r < 16; ++r) ps += p0[r];
#pragma unroll
  for (int r = 0; r < 16; ++r) ps += p1[r];
  { auto rr = __builtin_amdgcn_permlane32_swap(__float_as_uint(ps), __float_as_uint(ps), false, false);
    ps = __uint_as_float(rr[0]) + __uint_as_float(rr[1]); }
  l_reg = l_reg * alpha + ps;
#define PK4(Pv, B_, OUT) do { unsigned a0 = cvtpkv(Pv[B_+0], Pv[B_+1]), a1 = cvtpkv(Pv[B_+2], Pv[B_+3]); \
    unsigned b0 = cvtpkv(Pv[B_+4], Pv[B_+5]), b1 = cvtpkv(Pv[B_+6], Pv[B_+7]); \
    auto r0 = __builtin_amdgcn_permlane32_swap(a0, b0, false, false); auto r1 = __builtin_amdgcn_permlane32_swap(a1, b1, false, false); \
    u32x4 w = {r0[0], r1[0], r0[1], r1[1]}; OUT = *reinterpret_cast<bf16x8*>(&w); } while (0)
  PK4(p0, 0, pa0); PK4(p0, 8, pa1); PK4(p1, 0, pa2); PK4(p1, 8, pa3);
#undef PK4
}
template <int KB>
__device__ __forceinline__ void qkt(f32x16& p0, f32x16& p1, const char* lds, int r32, int hi, const bf16x8* qr) {
  const char* K_lds = lds + 2 * SHM_V;
  p0 = f32x16{}; p1 = f32x16{};
  const char* kb[4];
#pragma unroll
  for (int dd = 0; dd < 4; ++dd) kb[dd] = K_lds + KB * SHM_K + KSWZ(r32, (dd * 16 + hi * 8) * 2);
#pragma unroll
  for (int d0 = 0; d0 < 8; ++d0) { const char* a = kb[d0 & 3] + (d0 >> 2) * 128;
    bf16x8 b0 = *reinterpret_cast<const bf16x8*>(a);
    bf16x8 b1 = *reinterpret_cast<const bf16x8*>(a + 32 * 256);
    p0 = __builtin_amdgcn_mfma_f32_32x32x16_bf16(b0, qr[d0], p0, 0, 0, 0);
    p1 = __builtin_amdgcn_mfma_f32_32x32x16_bf16(b1, qr[d0], p1, 0, 0, 0); }
}
__device__ __forceinline__ void add_bias(f32x16& p0, f32x16& p1, const char* lds, int hi, int kbase) {
  const float* bb = (const float*)(lds + OFF_BIAS) + kbase + 4 * hi;
#pragma unroll
  for (int j = 0; j < 4; ++j) {
    const f32x4 t0 = *(const f32x4*)(bb + 8 * j), t1 = *(const f32x4*)(bb + 32 + 8 * j);
    p0[4 * j] += t0[0]; p0[4 * j + 1] += t0[1]; p0[4 * j + 2] += t0[2]; p0[4 * j + 3] += t0[3];
    p1[4 * j] += t1[0]; p1[4 * j + 1] += t1[1]; p1[4 * j + 2] += t1[2]; p1[4 * j + 3] += t1[3];
  }
}
template <int VB>
__device__ __forceinline__ void pv_tile(f32x16* o, int vb0, bf16x8 pa0, bf16x8 pa1, bf16x8 pa2, bf16x8 pa3) {
#define TRRD(dst, off) asm volatile("ds_read_b64_tr_b16 %0, %1 offset:%2" : "=&v"(dst) : "v"(vb0), "i"(off) : "memory")
#define PV_D0(d0) do { s16x4 l0, l1, l2, l3, h0, h1, h2, h3; constexpr int b_ = VB * SHM_V + v_rd_off(d0, 0, 0); \
    TRRD(l0, b_); TRRD(h0, b_ + 2048); TRRD(l1, b_ + 4096); TRRD(h1, b_ + 6144); TRRD(l2, b_ + 8192); TRRD(h2, b_ + 10240); TRRD(l3, b_ + 12288); TRRD(h3, b_ + 14336); \
    asm volatile("s_waitcnt lgkmcnt(0)" ::: "memory"); SBAR(); \
    o[d0] = __builtin_amdgcn_mfma_f32_32x32x16_bf16(pa0, (bf16x8){l0[0], l0[1], l0[2], l0[3], h0[0], h0[1], h0[2], h0[3]}, o[d0], 0, 0, 0); \
    o[d0] = __builtin_amdgcn_mfma_f32_32x32x16_bf16(pa1, (bf16x8){l1[0], l1[1], l1[2], l1[3], h1[0], h1[1], h1[2], h1[3]}, o[d0], 0, 0, 0); \
    o[d0] = __builtin_amdgcn_mfma_f32_32x32x16_bf16(pa2, (bf16x8){l2[0], l2[1], l2[2], l2[3], h2[0], h2[1], h2[2], h2[3]}, o[d0], 0, 0, 0); \
    o[d0] = __builtin_amdgcn_mfma_f32_32x32x16_bf16(pa3, (bf16x8){l3[0], l3[1], l3[2], l3[3], h3[0], h3[1], h3[2], h3[3]}, o[d0], 0, 0, 0); } while (0)
  PV_D0(0); PV_D0(1); PV_D0(2); PV_D0(3);
#undef PV_D0
#undef TRRD
}

struct BlockRef { const bf16_t* Q; const bf16_t* K; const bf16_t* V; const bf16_t* G; bf16_t* O; const float* C; int P0; };
struct Seam { bf16x8 qr[8]; bf16x8 st_v0, st_v1, st_k0, st_k1; };

#define ROWP(pp, k0, rr) ((pp) + (size_t)((k0) + (rr)) * LDQ + sc)
#define VMW() asm volatile("s_waitcnt vmcnt(0)" ::: "memory")
#define VMWN(n) asm volatile("s_waitcnt vmcnt(%0)" :: "i"(n) : "memory")
#define LD8(ptr) (*reinterpret_cast<const bf16x8*>(ptr))
#define SLOAD_H(ref, k0) do { S.st_v0 = LD8(ROWP((ref).V, k0, sr)); S.st_v1 = LD8(ROWP((ref).V, k0, 32 + sr)); \
    S.st_k0 = LD8(ROWP((ref).K, k0, sr)); S.st_k1 = LD8(ROWP((ref).K, k0, 32 + sr)); } while (0)
#define SWRITE_HK(bf) do { *(bf16x8*)(K_lds + (bf) * SHM_K + kws) = S.st_k0; *(bf16x8*)(K_lds + (bf) * SHM_K + kws + 32 * 256) = S.st_k1; } while (0)
#define SWRITE_HV(bf) do { *(bf16x8*)(V_lds + (bf) * SHM_V + vst0) = S.st_v0; *(bf16x8*)(V_lds + (bf) * SHM_V + vst1) = S.st_v1; } while (0)
#define SWRITE_H(bf) do { SWRITE_HV(bf); SWRITE_HK(bf); } while (0)

__device__ __forceinline__ void prime(const BlockRef& cur, int j_lo, int j_hi, char* lds, Seam& S) {
  const int tid = otid(), wid = __builtin_amdgcn_readfirstlane(tid >> 6), lane = tid & 63, r32 = lane & 31, hi = lane >> 5;
  const int sr = tid >> 4, sc = (tid & 15) * 8, kws = KSWZ(sr, sc * 2); char* K_lds = lds + 2 * SHM_V;
  const float cref = cur.C[cur.P0 + QB - 1];
#pragma unroll
  for (int d0 = 0; d0 < 8; ++d0) S.qr[d0] = LD8(cur.Q + (size_t)(wid * QBLK + r32) * LDQ + d0 * 16 + hi * 8);
  SLOAD_H(cur, j_lo * KVBLK);
  { float* ct = (float*)(lds + OFF_BIAS); const int k1 = j_hi * KVBLK;
#pragma unroll 4
    for (int i = j_lo * KVBLK + tid; i < k1; i += NTHREADS) ct[i] = (cref - cur.C[i]) * SQRTD; }
  VMW(); SWRITE_HK(0);
  __syncthreads();
}

__device__ __forceinline__ void block(const BlockRef& cur, int j_lo, int j_hi, float* opart, float* mlpart, char* lds, Seam& S) {
  const int tid = otid(), wid = __builtin_amdgcn_readfirstlane(tid >> 6), lane = tid & 63, r32 = lane & 31, hi = lane >> 5;
  const int NT = j_hi - j_lo;
  const int qlo = cur.P0 + wid * QBLK, qm = qlo + r32 - 4 * hi;
  char* V_lds = lds; char* K_lds = lds + 2 * SHM_V;
  float* ws = (float*)(lds + OFF_WS) + wid * 64; float* li_l = ws, * al_l = ws + 32;
  float m_reg = -1e30f, l_reg = 0; f32x16 o[4] = {};
  const int sr = tid >> 4, sc = (tid & 15) * 8, vst0 = v_st(sr, sc), vst1 = v_st(32 + sr, sc), kws = KSWZ(sr, sc * 2);
  const int vb0 = (int)(uintptr_t)V_lds + v_rd_base(lane);
#define RESC(a) do { if (__any((a) < 1.f)) { if (hi == 0) al_l[r32] = (a); asm volatile("s_waitcnt lgkmcnt(0)" ::: "memory"); \
    for (int d_ = 0; d_ < 4; ++d_) for (int r = 0; r < 16; ++r) o[d_][r] *= al_l[crow(r, hi)]; } } while (0)
#define KBASE(t) ((j_lo + (t)) * KVBLK)
#define MASKT(P0_, P1_, t) do { const int kb_ = KBASE(t); if (kb_ + KVBLK - 1 > qlo) mask_tile(P0_, P1_, qm - kb_, WBIG); } while (0)
  constexpr int NQL = 8;
#define SEAM_K0() do { VMWN(NQL); SWRITE_HK(0); SBAR(); } while (0)
  f32x16 pA0, pA1, pB0, pB1; float mnA, mnB, alA, alB; bf16x8 pa0, pa1, pa2, pa3;
  SWRITE_HV(0); SBAR();
  if (NT > 1) { SLOAD_H(cur, KBASE(1)); }
  SBAR(); qkt<0>(pA0, pA1, lds, r32, hi, S.qr);
  add_bias(pA0, pA1, lds, hi, KBASE(0)); MASKT(pA0, pA1, 0); partialSM(pA0, pA1, m_reg, mnA, alA);
  if (NT > 1) { VMW(); SWRITE_H(1); }
  __syncthreads();
#define HALF_STEP(PX0, PX1, mnX, alX, PY0, PY1, alY, t, KB, VB, SB) do { \
    SBAR(); qkt<KB>(PX0, PX1, lds, r32, hi, S.qr); \
    finishSM(PY0, PY1, alY, l_reg, pa0, pa1, pa2, pa3); SBAR(); \
    if ((t) + 1 < NT) { SLOAD_H(cur, KBASE((t) + 1)); SBAR(); } \
    pv_tile<VB>(o, vb0, pa0, pa1, pa2, pa3); add_bias(PX0, PX1, lds, hi, KBASE(t)); MASKT(PX0, PX1, (t)); partialSM(PX0, PX1, m_reg, mnX, alX); \
    __syncthreads(); \
    if ((t) + 1 < NT) { VMW(); SWRITE_H(SB); } \
    RESC(alX); __syncthreads(); } while (0)
  for (int t = 1; t + 1 < NT; t += 2) {
    HALF_STEP(pB0, pB1, mnB, alB, pA0, pA1, alA, t, 1, 0, 0);
    HALF_STEP(pA0, pA1, mnA, alA, pB0, pB1, alB, t + 1, 0, 1, 1);
  }
  const bool even = (NT & 1) == 0;
  if (even) { SBAR(); qkt<1>(pB0, pB1, lds, r32, hi, S.qr); SBAR(); }
  finishSM(pA0, pA1, alA, l_reg, pa0, pa1, pa2, pa3); SBAR();
  pv_tile<0>(o, vb0, pa0, pa1, pa2, pa3);
  if (even) { add_bias(pB0, pB1, lds, hi, KBASE(NT - 1)); MASKT(pB0, pB1, NT - 1); partialSM(pB0, pB1, m_reg, mnB, alB); __syncthreads(); RESC(alB);
    finishSM(pB0, pB1, alB, l_reg, pa0, pa1, pa2, pa3); SBAR(); pv_tile<1>(o, vb0, pa0, pa1, pa2, pa3); }
  SBAR();
  if (opart) {
    if (hi == 0) { mlpart[wid * QBLK + r32] = m_reg; mlpart[256 + wid * QBLK + r32] = l_reg; }
    float* Ow = opart + wid * QBLK * 128;
#pragma unroll
    for (int r = 0; r < 16; ++r) { const int orow = crow(r, hi);
#pragma unroll
      for (int d0 = 0; d0 < 4; ++d0) Ow[orow * 128 + d0 * 32 + r32] = o[d0][r]; }
  } else {
    if (hi == 0) li_l[r32] = l_reg; asm volatile("s_waitcnt lgkmcnt(0)" ::: "memory");
    float rli[16];
#pragma unroll
    for (int r = 0; r < 16; ++r) rli[r] = __builtin_amdgcn_rcpf(li_l[crow(r, hi)]);
    bf16_t* Ow = cur.O + wid * QBLK * LD;
#pragma unroll
    for (int r = 0; r < 16; ++r) { const int orow = crow(r, hi);
#pragma unroll
      for (int d0 = 0; d0 < 4; ++d0) { const float v = o[d0][r] * rli[r];
        const float vn = __shfl_xor(v, 1);
        if ((r32 & 1) == 0) *(unsigned*)(Ow + orow * LD + d0 * 32 + r32) = cvtpkv(v, vn); }
    }
  }
  __syncthreads();
#undef RESC
#undef KBASE
#undef MASKT
#undef SEAM_K0
#undef HALF_STEP
}
#undef ROWP
#undef VMW
#undef VMWN
#undef SLOAD_H
#undef SWRITE_HK
#undef SWRITE_HV
#undef SWRITE_H

__device__ __forceinline__ BlockRef mkref(const P& p, int hh, int qb) {
  BlockRef r; const size_t ho = (size_t)hh * 128, ro = (size_t)qb * QB * LD, hm = (size_t)hh * S * 128;
  r.Q = p.zb + (size_t)6 * S * HW + hm + (size_t)qb * QB * 128; r.K = p.zb + (size_t)7 * S * HW + hm; r.V = p.zb + (size_t)8 * S * HW + hm;
  r.G = p.zb + (size_t)9 * S * HW + ro + ho; r.O = p.oc + ro + ho; r.C = p.cc + (size_t)hh * S; r.P0 = qb * QB;
  return r;
}
__device__ __forceinline__ void pair_work(const P& p, int l, int w, char* lds) {
  const int tid = otid();
  const int hh = w & 7, role = (w >> 3) & 1, x = w >> 4, pi = x * 8 + hh;
  float* opart = p.opart + (size_t)(pi * 2 + role) * 32768; float* mlpart = p.mlpart + (size_t)(pi * 2 + role) * 512;
#pragma unroll 1
  for (int k = 0; k <= role; ++k) {
    const BlockRef b0 = mkref(p, hh, k ? x : 31 - x);
    const int split = x <= 13 ? 68 : 66;
    const int j_lo = (k == 0 && role) ? split : 0;
    const int j_hi = k ? 4 * (x + 1) : (role ? 4 * (32 - x) : split);
    Seam S;
    prime(b0, j_lo, j_hi, lds, S);
    block(b0, j_lo, j_hi, k ? nullptr : opart, mlpart, lds, S);
    if (k) {
      asm volatile("s_waitcnt vmcnt(0)" ::: "memory"); __syncthreads();
      if (tid == 0) { __builtin_amdgcn_fence(__ATOMIC_ACQUIRE, "agent"); asm volatile("s_waitcnt vmcnt(0)" ::: "memory"); }
      __syncthreads();
#pragma unroll 2
      for (int i = 0; i < 8; ++i) {
        const int id = tid + NTHREADS * i, row = id >> 4, ch = id & 15;
        bf16_t* op = b0.O + row * LD + ch * 8;
        const u32x4 ov = *(const u32x4*)op, gv = *(const u32x4*)(b0.G + row * LD + ch * 8);
        u32x4 r;
#pragma unroll
        for (int j = 0; j < 4; ++j) r[j] = cvtpk(bflo(ov[j]) * bflo(gv[j]), bfhi(ov[j]) * bfhi(gv[j]));
        *(u32x4*)op = r;
      }
      __syncthreads();
    }
  }
  asm volatile("s_waitcnt vmcnt(0)" ::: "memory"); __syncthreads();
  unsigned* flag = (unsigned*)(lds + OFF_WS);
  if (tid == 0) {
    __builtin_amdgcn_fence(__ATOMIC_RELEASE, "agent"); asm volatile("s_waitcnt vmcnt(0)" ::: "memory");
    const unsigned o_ = __hip_atomic_fetch_add(p.bar + XCD_BAR_WORDS + l * 128 + pi, 1u, __ATOMIC_RELAXED, __HIP_MEMORY_SCOPE_AGENT);
    if (o_ == 1u) { __builtin_amdgcn_fence(__ATOMIC_ACQUIRE, "agent"); asm volatile("s_waitcnt vmcnt(0)" ::: "memory"); }
    *flag = o_;
  }
  __syncthreads();
  const unsigned old = *flag;
  __syncthreads();
  if (old == 1u) {
    const BlockRef hv = mkref(p, hh, 31 - x);
    const float* oA = p.opart + (size_t)(pi * 2) * 32768; const float* oB = oA + 32768;
    const float* mA = p.mlpart + (size_t)(pi * 2) * 512; const float* mB = mA + 512;
    const int row = tid >> 1, c0 = (tid & 1) * 64;
    constexpr float C2 = 1.4426950408889634f * SCALE;
    const float ma = mA[row], la = mA[256 + row], mb = mB[row], lb = mB[256 + row];
    const float M = fmaxf(ma, mb), wa = __builtin_amdgcn_exp2f((ma - M) * C2), wb = __builtin_amdgcn_exp2f((mb - M) * C2);
    const float inv = 1.f / (la * wa + lb * wb);
#pragma unroll 4
    for (int j = 0; j < 16; ++j) {
      const f32x4 a = *(const f32x4*)(oA + row * 128 + c0 + 4 * j), b = *(const f32x4*)(oB + row * 128 + c0 + 4 * j);
      const u32x2 g = *(const u32x2*)(hv.G + row * LD + c0 + 4 * j);
      const float v0 = (a[0] * wa + b[0] * wb) * inv * bflo(g[0]), v1 = (a[1] * wa + b[1] * wb) * inv * bfhi(g[0]);
      const float v2 = (a[2] * wa + b[2] * wb) * inv * bflo(g[1]), v3 = (a[3] * wa + b[3] * wb) * inv * bfhi(g[1]);
      u32x2 ov = {cvtpk(v0, v1), cvtpk(v2, v3)};
      *(u32x2*)(hv.O + row * LD + c0 + 4 * j) = ov;
    }
  }
  __syncthreads();
}
}

__device__ __forceinline__ void glu_tile(const P& p, int l, int t, char* lds) {
  const int tid = otid(), lane = tid & 63, wid = tid >> 6, wr = wid >> 2, wc = wid & 3, fr = lane & 15, fq = lane >> 4;
  const int pm = t & 31, pn = t >> 5;
  f32x4 acc[8][4];
  zero_acc<4>(acc);
  gemm8_main(acc, p.yg + (size_t)pm * 256 * HW, p.WgluT + ((size_t)l * 2048 + (size_t)pn * 256) * HW, HW, lds);
  const bf16_t* sg = p.zb + (size_t)5 * S * HW;
#pragma unroll
  for (int m = 0; m < 8; ++m)
#pragma unroll
    for (int nt = 0; nt < 2; ++nt) {
      const int row = pm * 256 + (m >> 2) * 128 + wr * 64 + (m & 3) * 16 + fr, c = pn * 128 + wc * 32 + nt * 16 + 4 * fq;
      const u32x2 gt = *(const u32x2*)(sg + (size_t)row * HW + c);
      const f32x4 v = acc[m][nt], gg = acc[m][nt + 2];
      const float o0 = v[0] * sigmoidf_(gg[0]) * bflo(gt[0]), o1 = v[1] * sigmoidf_(gg[1]) * bfhi(gt[0]);
      const float o2 = v[2] * sigmoidf_(gg[2]) * bflo(gt[1]), o3 = v[3] * sigmoidf_(gg[3]) * bfhi(gt[1]);
      u32x2 o = {cvtpk(o0, o1), cvtpk(o2, o3)};
      *(u32x2*)(p.ob + (size_t)row * HW + c) = o;
      if (nt == 1) __builtin_amdgcn_sched_barrier(0);
    }
}
__device__ __forceinline__ void phase_attn_glu(const P& p, int l, char* lds) {
  const int G = ogdim(), b = obid();
#pragma unroll 1
  for (int w = b; w < 256; w += G) fa::pair_work(p, l, w, lds);
#pragma unroll 1
  for (int t = b; t < 256; t += G) glu_tile(p, l, t, lds);
}

__device__ __forceinline__ void phase_merge(const P& p, int l, char* lds) {
  const int tid = otid(), lane = tid & 63, wid = tid >> 6, wr = wid >> 2, wc = wid & 3, fr = lane & 15, fq = lane >> 4;
  for (int t = obid(); t < 32 * 16; t += ogdim()) {
    const int pm = t & 31, pn = t >> 5;
    f32x4 macc[8][2];
    zero_acc<2>(macc);
#pragma unroll 1
    for (int br = 0; br < 3; ++br) {
      const bf16_t* A = (br == 0 ? p.oa : br == 1 ? p.ob : p.oc) + (size_t)pm * 256 * HW;
      f32x4 acc[8][2];
      zero_acc<2>(acc);
      u32x2 gtv[8][2];
#pragma unroll
      for (int m = 0; m < 8; ++m)
#pragma unroll
        for (int nt = 0; nt < 2; ++nt) {
          const int row = pm * 256 + wr * 128 + m * 16 + fr, c = pn * 128 + wc * 32 + nt * 16 + 4 * fq;
          gtv[m][nt] = *(const u32x2*)(p.gates + (size_t)row * 6144 + br * DM + c);
        }
      gemm_main<2>(acc, A, HW, p.WbrT + ((size_t)(l * 3 + br) * DM + (size_t)pn * 128) * HW, HW, HW, lds);
#pragma unroll
      for (int m = 0; m < 8; ++m)
#pragma unroll
        for (int nt = 0; nt < 2; ++nt) {
          const u32x2 gt = gtv[m][nt];
          macc[m][nt][0] += bflo(gt[0]) * acc[m][nt][0]; macc[m][nt][1] += bfhi(gt[0]) * acc[m][nt][1];
          macc[m][nt][2] += bflo(gt[1]) * acc[m][nt][2]; macc[m][nt][3] += bfhi(gt[1]) * acc[m][nt][3];
        }
    }
#pragma unroll
    for (int m = 0; m < 8; ++m)
#pragma unroll
      for (int nt = 0; nt < 2; ++nt) {
        const int row = pm * 256 + wr * 128 + m * 16 + fr, c = pn * 128 + wc * 32 + nt * 16 + 4 * fq;
        u32x2 o = {cvtpk(macc[m][nt][0], macc[m][nt][1]), cvtpk(macc[m][nt][2], macc[m][nt][3])};
        *(u32x2*)(p.m + (size_t)row * DM + c) = o;
      }
  }
}

__device__ __forceinline__ void phase_wout(const P& p, int l, char* lds) {
  const int tid = otid(), lane = tid & 63, wid = tid >> 6, wr = wid >> 2, wc = wid & 3, fr = lane & 15, fq = lane >> 4;
  const float* xin = l == 0 ? p.x : p.xbuf;
  for (int t = obid(); t < 32 * 8; t += ogdim()) {
    const int pm = t & 31, pn = t >> 5;
    f32x4 acc[8][4];
    zero_acc<4>(acc);
    gemm8_main(acc, p.m + (size_t)pm * 256 * DM, p.WoutT + ((size_t)l * DM + (size_t)pn * 256) * DM, DM, lds);
#pragma unroll
    for (int m = 0; m < 8; ++m)
#pragma unroll
      for (int nt = 0; nt < 4; ++nt) {
        const int row = pm * 256 + (m >> 2) * 128 + wr * 64 + (m & 3) * 16 + fr, c = pn * 256 + wc * 32 + ncol<4>(nt) + 4 * fq;
        const f32x4 xv = *(const f32x4*)(xin + (size_t)row * DM + c);
        *(f32x4*)(p.xbuf + (size_t)row * DM + c) = xv + acc[m][nt];
        if (nt == 3) __builtin_amdgcn_sched_barrier(0);
      }
  }
}

#if SINGLE_LAUNCH
typedef const __attribute__((address_space(4))) P KP;
#if defined(__HIP_DEVICE_COMPILE__)
#define LOADP() KP* q_ = (KP*)__builtin_amdgcn_kernarg_segment_ptr(); asm volatile("" : "+s"(q_)); const P p = *(const P*)q_
#else
#define LOADP() const P p{}
#endif
constexpr int XB_ST_OFF = LDS_BYTES - 16;
__device__ __forceinline__ void gsync(char* lds) {
#if defined(__HIP_DEVICE_COMPILE__)
  KP* q_ = (KP*)__builtin_amdgcn_kernarg_segment_ptr(); asm volatile("" : "+s"(q_));
  XcdBarrier b; b.bar = ((const P*)q_)->bar; b.x = xb_xcc_id(); b.st = (volatile LAS unsigned*)(lds + XB_ST_OFF);
  xcd_barrier(b);
#endif
}
template <int L> __device__ __forceinline__ void run_layer(char* lds) {
#ifndef ONLY_S
#define PH_ON(s) 1
#else
#define PH_ON(s) ((s) == ONLY_S)
#endif
  if (L != 0) { if (PH_ON(0)) { LOADP(); phase_norm(p, L, lds); } gsync(lds); }
#if defined(DOUBLE_S) && DOUBLE_S == 0
  { LOADP(); phase_norm(p, L, lds); } gsync(lds);
#endif
  if (PH_ON(1)) { LOADP(); phase_gemm_in(p, L, lds); } gsync(lds);
#if defined(DOUBLE_S) && DOUBLE_S == 1
  { LOADP(); phase_gemm_in(p, L, lds); } gsync(lds);
#endif
  if (PH_ON(2)) { LOADP(); phase_local(p, L, lds); } gsync(lds);
#if defined(DOUBLE_S) && DOUBLE_S == 2
  { LOADP(); phase_local(p, L, lds); } gsync(lds);
#endif
  if (PH_ON(3)) { LOADP(); phase_scan(p, L); } gsync(lds);
#if defined(DOUBLE_S) && DOUBLE_S == 3
  { LOADP(); phase_scan(p, L); } gsync(lds);
#endif
  if (PH_ON(4)) { LOADP(); phase_out(p, L, lds); } gsync(lds);
#if defined(DOUBLE_S) && DOUBLE_S == 4
  { LOADP(); phase_out(p, L, lds); } gsync(lds);
#endif
  if (PH_ON(5)) { LOADP(); phase_attn_glu(p, L, lds); } gsync(lds);
#if defined(DOUBLE_S) && DOUBLE_S == 5
  { LOADP(); phase_attn_glu(p, L, lds); } gsync(lds);
#endif
  if (PH_ON(6)) { LOADP(); phase_merge(p, L, lds); } gsync(lds);
#if defined(DOUBLE_S) && DOUBLE_S == 6
  { LOADP(); phase_merge(p, L, lds); } gsync(lds);
#endif
  if (PH_ON(7)) { LOADP(); phase_wout(p, L, lds); } gsync(lds);
}

__global__ void __launch_bounds__(NTHREADS) fwd_kernel(P pdummy) {
  extern __shared__ __attribute__((aligned(16))) char lds[];
  cg::grid_group grid = cg::this_grid();
  (void)pdummy;
  if (threadIdx.x < 4) ((volatile LAS unsigned*)(lds + XB_ST_OFF))[threadIdx.x] = 0u;
  __syncthreads();
  { LOADP(); (void)xcd_barrier_post(p.bar, (volatile LAS unsigned*)(lds + XB_ST_OFF)); }
  { LOADP(); phase_prep(p, lds); if (p.out == nullptr) grid.sync(); }
  { LOADP(); phase_norm(p, 0, lds); }
  gsync(lds);
#if defined(DOUBLE_S) && DOUBLE_S == 9
  for (int i = 0; i < 16; ++i) gsync(lds);
#endif
  run_layer<0>(lds);
  run_layer<1>(lds);
  { LOADP(); phase_final_norm(p); }
}

#else
constexpr int NPHASE = 18;
#ifdef PROBE_A
__global__ void stamp_k(unsigned long long* ts, int i) { if (threadIdx.x == 0 && blockIdx.x == 0) ts[i] = wall_clock64(); }
__global__ void fill_k(float* out, const unsigned long long* ts) {
  const float c = (float)(ts[PROBE_A + 1] - ts[PROBE_A]) * 1e-4f, a = (float)(ts[PROBE_B + 1] - ts[PROBE_B]) * 1e-2f;
  for (unsigned i = blockIdx.x * blockDim.x + threadIdx.x; i < (unsigned)(S * DM); i += gridDim.x * blockDim.x) out[i] = i == 0 ? a : c;
}
#endif
template <int SS> __global__ void __launch_bounds__(NTHREADS) phase_k(P p, int l) {
  extern __shared__ __attribute__((aligned(16))) char lds[];
  if (SS == 8) phase_prep(p, lds);
  else if (SS == 9) phase_final_norm(p);
  else if (SS == 0) phase_norm(p, l, lds);
  else if (SS == 1) phase_gemm_in(p, l, lds);
  else if (SS == 2) phase_local(p, l, lds);
  else if (SS == 3) phase_scan(p, l);
  else if (SS == 4) phase_out(p, l, lds);
  else if (SS == 5) phase_attn_glu(p, l, lds);
  else if (SS == 6) phase_merge(p, l, lds);
  else phase_wout(p, l, lds);
}
#endif

extern "C" void kernel_launch(void* const* d_in, const int* in_sizes, int n_in, void* d_out, int out_size, void* d_ws, size_t ws_size,
                              hipStream_t stream) {
  (void)in_sizes; (void)n_in; (void)out_size;
  static int grid_blocks = 0;
  if (!grid_blocks) {
    int dev = 0, cus = 0;
    (void)hipGetDevice(&dev);
    (void)hipDeviceGetAttribute(&cus, hipDeviceAttributeMultiprocessorCount, dev);
    if (cus <= 0) cus = 256;
#if SINGLE_LAUNCH
    int per_cu = 0;
    hipError_t e = hipFuncSetAttribute((const void*)fwd_kernel, hipFuncAttributeMaxDynamicSharedMemorySize, LDS_BYTES);
    if (e != hipSuccess) fprintf(stderr, "hipFuncSetAttribute failed: %s\n", hipGetErrorString(e));
    (void)hipOccupancyMaxActiveBlocksPerMultiprocessor(&per_cu, fwd_kernel, NTHREADS, LDS_BYTES);
    if (per_cu < 1) fprintf(stderr, "occupancy query returned %d\n", per_cu);
#else
#define SETA(SS) (void)hipFuncSetAttribute((const void*)phase_k<SS>, hipFuncAttributeMaxDynamicSharedMemorySize, LDS_BYTES)
    SETA(0); SETA(1); SETA(2); SETA(3); SETA(4); SETA(5); SETA(6); SETA(7); SETA(8); SETA(9);
#undef SETA
#endif
    grid_blocks = cus;
  }
  P p{};
  const float* const* in = (const float* const*)d_in;
  p.x = in[0]; p.norm_g = in[1]; p.w_in = in[2]; p.b_gate = in[3]; p.fox_bf = in[4]; p.hg_lb = in[5]; p.hg_norm_g = in[6];
  p.a_re = in[7]; p.a_im = in[8]; p.log_dt = in[9]; p.b_re = in[10]; p.b_im = in[11]; p.c_re = in[12]; p.c_im = in[13];
  p.s5_d = in[14]; p.w_glu = in[15]; p.w_a = in[16]; p.w_b = in[17]; p.w_c = in[18]; p.w_out = in[19]; p.final_g = in[20];
  p.out = (float*)d_out;
  char* w = (char*)d_ws; size_t off = 0;
  auto take = [&](size_t bytes) { char* r = w + off; off += (bytes + 255) & ~(size_t)255; return r; };
  p.WinT = (bf16_t*)take((size_t)2 * NZ * DM * 2);
  p.WgluT = (bf16_t*)take((size_t)2 * 2048 * HW * 2);
  p.WbrT = (bf16_t*)take((size_t)6 * DM * HW * 2);
  p.WoutT = (bf16_t*)take((size_t)2 * DM * DM * 2);
  p.Ktab = (bf16_t*)take((size_t)2 * 64 * 32 * 256 * 2);
  p.M1 = (bf16_t*)take((size_t)2 * 64 * 128 * 512 * 2);
  p.M2 = (bf16_t*)take((size_t)2 * 64 * 512 * 128 * 2);
  p.AL = (float*)take((size_t)2 * 64 * 64 * 2 * 4);
  p.xbuf = (float*)take((size_t)S * DM * 4);
  p.h = (bf16_t*)take((size_t)S * DM * 2);
  p.lsf = (float*)take((size_t)S * 8 * 4);
  p.cc = (float*)take((size_t)S * 8 * 4);
  p.zb = (bf16_t*)take((size_t)10 * S * HW * 2);
  p.logf = (float*)take((size_t)S * HW * 4);
  p.gates = (bf16_t*)take((size_t)S * 6144 * 2);
  p.oin = (float*)take((size_t)S * HW * 4);
  p.qd = (bf16_t*)take((size_t)S * HW * 2);
  p.SlocT = (float*)take((size_t)8 * 128 * 128 * 128 * 4);
  p.elast = (float*)take((size_t)8 * 128 * 128 * 4);
  p.SprevT = (bf16_t*)take((size_t)8 * 128 * 128 * 128 * 2);
  p.Xloc = (float*)take((size_t)64 * NCH * 128 * 4);
  p.Xprev = (bf16_t*)take((size_t)64 * NCH * 128 * 2);
  p.yg = (bf16_t*)take((size_t)S * HW * 2);
  p.oa = (bf16_t*)take((size_t)S * HW * 2);
  p.ob = (bf16_t*)take((size_t)S * HW * 2);
  p.oc = (bf16_t*)take((size_t)S * HW * 2);
  p.m = (bf16_t*)take((size_t)S * DM * 2);
  p.ts = (unsigned long long*)take(4096);
  p.bar = (unsigned*)take((size_t)(XCD_BAR_WORDS + 256) * 4);
  p.opart = (float*)take((size_t)256 * 32768 * 4);
  p.mlpart = (float*)take((size_t)256 * 512 * 4);
  p.mtmp = (float*)take((size_t)256 * 65536 * 4);
  if (off > ws_size) { fprintf(stderr, "workspace too small: need %zu have %zu\n", off, ws_size); return; }
#if SINGLE_LAUNCH
  (void)hipMemsetAsync(p.bar, 0, (size_t)(XCD_BAR_WORDS + 256) * 4, stream);
  void* args[] = {&p};
  hipError_t e = hipLaunchCooperativeKernel((const void*)fwd_kernel, dim3(grid_blocks), dim3(NTHREADS), args, LDS_BYTES, stream);
  if (e != hipSuccess) fprintf(stderr, "cooperative launch failed: %s (grid %d)\n", hipGetErrorString(e), grid_blocks);
#else
#ifdef PROBE_A
  int sidx = 0;
#define LAUNCH(SS, L) do { stamp_k<<<1, 64, 0, stream>>>(p.ts, sidx++); phase_k<SS><<<dim3(grid_blocks), dim3(NTHREADS), LDS_BYTES, stream>>>(p, L); } while (0)
#else
#define LAUNCH(SS, L) phase_k<SS><<<dim3(grid_blocks), dim3(NTHREADS), LDS_BYTES, stream>>>(p, L)
#endif
  LAUNCH(8, 0);
  for (int l = 0; l < 2; ++l) { LAUNCH(0, l); LAUNCH(1, l); LAUNCH(2, l); LAUNCH(3, l); LAUNCH(4, l); LAUNCH(5, l); LAUNCH(6, l); LAUNCH(7, l); }
  LAUNCH(9, 0);
#ifdef PROBE_A
  stamp_k<<<1, 64, 0, stream>>>(p.ts, sidx++);
  fill_k<<<1024, 256, 0, stream>>>(p.out, p.ts);
#endif
#undef LAUNCH
#endif
}
```
